# Optimizing an MI355X kernel written in HIP

```python
import jax, jax.numpy as jnp
from jax import lax
import numpy as np

D_MODEL = 1024
BATCH = 2
SEQ = 8192
DEPTH = 2

GRID_W = 64
CTX_LEN = 256
EPS = 1e-6
CONV_CH = 512
CONV_WIDTH = 31
NA_HEADS = 8
NA_HEAD_DIM = 64
NA_KR_MAX = 8
NA_KC = 16
EVEN_IN = 2 * CONV_CH + 3 * NA_HEADS * NA_HEAD_DIM
EVEN_MIX = CONV_CH + NA_HEADS * NA_HEAD_DIM
POOL_CH = 512
POOL_WINDOWS = (2, 4, 8, 16)
POOL_GROUP = POOL_CH // len(POOL_WINDOWS)
GLA_HEADS = 4
GLA_DK = 64
GLA_DV = 128
GLA_RANK = 16
GLA_TAU = 16.0
GLA_CHUNK = 64
ODD_IN = POOL_CH + GLA_HEADS * (2 * GLA_DK + 2 * GLA_DV) + 2 * GLA_RANK
ODD_MIX = POOL_CH + GLA_HEADS * GLA_DV
ROPE_BASE = 10000.0
N_EXPERTS = 16
EXPERT_FF = 2816
EC_CAPACITY_FACTOR = 2

kernel_name = 'hybrid_diffusion_conv_na_pool_gla_ecmoe'


def rms_norm(x, g):
    xf = x.astype(jnp.float32)
    y = xf * lax.rsqrt(jnp.mean(xf * xf, axis=-1, keepdims=True) + EPS)
    return (y * g.astype(jnp.float32)).astype(x.dtype)


def layer_norm(x, g, b):
    xf = x.astype(jnp.float32)
    mu = jnp.mean(xf, axis=-1, keepdims=True)
    var = jnp.mean(jnp.square(xf - mu), axis=-1, keepdims=True)
    y = (xf - mu) * lax.rsqrt(var + EPS) * g.astype(jnp.float32) + b.astype(jnp.float32)
    return y.astype(x.dtype)


def adaln(x, g, shift, scale):
    return rms_norm(x, g) * (1.0 + scale) + shift


def axial_rope(x):
    L, dk = x.shape[1], x.shape[-1]
    t = jnp.arange(L)
    pos_r = (t // GRID_W).astype(jnp.float32)
    pos_c = (t % GRID_W).astype(jnp.float32)
    half = dk // 2
    nf = half // 2
    inv = jnp.power(ROPE_BASE, -jnp.arange(nf, dtype=jnp.float32) / nf)

    def rot(xa, pos):
        ang = pos[:, None] * inv[None, :]
        cos = jnp.cos(ang)[None, :, None, :].astype(xa.dtype)
        sin = jnp.sin(ang)[None, :, None, :].astype(xa.dtype)
        x1, x2 = xa[..., :nf], xa[..., nf:]
        return jnp.concatenate([x1 * cos - x2 * sin, x1 * sin + x2 * cos], axis=-1)

    return jnp.concatenate([rot(x[..., :half], pos_r), rot(x[..., half:], pos_c)], axis=-1)


def conformer_conv(u, conv_w, conv_b, ln_g, ln_b):
    glu = u[..., :CONV_CH] * jax.nn.sigmoid(u[..., CONV_CH:])
    y = lax.conv_general_dilated(
        glu, conv_w[:, None, :].astype(glu.dtype), window_strides=(1,),
        padding=[(CONV_WIDTH // 2, CONV_WIDTH // 2)],
        dimension_numbers=('NWC', 'WIO', 'NWC'), feature_group_count=CONV_CH) + conv_b
    return jax.nn.silu(layer_norm(y, ln_g, ln_b))


def neighbourhood_attention(q, k, v, kc, vc, rpb, rows):
    B_, L, H, dh = q.shape
    kr = min(NA_KR_MAX, rows)
    scale = dh ** -0.5
    qg = (q * scale).reshape(B_, rows, GRID_W, H, dh).transpose(1, 0, 3, 2, 4)
    kg = k.reshape(B_, rows, GRID_W, H, dh)
    vg = v.reshape(B_, rows, GRID_W, H, dh)
    col = jnp.arange(GRID_W)
    col_start = jnp.clip(col - NA_KC // 2, 0, GRID_W - NA_KC)
    col_idx = col_start[:, None] + jnp.arange(NA_KC)[None, :]
    col_off = col_idx - col[:, None] + NA_KC - 1

    def row_block(args):
        r, qr = args
        rs = jnp.clip(r - kr // 2, 0, rows - kr)
        kw = lax.dynamic_slice_in_dim(kg, rs, kr, axis=1)[:, :, col_idx]
        vw = lax.dynamic_slice_in_dim(vg, rs, kr, axis=1)[:, :, col_idx]
        row_off = rs + jnp.arange(kr) - r + NA_KR_MAX - 1
        bias = rpb[:, row_off[None, :, None], col_off[:, None, :]]
        s_win = jnp.einsum('bhcd,brckhd->bhcrk', qr, kw) + bias[None].astype(qr.dtype)
        s_ctx = jnp.einsum('bhcd,bnhd->bhcn', qr, kc)
        s = jnp.concatenate([s_win.reshape(B_, H, GRID_W, kr * NA_KC), s_ctx], axis=-1)
        p = jax.nn.softmax(s.astype(jnp.float32), axis=-1).astype(v.dtype)
        p_win = p[..., :kr * NA_KC].reshape(B_, H, GRID_W, kr, NA_KC)
        p_ctx = p[..., kr * NA_KC:]
        return (jnp.einsum('bhcrk,brckhd->bchd', p_win, vw)
                + jnp.einsum('bhcn,bnhd->bchd', p_ctx, vc))

    out = lax.map(row_block, (jnp.arange(rows), qg))
    return out.transpose(1, 0, 2, 3, 4).reshape(B_, L, H, dh)


def context_attention(q, k, v):
    s = jnp.einsum('bqhd,bkhd->bhqk', q, k) * (q.shape[-1] ** -0.5)
    p = jax.nn.softmax(s.astype(jnp.float32), axis=-1).astype(v.dtype)
    return jnp.einsum('bhqk,bkhd->bqhd', p, v)


def multiscale_pool(u, w, scale):
    B_, L, _ = u.shape
    uf = u.astype(jnp.float32)
    cs = jnp.concatenate([jnp.zeros((B_, 1, POOL_CH), jnp.float32), jnp.cumsum(uf, axis=1)], axis=1)
    t = jnp.arange(L)
    diffs = []
    for gi, win in enumerate(POOL_WINDOWS):
        sl = slice(gi * POOL_GROUP, (gi + 1) * POOL_GROUP)
        lo = jnp.clip(t - win // 2, 0, L)
        hi = jnp.clip(t + win - win // 2, 0, L)
        csg = cs[:, :, sl]
        mean = (csg[:, hi] - csg[:, lo]) / (hi - lo).astype(jnp.float32)[None, :, None]
        diffs.append(mean - uf[:, :, sl])
    d = jnp.stack(diffs, axis=2)
    y = jnp.einsum('blgc,gce->blge', d, w.astype(jnp.float32)).reshape(B_, L, POOL_CH)
    return (y * scale.astype(jnp.float32)).astype(u.dtype)


def gla_scan(q, k, v, g, s0):
    B_, L, H, _ = q.shape
    dv = v.shape[-1]
    n = L // GLA_CHUNK
    mask = jnp.tril(jnp.ones((GLA_CHUNK, GLA_CHUNK), dtype=bool))

    def to_chunks(a):
        return a.reshape(B_, n, GLA_CHUNK, H, a.shape[-1]).transpose(1, 0, 3, 2, 4)

    def step(S, inp):
        qc, kc, vc, gc = inp
        b = jnp.cumsum(gc, axis=2)
        inter = jnp.einsum('bhid,bhde->bhie', qc * jnp.exp(b), S)
        diff = b[:, :, :, None, :] - b[:, :, None, :, :]
        decay = jnp.exp(jnp.where(mask[:, :, None], diff, -jnp.inf))
        att = jnp.einsum('bhid,bhjd,bhijd->bhij', qc, kc, decay)
        intra = jnp.einsum('bhij,bhje->bhie', att, vc)
        b_last = b[:, :, -1:, :]
        S_new = (jnp.exp(b_last[:, :, 0, :])[..., None] * S
                 + jnp.einsum('bhjd,bhje->bhde', kc * jnp.exp(b_last - b), vc))
        return S_new, inter + intra

    S_fin, o = lax.scan(step, s0, (to_chunks(q), to_chunks(k), to_chunks(v), to_chunks(g)))
    return o.transpose(1, 0, 3, 2, 4).reshape(B_, L, H, dv), S_fin


def gla_final_state(k, v, g):
    b = jnp.cumsum(g, axis=1)
    return jnp.einsum('blhd,blhe->bhde', k * jnp.exp(b[:, -1:] - b), v)


def flip(a):
    return a[:, ::-1]


def even_mixer(h, h_ctx, rows, w_in, w_out, conv_w, conv_b, ln_g, ln_b, rpb, ctx_out):
    B_, L, _ = h.shape
    N = h_ctx.shape[1]
    hd = NA_HEADS * NA_HEAD_DIM
    q0 = 2 * CONV_CH
    k0 = q0 + hd
    v0 = k0 + hd

    def heads(a):
        return a.reshape(a.shape[0], a.shape[1], NA_HEADS, NA_HEAD_DIM)

    p = h @ w_in
    off = 0 if ctx_out else k0
    pc = h_ctx @ w_in[:, off:]
    kc = heads(pc[..., k0 - off:v0 - off])
    vc = heads(pc[..., v0 - off:])
    a_lat = conformer_conv(p[..., :q0], conv_w, conv_b, ln_g, ln_b)
    na = neighbourhood_attention(heads(p[..., q0:k0]), heads(p[..., k0:v0]), heads(p[..., v0:]), kc, vc, rpb, rows)
    y = jnp.concatenate([a_lat, na.reshape(B_, L, hd)], axis=-1) @ w_out
    if not ctx_out:
        return y, None
    a_ctx = conformer_conv(pc[..., :q0], conv_w, conv_b, ln_g, ln_b)
    att = context_attention(heads(pc[..., q0:k0]), kc, vc)
    y_ctx = jnp.concatenate([a_ctx, att.reshape(B_, N, hd)], axis=-1) @ w_out
    return y, y_ctx


def odd_mixer(h, h_ctx, w_in, w_out, pool_w, pool_scale, gate_w, gate_b, head_g, ctx_out):
    B_, L, _ = h.shape
    N = h_ctx.shape[1]
    qk = GLA_HEADS * GLA_DK
    vd = GLA_HEADS * GLA_DV
    q0 = POOL_CH
    k0 = q0 + qk
    v0 = k0 + qk
    r0 = v0 + vd
    l0 = r0 + vd
    f32 = jnp.float32
    qscale = GLA_DK ** -0.5

    def heads(a):
        return a.reshape(a.shape[0], a.shape[1], GLA_HEADS, -1).astype(f32)

    def gates(lr):
        lr = lr.astype(f32)
        gf = jax.nn.log_sigmoid(lr[..., :GLA_RANK] @ gate_w[0] + gate_b[0]) / GLA_TAU
        gb = jax.nn.log_sigmoid(lr[..., GLA_RANK:] @ gate_w[1] + gate_b[1]) / GLA_TAU
        return heads(gf), heads(gb)

    def gla_out(o, r):
        o = rms_norm(o.astype(h.dtype), head_g.reshape(GLA_HEADS, GLA_DV))
        return o.reshape(o.shape[0], o.shape[1], vd) * jax.nn.silu(r)

    if ctx_out:
        pc = h_ctx @ w_in
        qc = heads(pc[..., q0:k0]) * qscale
        kc, vc = heads(pc[..., k0:v0]), heads(pc[..., v0:r0])
        gcf, gcb = gates(pc[..., l0:])
        s0 = jnp.zeros((B_, GLA_HEADS, GLA_DK, GLA_DV), f32)
        oc_f, s_f = gla_scan(qc, kc, vc, gcf, s0)
        oc_b, s_b = gla_scan(flip(qc), flip(kc), flip(vc), flip(gcb), s0)
        d_ctx = gla_out(oc_f + flip(oc_b), pc[..., r0:l0])
    else:
        pkv = h_ctx @ w_in[:, k0:r0]
        plr = h_ctx @ w_in[:, l0:]
        kc, vc = heads(pkv[..., :qk]), heads(pkv[..., qk:])
        gcf, gcb = gates(plr)
        s_f = gla_final_state(kc, vc, gcf)
        s_b = gla_final_state(flip(kc), flip(vc), flip(gcb))

    p = h @ w_in
    q = axial_rope(heads(p[..., q0:k0])) * qscale
    k = axial_rope(heads(p[..., k0:v0]))
    v = heads(p[..., v0:r0])
    gf, gb = gates(p[..., l0:])
    o_f, _ = gla_scan(q, k, v, gf, s_f)
    o_b, _ = gla_scan(flip(q), flip(k), flip(v), flip(gb), s_b)
    d_lat = gla_out(o_f + flip(o_b), p[..., r0:l0])
    y = jnp.concatenate([multiscale_pool(p[..., :q0], pool_w, pool_scale), d_lat], axis=-1) @ w_out
    if not ctx_out:
        return y, None
    y_ctx = jnp.concatenate([multiscale_pool(pc[..., :q0], pool_w, pool_scale), d_ctx], axis=-1) @ w_out
    return y, y_ctx


def ec_moe(x, router_w, w_gate, w_up, w_down):
    B_, N, D = x.shape
    cap = EC_CAPACITY_FACTOR * N // N_EXPERTS
    aff = jax.nn.softmax((x @ router_w).astype(jnp.float32), axis=-1)
    vals, idx = lax.top_k(jnp.swapaxes(aff, 1, 2), cap)
    xg = jax.vmap(lambda xb, ib: xb[ib])(x, idx)
    hid = jax.nn.silu(jnp.einsum('becd,edf->becf', xg, w_gate)) * jnp.einsum('becd,edf->becf', xg, w_up)
    y = jnp.einsum('becf,efd->becd', hid, w_down) * vals[..., None].astype(x.dtype)
    return jax.vmap(lambda yb, ib: jnp.zeros((N, D), yb.dtype).at[ib.reshape(-1)].add(yb.reshape(-1, D)))(y, idx)


def setup_inputs(seed: int = 0) -> dict:
    key = jax.random.key(seed)
    ks = iter(jax.random.split(key, 40))
    n_even = (DEPTH + 1) // 2
    n_odd = DEPTH // 2
    D = D_MODEL

    def nrm(shape, scale):
        return jax.random.normal(next(ks), shape, jnp.float32) * scale

    def gain(shape):
        return 1.0 + 0.01 * jax.random.normal(next(ks), shape, jnp.float32)

    return {
        'x': nrm((BATCH, SEQ, D), 1.0),
        'c': nrm((BATCH, D), 1.0),
        'ctx': nrm((BATCH, CTX_LEN, D), 1.0),
        'c_ctx': nrm((D,), 1.0),
        'w_mod': nrm((DEPTH, D, 6 * D), 0.5 * D ** -0.5),
        'b_mod': nrm((DEPTH, 6 * D), 0.01),
        'norm_g': gain((DEPTH, 4, D)),
        'w_in_even': nrm((n_even, D, EVEN_IN), D ** -0.5),
        'w_out_even': nrm((n_even, EVEN_MIX, D), EVEN_MIX ** -0.5),
        'conv_w': nrm((n_even, CONV_WIDTH, CONV_CH), CONV_WIDTH ** -0.5),
        'conv_b': nrm((n_even, CONV_CH), 0.01),
        'conv_ln_g': gain((n_even, CONV_CH)),
        'conv_ln_b': nrm((n_even, CONV_CH), 0.01),
        'na_rpb': nrm((n_even, NA_HEADS, 2 * NA_KR_MAX - 1, 2 * NA_KC - 1), 0.02),
        'w_in_odd': nrm((n_odd, D, ODD_IN), D ** -0.5),
        'w_out_odd': nrm((n_odd, ODD_MIX, D), ODD_MIX ** -0.5),
        'pool_w': nrm((n_odd, len(POOL_WINDOWS), POOL_GROUP, POOL_GROUP), POOL_GROUP ** -0.5),
        'pool_scale': gain((n_odd, POOL_CH)),
        'gla_gate_w': nrm((n_odd, 2, GLA_RANK, GLA_HEADS * GLA_DK), GLA_RANK ** -0.5),
        'gla_gate_b': nrm((n_odd, 2, GLA_HEADS * GLA_DK), 0.01),
        'gla_head_g': gain((n_odd, GLA_HEADS * GLA_DV)),
        'router_w': nrm((DEPTH, D, N_EXPERTS), D ** -0.5),
        'expert_w_gate': nrm((DEPTH, N_EXPERTS, D, EXPERT_FF), D ** -0.5),
        'expert_w_up': nrm((DEPTH, N_EXPERTS, D, EXPERT_FF), D ** -0.5),
        'expert_w_down': nrm((DEPTH, N_EXPERTS, EXPERT_FF, D), EXPERT_FF ** -0.5),
    }


def reference(x, c, ctx, c_ctx, w_mod, b_mod, norm_g, w_in_even, w_out_even, conv_w, conv_b,
              conv_ln_g, conv_ln_b, na_rpb, w_in_odd, w_out_odd, pool_w, pool_scale,
              gla_gate_w, gla_gate_b, gla_head_g, router_w, expert_w_gate, expert_w_up, expert_w_down):
    B_, L, D = x.shape
    rows = L // GRID_W
    for i in range(DEPTH):
        ctx_out = i < DEPTH - 1
        j = i // 2
        m = (jax.nn.silu(c) @ w_mod[i] + b_mod[i]).reshape(B_, 6, 1, D)
        mc = (jax.nn.silu(c_ctx) @ w_mod[i] + b_mod[i]).reshape(6, D)
        g = norm_g[i]
        h = adaln(x, g[0], m[:, 0], m[:, 1])
        hc = adaln(ctx, g[0], mc[0], mc[1])
        if i % 2 == 0:
            y, yc = even_mixer(h, hc, rows, w_in_even[j], w_out_even[j], conv_w[j], conv_b[j],
                               conv_ln_g[j], conv_ln_b[j], na_rpb[j], ctx_out)
        else:
            y, yc = odd_mixer(h, hc, w_in_odd[j], w_out_odd[j], pool_w[j], pool_scale[j],
                              gla_gate_w[j], gla_gate_b[j], gla_head_g[j], ctx_out)
        x = x + m[:, 2] * rms_norm(y, g[1])
        f = ec_moe(adaln(x, g[2], m[:, 3], m[:, 4]), router_w[i], expert_w_gate[i], expert_w_up[i], expert_w_down[i])
        x = x + m[:, 5] * rms_norm(f, g[3])
        if ctx_out:
            ctx = ctx + mc[2] * rms_norm(yc, g[1])
            fc = ec_moe(adaln(ctx, g[2], mc[3], mc[4]), router_w[i], expert_w_gate[i], expert_w_up[i], expert_w_down[i])
            ctx = ctx + mc[5] * rms_norm(fc, g[3])
    return x
```

```cpp
#include <hip/hip_runtime.h>
#include <cstdio>
#include <cstdint>
namespace pg8 {
#define PG8_LAS __attribute__((address_space(3)))
typedef unsigned short bf16_t;
typedef short bf16x8 __attribute__((ext_vector_type(8)));
typedef float f32x4 __attribute__((ext_vector_type(4)));
typedef unsigned u32x4 __attribute__((ext_vector_type(4)));
constexpr int BM = 256, BK = 64, HALF = 128, HTB = HALF * BK * 2  , STAGE_BYTES = 8 * HTB, NXCD = 8, WGM = 8;

__host__ __device__ __forceinline__ int lds_byte(int r, int c) { const int st = (r >> 4) * 2 + (c >> 5), rr = r & 15, cc = c & 31, ob = rr * 64 + cc * 2; return st * 1024 + (ob ^ (((ob >> 9) & 1) << 5)); }
__host__ __device__ __forceinline__ void stage_rc(int b, int& R, int& C) { const int st = b / 1024, sb = b % 1024, swz = sb ^ (((sb >> 9) & 1) << 5); R = (st >> 1) * 16 + swz / 64; C = (st & 1) * 32 + (swz % 64) / 2; }
__host__ __device__ __forceinline__ int perm32(int rho) { const int n = rho >> 4, i = rho & 15; return 8 * (i >> 2) + 4 * n + (i & 3); }

struct Unit { int pm, pn, pb; };
struct Gemm { const bf16_t* A; const bf16_t* Bt; int K; };

struct Order {
    int nM, nN, nwg, G, c, moe;
    __device__ void init(int nM_, int nN_, int G_, int c_, int moe_) { nM = nM_; nN = nN_; nwg = nM * nN; G = G_; c = c_; moe = moe_; }
    __device__ bool next(int i, Unit& u) const {
        const long L = (long)i * G + c; if (L >= nwg) return false;
        int wgid = (int)L; { const int q = nwg / NXCD, r = nwg % NXCD, xcd = wgid % NXCD, off = wgid / NXCD; wgid = (xcd < r ? xcd * (q + 1) : r * (q + 1) + (xcd - r) * q) + off; }
        const int nig = WGM * nN, gid = wgid / nig, fm = gid * WGM, gsz = (nM - fm) < WGM ? (nM - fm) : WGM;
        u.pm = fm + ((wgid % nig) % gsz); u.pn = (wgid % nig) / gsz;
        u.pb = moe ? ((u.pm < 128 ? (u.pm >> 3) : (u.pm - 128)) * nN + u.pn) : u.pn;
        return true;
    }
    __device__ __forceinline__ void a_ready(const Unit&) const {}
    __device__ __forceinline__ void done(const Unit&) const {}
};

__device__ __forceinline__ unsigned cvt_pk_bf16(float lo, float hi) { unsigned r; asm volatile("v_cvt_pk_bf16_f32 %0, %1, %2" : "=v"(r) : "v"(lo), "v"(hi)); return r; }

struct EpiBf16 {
    static constexpr bool PERM = true, AFTER_DRAIN = false;
    bf16_t* O; int ldc;
    __device__ __forceinline__ void operator()(const f32x4 (&acc)[2][2][4][2], const Unit& u, int wr, int wc, int fr, int fq) const {
        const int row0 = u.pm * BM + wr * 64 + fr; const int col0 = u.pn * BM + wc * 32 + 8 * fq;
#pragma unroll
        for (int ai = 0; ai < 2; ++ai)
#pragma unroll
            for (int m = 0; m < 4; ++m) { bf16_t* rowp = O + (size_t)(row0 + ai * HALF + m * 16) * ldc + col0;
#pragma unroll
                for (int bj = 0; bj < 2; ++bj) { const f32x4 v0 = acc[ai][bj][m][0], v1 = acc[ai][bj][m][1];
                    u32x4 w; w.x = cvt_pk_bf16(v0[0], v0[1]); w.y = cvt_pk_bf16(v0[2], v0[3]); w.z = cvt_pk_bf16(v1[0], v1[1]); w.w = cvt_pk_bf16(v1[2], v1[3]);
                    *(u32x4*)(rowp + bj * HALF) = w; } }
    }
};
__device__ __forceinline__ float silu_f(float x) { return x * __builtin_amdgcn_rcpf(1.0f + __expf(-x)); }
struct EpiSwiglu {
    static constexpr bool PERM = true, AFTER_DRAIN = false;
    bf16_t* O; int ldc;
    __device__ __forceinline__ void operator()(const f32x4 (&acc)[2][2][4][2], const Unit& u, int wr, int wc, int fr, int fq) const {
        const int row0 = u.pm * BM + wr * 64 + fr; const int col0 = u.pn * HALF + wc * 32 + 8 * fq;
#pragma unroll
        for (int ai = 0; ai < 2; ++ai)
#pragma unroll
            for (int m = 0; m < 4; ++m) { bf16_t* rowp = O + (size_t)(row0 + ai * HALF + m * 16) * ldc + col0;
                const f32x4 g0 = acc[ai][0][m][0], g1 = acc[ai][0][m][1], u0 = acc[ai][1][m][0], u1 = acc[ai][1][m][1];
                u32x4 w; w.x = cvt_pk_bf16(silu_f(g0[0]) * u0[0], silu_f(g0[1]) * u0[1]); w.y = cvt_pk_bf16(silu_f(g0[2]) * u0[2], silu_f(g0[3]) * u0[3]);
                w.z = cvt_pk_bf16(silu_f(g1[0]) * u1[0], silu_f(g1[1]) * u1[1]); w.w = cvt_pk_bf16(silu_f(g1[2]) * u1[2], silu_f(g1[3]) * u1[3]);
                *(u32x4*)rowp = w; }
    }
};

template <class Epi, class Sched, bool ALIGN_EPI = false, bool SP2 = false>
__device__ __forceinline__ void gemm_phase(PG8_LAS unsigned char* lds, const Gemm g, const Sched& S, const Epi& E) {
    const int tid = threadIdx.x, wid = __builtin_amdgcn_readfirstlane(tid >> 6), lane = tid & 63, wr = wid >> 2, wc = wid & 3, fr = lane & 15, fq = lane >> 4;
    const int K = g.K, nt = K / BK;
    unsigned voffA[2], voffB[2];
#pragma unroll
    for (int i = 0; i < 2; ++i) { int R, C; stage_rc(tid * 16 + i * 8192, R, C); const int Rb = Epi::PERM ? ((R & ~31) + perm32(R & 31)) : R;
        voffA[i] = (unsigned)(R * K + C) * 2u; voffB[i] = (unsigned)(Rb * K + C) * 2u; }
    const size_t kstep = (size_t)(BK * 2);
    const size_t hstep = (size_t)HALF * K * 2;
    const size_t tstep = 2 * hstep;
    const unsigned ldsw = (unsigned)wid * 1024u;
    const int aoff = lds_byte(wr * 64 + fr, fq * 8), boff = lds_byte(wc * 32 + fr, fq * 8);
#define PG8_SA(b, h) (((b) * 2 + (h)) * HTB)
#define PG8_SB(b, h) ((4 + (b) * 2 + (h)) * HTB)
#define PG8_STAGE(bufoff, gbase, voff) do { _Pragma("unroll") for (int _i = 0; _i < 2; ++_i) \
        __builtin_amdgcn_global_load_lds((const unsigned*)((const char*)(gbase) + (voff)[_i]), (PG8_LAS unsigned*)(lds + (bufoff) + ldsw + _i * 8192), 16, 0, 0); } while (0)
#define PG8_LDA(dst, b, h) do { _Pragma("unroll") for (int m = 0; m < 4; ++m) _Pragma("unroll") for (int k = 0; k < 2; ++k) dst[m][k] = *(const PG8_LAS bf16x8*)(lds + PG8_SA(b, h) + aoff + m * 2048 + k * 1024); } while (0)
#define PG8_LDB(dst, b, h) do { _Pragma("unroll") for (int n = 0; n < 2; ++n) _Pragma("unroll") for (int k = 0; k < 2; ++k) dst[n][k] = *(const PG8_LAS bf16x8*)(lds + PG8_SB(b, h) + boff + n * 2048 + k * 1024); } while (0)
#define PG8_MMA(ai, bj, At, Bt) do { __builtin_amdgcn_s_setprio(1); _Pragma("unroll") for (int m = 0; m < 4; ++m) _Pragma("unroll") for (int n = 0; n < 2; ++n) _Pragma("unroll") for (int k = 0; k < 2; ++k) \
        acc[ai][bj][m][n] = __builtin_amdgcn_mfma_f32_16x16x32_bf16(Bt[n][k], At[m][k], acc[ai][bj][m][n], 0, 0, 0); __builtin_amdgcn_s_setprio(0); } while (0)
#define PG8_WAIT_V(n) asm volatile("s_waitcnt vmcnt(" #n ")" ::: "memory")
#define PG8_WAIT_L(n) asm volatile("s_waitcnt lgkmcnt(" #n ")" ::: "memory")
#define PG8_BAR __builtin_amdgcn_s_barrier()
#define PG8_SCHED __builtin_amdgcn_sched_barrier(0)
    Unit cur, nxt; int ui = 0;
    if (!S.next(0, cur)) return;
    f32x4 acc[2][2][4][2];
#pragma unroll
    for (int a = 0; a < 2; ++a)
#pragma unroll
        for (int b = 0; b < 2; ++b)
#pragma unroll
            for (int m = 0; m < 4; ++m)
#pragma unroll
                for (int n = 0; n < 2; ++n) acc[a][b][m][n] = (f32x4){0.f, 0.f, 0.f, 0.f};
    bf16x8 At[4][2], B0[2][2], B1[2][2];
    const char* cA = (const char*)g.A + (size_t)cur.pm * tstep; const char* cB = (const char*)g.Bt + (size_t)cur.pb * tstep;
    S.a_ready(cur);
    if constexpr (SP2) {
        PG8_STAGE(PG8_SB(0, 0), cB, voffB); PG8_STAGE(PG8_SB(0, 1), cB + hstep, voffB); PG8_STAGE(PG8_SA(0, 0), cA, voffA); PG8_STAGE(PG8_SA(0, 1), cA + hstep, voffA);
        if (wr == 1) PG8_BAR;
        PG8_WAIT_V(2); PG8_BAR;
        PG8_STAGE(PG8_SB(1, 0), cB + kstep, voffB); PG8_STAGE(PG8_SA(1, 0), cA + kstep, voffA); PG8_STAGE(PG8_SB(1, 1), cB + hstep + kstep, voffB);
        PG8_WAIT_V(6); PG8_BAR;
    } else {
        PG8_STAGE(PG8_SB(0, 0), cB, voffB); PG8_STAGE(PG8_SA(0, 0), cA, voffA); PG8_STAGE(PG8_SB(0, 1), cB + hstep, voffB); PG8_STAGE(PG8_SA(0, 1), cA + hstep, voffA);
        if (wr == 1) PG8_BAR;
        PG8_WAIT_V(4); PG8_BAR;
        PG8_STAGE(PG8_SB(1, 0), cB + kstep, voffB); PG8_STAGE(PG8_SA(1, 0), cA + kstep, voffA); PG8_STAGE(PG8_SB(1, 1), cB + hstep + kstep, voffB);
        PG8_WAIT_V(6); PG8_BAR;
    }
    for (;;) {
        const bool has_next = S.next(ui + 1, nxt);
        const char* nA = has_next ? (const char*)g.A + (size_t)nxt.pm * tstep : cA; const char* nB = has_next ? (const char*)g.Bt + (size_t)nxt.pb * tstep : cB;
        for (int t = 0; t < nt; t += 2) {
            const bool last = (t == nt - 2);
            const char* a1 = cA + (size_t)(t + 1) * kstep;
            const char* a2 = last ? nA : cA + (size_t)(t + 2) * kstep; const char* b2 = last ? nB : cB + (size_t)(t + 2) * kstep;
            const char* a3 = a2 + kstep; const char* b3 = b2 + kstep;
            if (last && has_next) S.a_ready(nxt);
            if constexpr (SP2) {
            PG8_LDB(B0, 0, 0); PG8_LDB(B1, 0, 1); PG8_SCHED; PG8_LDA(At, 0, 0); PG8_STAGE(PG8_SA(1, 1), a1 + hstep, voffA);
            PG8_WAIT_V(8); PG8_WAIT_L(0); PG8_BAR; PG8_MMA(0, 0, At, B0); PG8_MMA(0, 1, At, B1); PG8_BAR; PG8_SCHED;
            PG8_LDA(At, 0, 1); PG8_STAGE(PG8_SB(0, 0), b2, voffB); PG8_STAGE(PG8_SB(0, 1), b2 + hstep, voffB); PG8_STAGE(PG8_SA(0, 0), a2, voffA);
            PG8_WAIT_V(8); PG8_WAIT_L(0); PG8_BAR; PG8_MMA(1, 0, At, B0); PG8_MMA(1, 1, At, B1); PG8_BAR; PG8_SCHED;
            PG8_LDB(B0, 1, 0); PG8_LDB(B1, 1, 1); PG8_SCHED; PG8_LDA(At, 1, 0); PG8_STAGE(PG8_SA(0, 1), a2 + hstep, voffA);
            PG8_WAIT_V(8); PG8_WAIT_L(0); PG8_BAR; PG8_MMA(0, 0, At, B0); PG8_MMA(0, 1, At, B1); PG8_BAR; PG8_SCHED;
            PG8_LDA(At, 1, 1); PG8_STAGE(PG8_SB(1, 0), b3, voffB); PG8_STAGE(PG8_SB(1, 1), b3 + hstep, voffB); PG8_STAGE(PG8_SA(1, 0), a3, voffA);
            PG8_WAIT_V(8); PG8_WAIT_L(0); PG8_BAR; PG8_MMA(1, 0, At, B0); PG8_MMA(1, 1, At, B1); PG8_BAR; PG8_SCHED;
            } else {
            PG8_LDB(B0, 0, 0); PG8_SCHED; PG8_LDA(At, 0, 0); PG8_STAGE(PG8_SA(1, 1), a1 + hstep, voffA);
            PG8_WAIT_L(8); PG8_BAR; PG8_WAIT_L(0); PG8_MMA(0, 0, At, B0); PG8_BAR; PG8_SCHED;
            PG8_LDB(B1, 0, 1); PG8_STAGE(PG8_SB(0, 0), b2, voffB);
            PG8_BAR; PG8_WAIT_L(0); PG8_MMA(0, 1, At, B1); PG8_BAR;
            PG8_LDA(At, 0, 1); PG8_STAGE(PG8_SA(0, 0), a2, voffA);
            PG8_BAR; PG8_WAIT_L(0); PG8_MMA(1, 0, At, B0); PG8_BAR; PG8_SCHED;
            PG8_STAGE(PG8_SB(0, 1), b2 + hstep, voffB);
            PG8_WAIT_V(6); PG8_BAR; PG8_MMA(1, 1, At, B1); PG8_BAR;
            PG8_LDB(B0, 1, 0); PG8_SCHED; PG8_LDA(At, 1, 0); PG8_STAGE(PG8_SA(0, 1), a2 + hstep, voffA);
            PG8_WAIT_L(8); PG8_BAR; PG8_WAIT_L(0); PG8_MMA(0, 0, At, B0); PG8_BAR; PG8_SCHED;
            PG8_LDB(B1, 1, 1); PG8_STAGE(PG8_SB(1, 0), b3, voffB);
            PG8_BAR; PG8_WAIT_L(0); PG8_MMA(0, 1, At, B1); PG8_BAR;
            PG8_LDA(At, 1, 1); PG8_STAGE(PG8_SA(1, 0), a3, voffA);
            PG8_BAR; PG8_WAIT_L(0); PG8_MMA(1, 0, At, B0); PG8_BAR; PG8_SCHED;
            PG8_STAGE(PG8_SB(1, 1), b3 + hstep, voffB);
            PG8_WAIT_V(6); PG8_BAR; PG8_MMA(1, 1, At, B1); PG8_BAR;
            }
        }
        if constexpr (ALIGN_EPI) { if (wr == 0) PG8_BAR; }
        if constexpr (!Epi::AFTER_DRAIN) { E(acc, cur, wr, wc, fr, fq); S.done(cur); }
        if (!has_next) break;
#pragma unroll
        for (int a = 0; a < 2; ++a)
#pragma unroll
            for (int b = 0; b < 2; ++b)
#pragma unroll
                for (int m = 0; m < 4; ++m)
#pragma unroll
                    for (int n = 0; n < 2; ++n) acc[a][b][m][n] = (f32x4){0.f, 0.f, 0.f, 0.f};
        cur = nxt; cA = nA; cB = nB; ++ui;
        if constexpr (ALIGN_EPI) { if (wr == 1) PG8_BAR; }
    }
    PG8_WAIT_V(0);
    if constexpr (!ALIGN_EPI) { if (wr == 0) PG8_BAR; }
    PG8_BAR;
    if constexpr (Epi::AFTER_DRAIN) { E.fused(acc, cur, wr, wc, fr, fq, lds, wid, lane); S.done(cur); }
#undef PG8_SA
#undef PG8_SB
#undef PG8_STAGE
#undef PG8_LDA
#undef PG8_LDB
#undef PG8_MMA
#undef PG8_WAIT_V
#undef PG8_WAIT_L
#undef PG8_BAR
#undef PG8_SCHED
}
}

#ifndef PG8_SP2
#define PG8_SP2 true
#endif
#ifndef PG8_ALIGN
#define PG8_ALIGN true
#endif
constexpr int D = 1024, SEQ = 8192, NLAT = 16384, CTXL = 256, NCTX = 512, NTOK = NLAT + NCTX;
constexpr int NE = 16, FF = 2816, EVEN_IN = 2560, ODD_IN = 2080;
constexpr int MOE_LAT = 32768, MOE_ROWS = 36864;
constexpr float EPS = 1e-6f;
constexpr int NWAVES = 8;
enum { I_X = 0, I_C, I_CTX, I_CCTX, I_WMOD, I_BMOD, I_NORMG, I_WINE, I_WOUTE, I_CONVW, I_CONVB, I_CLNG, I_CLNB, I_RPB, I_WINO, I_WOUTO, I_POOLW, I_POOLS, I_GATEW, I_GATEB, I_HEADG, I_ROUTER, I_WG, I_WU, I_WD, N_IN };

constexpr size_t MiB = 1u << 20;
constexpr size_t alup(size_t x) { return (x + MiB - 1) / MiB * MiB; }
constexpr size_t WS_CTL = 0, CTL_ZERO_BYTES = MiB;
constexpr size_t WS_MOD = WS_CTL + MiB;
constexpr size_t WS_ROPE = WS_MOD + alup((size_t)2 * 3 * 6144 * 4);
constexpr size_t WS_AFF = WS_ROPE + MiB;
constexpr size_t WS_INV = WS_AFF + alup((size_t)NTOK * 16 * 4);
constexpr size_t WS_ROWTOK = WS_INV + alup((size_t)NTOK * 16 * 4);
constexpr size_t WS_LR = WS_ROWTOK + alup((size_t)MOE_ROWS * 4);
constexpr size_t WS_WINE = WS_LR + alup((size_t)NTOK * 32 * 4);
constexpr size_t WS_WOUTE = WS_WINE + alup((size_t)2560 * 1024 * 2);
constexpr size_t WS_WINO = WS_WOUTE + alup((size_t)1024 * 1024 * 2);
constexpr size_t WS_WOUTO = WS_WINO + alup((size_t)2080 * 1024 * 2);
constexpr size_t WS_POOLW = WS_WOUTO + alup((size_t)1024 * 1024 * 2);
constexpr size_t WS_W1 = WS_POOLW + MiB;
constexpr size_t WS_W2 = WS_W1 + alup((size_t)2 * 16 * 5632 * 1024 * 2);
constexpr size_t WS_H = WS_W2 + alup((size_t)2 * 16 * 1024 * 2816 * 2);
constexpr size_t WS_X1 = WS_H + alup((size_t)NTOK * 1024 * 2);
constexpr size_t WS_XN2 = WS_X1 + alup((size_t)NTOK * 1024 * 4);
constexpr size_t WS_PBUF = WS_XN2 + alup((size_t)NTOK * 1024 * 2);
constexpr size_t WS_MIX = WS_PBUF + alup((size_t)NTOK * 2560 * 2);
constexpr size_t WS_YO = WS_MIX + alup((size_t)NTOK * 1024 * 2);
constexpr size_t WS_MOE = WS_YO + alup((size_t)NTOK * 1024 * 2);
constexpr size_t WS_XG = WS_MOE;
constexpr size_t WS_HID = WS_XG + alup((size_t)MOE_ROWS * 1024 * 2);
constexpr size_t WS_Y = WS_HID + alup((size_t)MOE_ROWS * 2816 * 2);
constexpr size_t WS_END = WS_Y + alup((size_t)MOE_ROWS * 1024 * 2);
constexpr size_t WS_DPOOL = WS_MOE;
constexpr size_t WS_QR = WS_DPOOL + alup((size_t)NLAT * 512 * 2);
constexpr size_t WS_KR = WS_QR + alup((size_t)NLAT * 256 * 4);
constexpr size_t WS_GF = WS_KR + alup((size_t)NTOK * 256 * 4);
constexpr size_t WS_GB = WS_GF + alup((size_t)NTOK * 256 * 4);
constexpr size_t WS_OACC = WS_GB + alup((size_t)NTOK * 256 * 4);
constexpr size_t WS_GLA_END = WS_OACC + alup((size_t)2 * NLAT * 512 * 4);
static_assert(WS_GLA_END <= WS_END, "overlay fits");
constexpr int CW_TMO = 0, CW_BAR = 4096;

constexpr int RING_OFF = 0, RING_BYTES = 131072;
constexpr int LDSCTL_OFF = RING_BYTES, MISC_OFF = LDSCTL_OFF + 320;
constexpr int LDS_BYTES = 147456;

#define GAS __attribute__((address_space(1)))
#define LAS __attribute__((address_space(3)))
typedef unsigned short bf16;
typedef unsigned v4u __attribute__((ext_vector_type(4)));
typedef unsigned v2u __attribute__((ext_vector_type(2)));
typedef float f32x4 __attribute__((ext_vector_type(4)));
typedef short bf16x8 __attribute__((ext_vector_type(8)));
typedef GAS unsigned gu32;
#define RLX_AGENT __ATOMIC_RELAXED, __HIP_MEMORY_SCOPE_AGENT
#define LDS_WAIT() asm volatile("s_waitcnt lgkmcnt(0)" ::: "memory")
#define VM_WAIT() asm volatile("s_waitcnt vmcnt(0)" ::: "memory")
__device__ __forceinline__ unsigned f2bf(float f) { unsigned u = __builtin_bit_cast(unsigned, f); return (u + 0x7fffu + ((u >> 16) & 1u)) >> 16; }
__device__ __forceinline__ unsigned pk2(float lo, float hi) { return f2bf(lo) | (f2bf(hi) << 16); }
__device__ __forceinline__ float bflo(unsigned w) { return __builtin_bit_cast(float, w << 16); }
__device__ __forceinline__ float bfhi(unsigned w) { return __builtin_bit_cast(float, w & 0xffff0000u); }
__device__ __forceinline__ float bf2f(bf16 b) { return __builtin_bit_cast(float, ((unsigned)b) << 16); }
__device__ __forceinline__ float wave_sum(float v) {
#pragma unroll
    for (int o = 1; o < 64; o <<= 1) v += __shfl_xor(v, o);
    return v;
}
__device__ __forceinline__ float silu(float x) { return x / (1.0f + __expf(-x)); }
__device__ __forceinline__ float sigmoidf(float x) { return 1.0f / (1.0f + __expf(-x)); }
#define XB_TMO      128
#define XB_XCNT(j)  (256  + 64 * (j))
#define XB_XSUB(j)  (1280 + 64 * (j))
#define XB_XGEN(j)  (2304 + 64 * (j))
#define XB_TOP      3328
#define XB_TOPGEN   3392
#define XCD_BAR_WORDS 3456
#define XB_SPIN_CAP (1u << 18)

__device__ __forceinline__ unsigned xb_ld(unsigned* p)              { return __hip_atomic_load(p, __ATOMIC_RELAXED, __HIP_MEMORY_SCOPE_AGENT); }
__device__ __forceinline__ unsigned xb_add(unsigned* p, unsigned v) { return __hip_atomic_fetch_add(p, v, __ATOMIC_RELAXED, __HIP_MEMORY_SCOPE_AGENT); }
__device__ __forceinline__ unsigned xb_xcc_id() { return (unsigned)__builtin_amdgcn_s_getreg((3 << 11) | 20) & 0xFu; }
#define XB_SPIN(cond, bar) do { unsigned _sp = 0; while (cond) { __builtin_amdgcn_s_sleep(1); \
    if ((++_sp & 255u) == 0u) { if (xb_ld(&(bar)[XB_TMO])) break; if (_sp > XB_SPIN_CAP) { atomicAdd(&(bar)[XB_TMO], 1u); break; } } } } while (0)

struct XcdBarrier {
    unsigned* bar; unsigned x;
    volatile LAS unsigned* st;
};

__device__ __forceinline__ XcdBarrier xcd_barrier_post(unsigned* bar, volatile LAS unsigned* st) {
    XcdBarrier b; b.bar = bar; b.x = xb_xcc_id(); b.st = st;
    if (threadIdx.x == 0) (void)xb_add(&bar[XB_XCNT(b.x)], 1u);
    return b;
}
__device__ __forceinline__ void xcd_barrier_complete(unsigned* bar, unsigned x, unsigned& nloc, unsigned& nx) {
    const unsigned G = gridDim.x * gridDim.y * gridDim.z;
    unsigned sum, cnt, mine, sp = 0u;
    for (;;) {
        sum = 0u; cnt = 0u; mine = 0u;
#pragma unroll
        for (unsigned j = 0; j < 16; ++j) { const unsigned c = xb_ld(&bar[XB_XCNT(j)]); sum += c; cnt += (c > 0u) ? 1u : 0u; mine = (j == x) ? c : mine; }
        if (sum == G) break;
        __builtin_amdgcn_s_sleep(1);
        if ((++sp & 255u) == 0u) { if (xb_ld(&bar[XB_TMO])) break; if (sp > XB_SPIN_CAP) { atomicAdd(&bar[XB_TMO], 1u); break; } }
    }
    nloc = mine > 0u ? mine : 1u; nx = cnt > 0u ? cnt : 1u;
}

__device__ __forceinline__ void xcd_barrier(const XcdBarrier& b) {
    asm volatile("s_waitcnt vmcnt(0)" ::: "memory");
    __syncthreads();
    if (threadIdx.x == 0) {
        unsigned* bar = b.bar;
        __builtin_amdgcn_s_waitcnt(0);
        unsigned nloc = b.st[0], nx = b.st[1];
        if (nloc == 0u) { xcd_barrier_complete(bar, b.x, nloc, nx); b.st[0] = nloc; b.st[1] = nx; }
        const unsigned old = xb_add(&bar[XB_XSUB(b.x)], 1u);
        const unsigned gen = old / nloc;
        if (old + 1u == (gen + 1u) * nloc) {
            __builtin_amdgcn_fence(__ATOMIC_RELEASE, "agent");
            asm volatile("s_waitcnt vmcnt(0)" ::: "memory");
            const unsigned og = xb_add(&bar[XB_TOP], 1u);
            const unsigned tg = og / nx;
            if (og + 1u == (tg + 1u) * nx) xb_add(&bar[XB_TOPGEN], 1u);
            else XB_SPIN(xb_ld(&bar[XB_TOPGEN]) == tg, bar);
            __builtin_amdgcn_fence(__ATOMIC_ACQUIRE, "agent");
            xb_add(&bar[XB_XGEN(b.x)], 1u);
            asm volatile("s_waitcnt vmcnt(0)" ::: "memory");
        } else {
            XB_SPIN(xb_ld(&bar[XB_XGEN(b.x)]) == gen, bar);
            __builtin_amdgcn_fence(__ATOMIC_ACQUIRE, "agent");
            asm volatile("s_waitcnt vmcnt(0)" ::: "memory");
        }
    }
    __syncthreads();
}

struct Args { const float* in[N_IN]; float* out; unsigned char* ws; int ph_lo, ph_hi; };
struct Ctx {
    LAS unsigned char* lds;
    const Args* a; float* out; unsigned char* ws;
    int tid, lane, wave, G, gw, ngw;
};
#define WSP(T, off) ((T*)(c.ws + (off)))

__device__ __forceinline__ f32x4 wave_tile16(const bf16* A, int lda, const bf16* Bt, int ldb, int K, int lane) {
    const bf16* ap = A + (size_t)(lane & 15) * lda + 8 * (lane >> 4);
    const bf16* bp = Bt + (size_t)(lane & 15) * ldb + 8 * (lane >> 4);
    f32x4 acc = {0.f, 0.f, 0.f, 0.f};
#pragma unroll 4
    for (int k = 0; k < K; k += 32) {
        const bf16x8 a = *(const bf16x8*)(ap + k), b = *(const bf16x8*)(bp + k);
        acc = __builtin_amdgcn_mfma_f32_16x16x32_bf16(b, a, acc, 0, 0, 0);
    }
    return acc;
}

__device__ __forceinline__ void transpose_tile(const float* W, int N, int k0, int n0, bf16* dst, int ldd, LAS float* scr, int lane) {
#pragma unroll 8
    for (int i = 0; i < 32; ++i) { const int kk = 2 * i + (lane >> 5); scr[kk * 33 + (lane & 31)] = W[(size_t)(k0 + kk) * N + n0 + (lane & 31)]; }
    LDS_WAIT(); asm volatile("" ::: "memory");
    const int cc = lane & 7;
#pragma unroll
    for (int j = 0; j < 4; ++j) { const int n = (lane >> 3) + 8 * j; const LAS float* s = scr + (8 * cc) * 33 + n;
        v4u o; o.x = pk2(s[0 * 33], s[1 * 33]); o.y = pk2(s[2 * 33], s[3 * 33]); o.z = pk2(s[4 * 33], s[5 * 33]); o.w = pk2(s[6 * 33], s[7 * 33]);
        *(v4u*)(dst + (size_t)n * ldd + 8 * cc) = o; }
    LDS_WAIT(); asm volatile("" ::: "memory");
}

constexpr int TI_WINE = (1024 / 64) * (2560 / 32), TI_WOUT = (1024 / 64) * (1024 / 32), TI_WINO = (1024 / 64) * (2080 / 32), TI_POOL = 4 * 2 * 4;
constexpr int TI_SMALL = TI_WINE + 2 * TI_WOUT + TI_WINO + TI_POOL;
constexpr int TI_GU = (1024 / 64) * (2816 / 32), TI_DN = (2816 / 64) * (1024 / 32);
constexpr int TI_PER_LE = 2 * TI_GU + TI_DN;
constexpr int TI_TOTAL = TI_SMALL + 32 * TI_PER_LE;

__device__ __forceinline__ void ph_prologue(const Ctx& c) {
    if (blockIdx.x < 192) {
        LAS float* sl = (LAS float*)c.lds;
        LAS float* red = sl + 3 * 1024;
        for (int i = c.tid; i < 3072; i += 512) { const int s = i >> 10, k = i & 1023; const float v = s < 2 ? c.a->in[I_C][s * 1024 + k] : c.a->in[I_CCTX][k]; sl[i] = silu(v); }
        __syncthreads();
        const int item = blockIdx.x, l = item / 96, j = 64 * (item % 96) + c.lane;
        const float* W = c.a->in[I_WMOD] + (size_t)l * 1024 * 6144 + j;
        float a0 = 0.f, a1 = 0.f, a2 = 0.f;
#pragma unroll 8
        for (int kk = 0; kk < 128; ++kk) { const int k = c.wave * 128 + kk; const float w = W[(size_t)k * 6144]; a0 += sl[k] * w; a1 += sl[1024 + k] * w; a2 += sl[2048 + k] * w; }
        red[(c.wave * 3 + 0) * 64 + c.lane] = a0; red[(c.wave * 3 + 1) * 64 + c.lane] = a1; red[(c.wave * 3 + 2) * 64 + c.lane] = a2;
        __syncthreads();
        if (c.wave < 3) { float s = 0.f;
#pragma unroll
            for (int w = 0; w < 8; ++w) s += red[(w * 3 + c.wave) * 64 + c.lane];
            WSP(float, WS_MOD)[(l * 3 + c.wave) * 6144 + j] = s + c.a->in[I_BMOD][l * 6144 + j]; }
        __syncthreads();
    }
    { const int g = blockIdx.x * 512 + c.tid;
      if (g < 192 * 16) { const int pos = g >> 4, f = g & 15; const float inv = powf(10000.0f, -(float)f / 16.0f); const float ang = (float)(pos < 128 ? pos : pos - 128) * inv;
          float sn, cs; sincosf(ang, &sn, &cs); float* T = WSP(float, WS_ROPE); T[g * 2] = cs; T[g * 2 + 1] = sn; } }
    LAS float* scr = (LAS float*)(c.lds + 16384 + c.wave * 12288);
    for (int it = c.gw; it < TI_TOTAL; it += c.ngw) {
        int r = it;
        if (r < TI_SMALL) {
            if (r < TI_WINE) { const int nb = 2560 / 32, kb = r / nb, n0 = 32 * (r % nb); transpose_tile(c.a->in[I_WINE], 2560, 64 * kb, n0, WSP(bf16, WS_WINE) + (size_t)n0 * 1024 + 64 * kb, 1024, scr, c.lane); continue; } r -= TI_WINE;
            if (r < TI_WOUT) { const int nb = 32, kb = r / nb, n0 = 32 * (r % nb); transpose_tile(c.a->in[I_WOUTE], 1024, 64 * kb, n0, WSP(bf16, WS_WOUTE) + (size_t)n0 * 1024 + 64 * kb, 1024, scr, c.lane); continue; } r -= TI_WOUT;
            if (r < TI_WOUT) { const int nb = 32, kb = r / nb, n0 = 32 * (r % nb); transpose_tile(c.a->in[I_WOUTO], 1024, 64 * kb, n0, WSP(bf16, WS_WOUTO) + (size_t)n0 * 1024 + 64 * kb, 1024, scr, c.lane); continue; } r -= TI_WOUT;
            if (r < TI_WINO) { const int nb = 2080 / 32, kb = r / nb, n0 = 32 * (r % nb); transpose_tile(c.a->in[I_WINO], 2080, 64 * kb, n0, WSP(bf16, WS_WINO) + (size_t)n0 * 1024 + 64 * kb, 1024, scr, c.lane); continue; } r -= TI_WINO;
            { const int g = r / 8, kb = (r % 8) / 4, n0 = 32 * (r % 4);
              transpose_tile(c.a->in[I_POOLW] + (size_t)g * 128 * 128, 128, 64 * kb, n0, WSP(bf16, WS_POOLW) + (size_t)g * 128 * 128 + (size_t)n0 * 128 + 64 * kb, 128, scr, c.lane); continue; }
        }
        r -= TI_SMALL;
        const int le = r / TI_PER_LE; int q = r % TI_PER_LE;
        if (q < 2 * TI_GU) { const int up = q / TI_GU; q %= TI_GU; const int nb = 2816 / 32, kb = q / nb, n0 = 32 * (q % nb);
            const int drow = (n0 / 128) * 256 + (n0 % 128) + up * 128;
            transpose_tile(c.a->in[up ? I_WU : I_WG] + (size_t)le * 1024 * 2816, 2816, 64 * kb, n0, WSP(bf16, WS_W1) + ((size_t)le * 5632 + drow) * 1024 + 64 * kb, 1024, scr, c.lane); }
        else { q -= 2 * TI_GU; const int nb = 32, kb = q / nb, n0 = 32 * (q % nb);
            transpose_tile(c.a->in[I_WD] + (size_t)le * 2816 * 1024, 1024, 64 * kb, n0, WSP(bf16, WS_W2) + ((size_t)le * 1024 + n0) * 2816 + 64 * kb, 2816, scr, c.lane); }
    }
}

__device__ __forceinline__ void adaln_row_store(const float (&x)[16], const float* g, const float* shift, const float* scale, bf16* orow, int lane) {
    float ss = 0.f;
#pragma unroll
    for (int i = 0; i < 16; ++i) ss += x[i] * x[i];
    const float rs = 1.0f / sqrtf(wave_sum(ss) * (1.0f / 1024.0f) + EPS);
#pragma unroll
    for (int i = 0; i < 16; ++i) { const int k = lane + 64 * i; orow[k] = (bf16)f2bf(x[i] * rs * g[k] * (1.0f + scale[k]) + shift[k]); }
}
__device__ __forceinline__ void ph_adaln0(const Ctx& c) {
    const float* g0 = c.a->in[I_NORMG];
    for (int m = c.gw; m < NTOK; m += c.ngw) {
        const float* xr = m < NLAT ? c.a->in[I_X] + (size_t)m * 1024 : c.a->in[I_CTX] + (size_t)(m - NLAT) * 1024;
        const int s = m < NLAT ? m / SEQ : 2;
        const float* mod = WSP(float, WS_MOD) + (size_t)s * 6144;
        float x[16];
#pragma unroll
        for (int i = 0; i < 16; ++i) x[i] = xr[c.lane + 64 * i];
        adaln_row_store(x, g0, mod, mod + 1024, WSP(bf16, WS_H) + (size_t)m * 1024, c.lane);
    }
}

__device__ __forceinline__ void ph_conv(const Ctx& c) {
    LAS bf16* glu = (LAS bf16*)c.lds;
    LAS float* yb = (LAS float*)(c.lds + 65536);
    const bf16* P = WSP(bf16, WS_PBUF);
    const int ch = c.tid;
    float w[31];
#pragma unroll
    for (int i = 0; i < 31; ++i) w[i] = c.a->in[I_CONVW][i * 512 + ch];
    const float cb = c.a->in[I_CONVB][ch];
    for (int item = blockIdx.x; item < NTOK / 32; item += c.G) {
        const int t0 = item * 32;
        int lo, hi; if (t0 < NLAT) { lo = (t0 / SEQ) * SEQ; hi = lo + SEQ; } else { lo = NLAT + ((t0 - NLAT) / CTXL) * CTXL; hi = lo + CTXL; }
        for (int i = c.tid; i < 62 * 64; i += 512) { const int rr = i >> 6, c8 = (i & 63) * 8, row = t0 - 15 + rr;
            v4u o = {0u, 0u, 0u, 0u};
            if (row >= lo && row < hi) { const v4u a = *(const v4u*)(P + (size_t)row * 2560 + c8), b = *(const v4u*)(P + (size_t)row * 2560 + 512 + c8);
                o.x = pk2(bflo(a.x) * sigmoidf(bflo(b.x)), bfhi(a.x) * sigmoidf(bfhi(b.x))); o.y = pk2(bflo(a.y) * sigmoidf(bflo(b.y)), bfhi(a.y) * sigmoidf(bfhi(b.y)));
                o.z = pk2(bflo(a.z) * sigmoidf(bflo(b.z)), bfhi(a.z) * sigmoidf(bfhi(b.z))); o.w = pk2(bflo(a.w) * sigmoidf(bflo(b.w)), bfhi(a.w) * sigmoidf(bfhi(b.w))); }
            *(LAS v4u*)(glu + rr * 512 + c8) = o; }
        __syncthreads();
        float acc[32];
#pragma unroll
        for (int t = 0; t < 32; ++t) acc[t] = cb;
#pragma unroll
        for (int rr = 0; rr < 62; ++rr) { const float gv = bf2f(glu[rr * 512 + ch]);
#pragma unroll
            for (int t = 0; t < 32; ++t) if (rr - t >= 0 && rr - t <= 30) acc[t] += gv * w[rr - t]; }
#pragma unroll
        for (int t = 0; t < 32; ++t) yb[t * 512 + ch] = acc[t];
        __syncthreads();
#pragma unroll
        for (int tt = 0; tt < 4; ++tt) { const int t = c.wave * 4 + tt;
            const f32x4 v0 = *(const LAS f32x4*)(yb + t * 512 + 8 * c.lane), v1 = *(const LAS f32x4*)(yb + t * 512 + 8 * c.lane + 4);
            const float mu = wave_sum((v0[0] + v0[1]) + (v0[2] + v0[3]) + (v1[0] + v1[1]) + (v1[2] + v1[3])) * (1.0f / 512.0f);
            float q = 0.f; float d[8];
#pragma unroll
            for (int j = 0; j < 4; ++j) { d[j] = v0[j] - mu; d[4 + j] = v1[j] - mu; }
#pragma unroll
            for (int j = 0; j < 8; ++j) q += d[j] * d[j];
            const float rstd = 1.0f / sqrtf(wave_sum(q) * (1.0f / 512.0f) + EPS);
            float o[8];
#pragma unroll
            for (int j = 0; j < 8; ++j) { const int k = 8 * c.lane + j; o[j] = silu(d[j] * rstd * c.a->in[I_CLNG][k] + c.a->in[I_CLNB][k]); }
            v4u pk; pk.x = pk2(o[0], o[1]); pk.y = pk2(o[2], o[3]); pk.z = pk2(o[4], o[5]); pk.w = pk2(o[6], o[7]);
            *(v4u*)(WSP(bf16, WS_MIX) + (size_t)(t0 + t) * 1024 + 8 * c.lane) = pk; }
        __syncthreads();
    }
}

__device__ __forceinline__ void ph_na_naive(const Ctx& c) {
    const bf16* P = WSP(bf16, WS_PBUF);
    const int qc = c.tid & 63, h = c.tid >> 6;
    for (int item = blockIdx.x; item < 256 + 8; item += c.G) {
        int b, r = 0, m; const bool lat = item < 256;
        if (lat) { b = item >> 7; r = item & 127; m = b * SEQ + r * 64 + qc; } else { const int ci = item - 256; b = ci >> 2; m = NLAT + b * CTXL + (ci & 3) * 64 + qc; }
        float q[64], o[64];
        { const bf16* qp = P + (size_t)m * 2560 + 1024 + h * 64;
#pragma unroll
          for (int d = 0; d < 64; d += 8) { const v4u a = *(const v4u*)(qp + d); q[d] = bflo(a.x) * 0.125f; q[d + 1] = bfhi(a.x) * 0.125f; q[d + 2] = bflo(a.y) * 0.125f; q[d + 3] = bfhi(a.y) * 0.125f;
              q[d + 4] = bflo(a.z) * 0.125f; q[d + 5] = bfhi(a.z) * 0.125f; q[d + 6] = bflo(a.w) * 0.125f; q[d + 7] = bfhi(a.w) * 0.125f; } }
#pragma unroll
        for (int d = 0; d < 64; ++d) o[d] = 0.f;
        float mx = -1e30f, l = 0.f;
        const int rs = lat ? min(max(r - 4, 0), 120) : 0, cs = min(max(qc - 8, 0), 48);
        const int nwin = lat ? 128 : 0;
        for (int kk = 0; kk < nwin + 256; ++kk) {
            int tok; float bias = 0.f;
            if (kk < nwin) { const int i = kk >> 4, j = kk & 15; tok = b * SEQ + (rs + i) * 64 + cs + j; bias = c.a->in[I_RPB][(h * 15 + (rs + i - r + 7)) * 31 + (cs + j - qc + 15)]; }
            else tok = NLAT + b * CTXL + (kk - nwin);
            const bf16* kp = P + (size_t)tok * 2560 + 1536 + h * 64; const bf16* vp = kp + 512;
            float s = 0.f;
#pragma unroll
            for (int d = 0; d < 64; d += 8) { const v4u a = *(const v4u*)(kp + d);
                s += q[d] * bflo(a.x) + q[d + 1] * bfhi(a.x) + q[d + 2] * bflo(a.y) + q[d + 3] * bfhi(a.y) + q[d + 4] * bflo(a.z) + q[d + 5] * bfhi(a.z) + q[d + 6] * bflo(a.w) + q[d + 7] * bfhi(a.w); }
            s += bias;
            const float mn = fmaxf(mx, s), al = __expf(mx - mn), p = __expf(s - mn);
            l = l * al + p; mx = mn;
#pragma unroll
            for (int d = 0; d < 64; d += 8) { const v4u a = *(const v4u*)(vp + d);
                o[d] = o[d] * al + p * bflo(a.x); o[d + 1] = o[d + 1] * al + p * bfhi(a.x); o[d + 2] = o[d + 2] * al + p * bflo(a.y); o[d + 3] = o[d + 3] * al + p * bfhi(a.y);
                o[d + 4] = o[d + 4] * al + p * bflo(a.z); o[d + 5] = o[d + 5] * al + p * bfhi(a.z); o[d + 6] = o[d + 6] * al + p * bflo(a.w); o[d + 7] = o[d + 7] * al + p * bfhi(a.w); }
        }
        const float il = 1.0f / l;
        bf16* op = WSP(bf16, WS_MIX) + (size_t)m * 1024 + 512 + h * 64;
#pragma unroll
        for (int d = 0; d < 64; d += 8) { v4u pk; pk.x = pk2(o[d] * il, o[d + 1] * il); pk.y = pk2(o[d + 2] * il, o[d + 3] * il); pk.z = pk2(o[d + 4] * il, o[d + 5] * il); pk.w = pk2(o[d + 6] * il, o[d + 7] * il);
            *(v4u*)(op + d) = pk; }
    }
}

__device__ __forceinline__ void ph_outproj_ctx_tiles(const Ctx& c, size_t ws_wout) {
    for (int t = c.gw; t < 32 * 64; t += c.ngw) { const int mt = t >> 6, nt = t & 63;
        const f32x4 a = wave_tile16(WSP(bf16, WS_MIX) + (size_t)(NLAT + 16 * mt) * 1024, 1024, WSP(bf16, ws_wout) + (size_t)(16 * nt) * 1024, 1024, 1024, c.lane);
        v2u pk; pk.x = pk2(a[0], a[1]); pk.y = pk2(a[2], a[3]);
        *(v2u*)(WSP(bf16, WS_YO) + (size_t)(NLAT + 16 * mt + (c.lane & 15)) * 1024 + 16 * nt + 4 * (c.lane >> 4)) = pk; }
}
__device__ __forceinline__ void ph_inproj_odd_tiles(const Ctx& c) {
    const bf16* H = WSP(bf16, WS_H); const bf16* W = WSP(bf16, WS_WINO);
    for (int t = c.gw; t < 2048 + 32 * 48 + 64; t += c.ngw) {
        if (t < 2048) { const int mt = t >> 1, nt = t & 1;
            const f32x4 a = wave_tile16(H + (size_t)(16 * mt) * 1024, 1024, W + (size_t)(2048 + 16 * nt) * 1024, 1024, 1024, c.lane);
            *(f32x4*)(WSP(float, WS_LR) + (size_t)(16 * mt + (c.lane & 15)) * 32 + 16 * nt + 4 * (c.lane >> 4)) = a; }
        else if (t < 2048 + 32 * 48) { const int u = t - 2048, mt = u / 48, nt = u % 48;
            const f32x4 a = wave_tile16(H + (size_t)(NLAT + 16 * mt) * 1024, 1024, W + (size_t)(768 + 16 * nt) * 1024, 1024, 1024, c.lane);
            v2u pk; pk.x = pk2(a[0], a[1]); pk.y = pk2(a[2], a[3]);
            *(v2u*)(WSP(bf16, WS_PBUF) + (size_t)(NLAT + 16 * mt + (c.lane & 15)) * 2048 + 768 + 16 * nt + 4 * (c.lane >> 4)) = pk; }
        else { const int u = t - 2048 - 32 * 48, mt = u >> 1, nt = u & 1;
            const f32x4 a = wave_tile16(H + (size_t)(NLAT + 16 * mt) * 1024, 1024, W + (size_t)(2048 + 16 * nt) * 1024, 1024, 1024, c.lane);
            *(f32x4*)(WSP(float, WS_LR) + (size_t)(NLAT + 16 * mt + (c.lane & 15)) * 32 + 16 * nt + 4 * (c.lane >> 4)) = a; }
    }
}
__device__ __forceinline__ void ph_pool_tiles(const Ctx& c) {
    for (int t = c.gw; t < 1024 * 32; t += c.ngw) { const int mt = t >> 5, g = (t >> 3) & 3, et = t & 7;
        const f32x4 a = wave_tile16(WSP(bf16, WS_DPOOL) + (size_t)(16 * mt) * 512 + g * 128, 512, WSP(bf16, WS_POOLW) + (size_t)g * 128 * 128 + (size_t)(16 * et) * 128, 128, 128, c.lane);
        const int col = g * 128 + 16 * et + 4 * (c.lane >> 4); const float* sc = c.a->in[I_POOLS] + col;
        v2u pk; pk.x = pk2(a[0] * sc[0], a[1] * sc[1]); pk.y = pk2(a[2] * sc[2], a[3] * sc[3]);
        *(v2u*)(WSP(bf16, WS_MIX) + (size_t)(16 * mt + (c.lane & 15)) * 1024 + col) = pk; }
}

__device__ __forceinline__ void ph_post(const Ctx& c, int layer, int nrows) {
    LAS float* rw = (LAS float*)c.lds;
    { const float* R = c.a->in[I_ROUTER] + (size_t)layer * 1024 * 16;
      for (int i = c.tid; i < 1024 * 16; i += 512) rw[(i >> 4) * 20 + (i & 15)] = R[i]; }
    __syncthreads();
    const float* ng = c.a->in[I_NORMG] + (size_t)layer * 4 * 1024;
    for (int m = c.gw; m < nrows; m += c.ngw) {
        const int s = m < NLAT ? m / SEQ : 2;
        const float* mod = WSP(float, WS_MOD) + (size_t)(layer * 3 + s) * 6144;
        const float* xin = layer == 0 ? (m < NLAT ? c.a->in[I_X] + (size_t)m * 1024 : c.a->in[I_CTX] + (size_t)(m - NLAT) * 1024) : WSP(float, WS_X1) + (size_t)m * 1024;
        const bf16* yr = WSP(bf16, WS_YO) + (size_t)m * 1024;
        float x[16]; float ss = 0.f;
#pragma unroll
        for (int i = 0; i < 16; ++i) { x[i] = bf2f(yr[c.lane + 64 * i]); ss += x[i] * x[i]; }
        const float ry = 1.0f / sqrtf(wave_sum(ss) * (1.0f / 1024.0f) + EPS);
        float s1 = 0.f;
#pragma unroll
        for (int i = 0; i < 16; ++i) { const int k = c.lane + 64 * i; x[i] = xin[k] + mod[2048 + k] * (x[i] * ry * ng[1024 + k]); s1 += x[i] * x[i]; }
        float* x1r = WSP(float, WS_X1) + (size_t)m * 1024;
#pragma unroll
        for (int i = 0; i < 16; ++i) x1r[c.lane + 64 * i] = x[i];
        const float r1 = 1.0f / sqrtf(wave_sum(s1) * (1.0f / 1024.0f) + EPS);
        bf16* xo = WSP(bf16, WS_XN2) + (size_t)m * 1024;
#pragma unroll
        for (int i = 0; i < 16; ++i) { const int k = c.lane + 64 * i; x[i] = x[i] * r1 * ng[2048 + k] * (1.0f + mod[4 * 1024 + k]) + mod[3 * 1024 + k]; xo[k] = (bf16)f2bf(x[i]); }
        float lg[16];
#pragma unroll
        for (int e = 0; e < 16; ++e) lg[e] = 0.f;
#pragma unroll
        for (int i = 0; i < 16; ++i) { const int k = c.lane + 64 * i; const float xn = x[i];
            const LAS f32x4* wr = (const LAS f32x4*)(rw + k * 20);
            const f32x4 w0 = wr[0], w1 = wr[1], w2 = wr[2], w3 = wr[3];
#pragma unroll
            for (int j = 0; j < 4; ++j) { lg[j] += xn * w0[j]; lg[4 + j] += xn * w1[j]; lg[8 + j] += xn * w2[j]; lg[12 + j] += xn * w3[j]; }
            if (i & 1) asm volatile("" ::: "memory"); }
        float mx = -1e30f;
#pragma unroll
        for (int e = 0; e < 16; ++e) { lg[e] = wave_sum(lg[e]); mx = fmaxf(mx, lg[e]); }
        float den = 0.f;
#pragma unroll
        for (int e = 0; e < 16; ++e) { lg[e] = expf(lg[e] - mx); den += lg[e]; }
        float mine = 0.f;
#pragma unroll
        for (int e = 0; e < 16; ++e) mine = (c.lane == e) ? lg[e] : mine;
        if (c.lane < 16) WSP(float, WS_AFF)[(size_t)m * 16 + c.lane] = mine / den;
    }
    __syncthreads();
}

__device__ __forceinline__ void ph_topk(const Ctx& c, int nlists) {
    LAS unsigned* keys = (LAS unsigned*)c.lds;
    LAS int* hist = (LAS int*)(c.lds + 32768);
    LAS int* cg = (LAS int*)(c.lds + 32768 + 1024);
    LAS int* ce = cg + 512;
    LAS unsigned* ctl = (LAS unsigned*)(ce + 512);
    const float* aff = WSP(float, WS_AFF); int* inv = WSP(int, WS_INV); int* rowtok = WSP(int, WS_ROWTOK);
    for (int lid = blockIdx.x; lid < nlists; lid += c.G) {
        int n, cap, tok0, rowbase, e;
        if (lid < 32) { const int b = lid >> 4; e = lid & 15; n = SEQ; cap = 1024; tok0 = b * SEQ; rowbase = e * 2048 + b * 1024; }
        else { const int b = (lid - 32) >> 4; e = lid & 15; n = CTXL; cap = 32; tok0 = NLAT + b * CTXL; rowbase = MOE_LAT + e * 256 + b * 32; }
        const int cpt = n / 512 > 0 ? n / 512 : 1;
        for (int i = c.tid; i < n; i += 512) keys[i] = __builtin_bit_cast(unsigned, aff[(size_t)(tok0 + i) * 16 + e]);
        if (c.tid == 0) { ctl[0] = 0u; ctl[1] = (unsigned)cap; }
        __syncthreads();
        for (int pass = 0; pass < 4; ++pass) {
            const int shift = 24 - 8 * pass;
            if (c.tid < 256) hist[c.tid] = 0;
            __syncthreads();
            const unsigned prefix = ctl[0];
            for (int i = c.tid; i < n; i += 512) { const unsigned k = keys[i]; if (pass == 0 || (k >> (shift + 8)) == prefix) __hip_atomic_fetch_add(&hist[(k >> shift) & 255u], 1, __ATOMIC_RELAXED, __HIP_MEMORY_SCOPE_WORKGROUP); }
            __syncthreads();
            if (c.tid == 0) { int kth = (int)ctl[1], cum = 0, sel = 0;
                for (int bin = 255; bin >= 0; --bin) { const int h = hist[bin]; if (cum + h >= kth) { sel = bin; kth -= cum; break; } cum += h; }
                ctl[0] = (prefix << 8) | (unsigned)sel; ctl[1] = (unsigned)kth; }
            __syncthreads();
        }
        const unsigned T = ctl[0]; const int need_eq = (int)ctl[1]; const int ngt = cap - need_eq;
        { int g = 0, q = 0;
          for (int j = 0; j < cpt; ++j) { const int i = c.tid * cpt + j; if (i < n) { const unsigned k = keys[i]; g += (k > T); q += (k == T); } }
          cg[c.tid] = g; ce[c.tid] = q; }
        __syncthreads();
        if (c.wave == 0) {
            int g[8], q[8], sg = 0, sq = 0;
#pragma unroll
            for (int j = 0; j < 8; ++j) { g[j] = cg[c.lane * 8 + j]; q[j] = ce[c.lane * 8 + j]; sg += g[j]; sq += q[j]; }
            int ig = sg, iq = sq;
#pragma unroll
            for (int o = 1; o < 64; o <<= 1) { const int tg = __shfl_up(ig, o), tq = __shfl_up(iq, o); if (c.lane >= o) { ig += tg; iq += tq; } }
            int eg = ig - sg, eq = iq - sq;
#pragma unroll
            for (int j = 0; j < 8; ++j) { cg[c.lane * 8 + j] = eg; ce[c.lane * 8 + j] = eq; eg += g[j]; eq += q[j]; }
        }
        __syncthreads();
        { int g = cg[c.tid], q = ce[c.tid];
          for (int j = 0; j < cpt; ++j) { const int i = c.tid * cpt + j; if (i < n) { const unsigned k = keys[i]; int row = -1;
              if (k > T) { row = rowbase + g; ++g; } else if (k == T) { if (q < need_eq) row = rowbase + ngt + q; ++q; }
              inv[(size_t)(tok0 + i) * 16 + e] = row; if (row >= 0) rowtok[row] = tok0 + i; } } }
        if (lid >= 32 && lid < 48) { for (int i = 64 + c.tid; i < 256; i += 512) rowtok[MOE_LAT + e * 256 + i] = -1; }
        __syncthreads();
    }
}

__device__ __forceinline__ void ph_gather(const Ctx& c, int nrows) {
    const int* rowtok = WSP(int, WS_ROWTOK);
    for (int r = c.gw; r < nrows; r += c.ngw) {
        const int tok = rowtok[r];
        v4u a = {0u, 0u, 0u, 0u}, b = a;
        if (tok >= 0) { const v4u* src = (const v4u*)(WSP(bf16, WS_XN2) + (size_t)tok * 1024); a = src[c.lane]; b = src[64 + c.lane]; }
        v4u* dst = (v4u*)(WSP(bf16, WS_XG) + (size_t)r * 1024); dst[c.lane] = a; dst[64 + c.lane] = b;
    }
}

__device__ __forceinline__ void ph_combine(const Ctx& c, int layer, int nrows) {
    const float* ng = c.a->in[I_NORMG] + (size_t)layer * 4 * 1024;
    for (int m = c.gw; m < nrows; m += c.ngw) {
        const int s = m < NLAT ? m / SEQ : 2;
        const float* mod = WSP(float, WS_MOD) + (size_t)(layer * 3 + s) * 6144;
        const int myinv = c.lane < 16 ? WSP(int, WS_INV)[(size_t)m * 16 + c.lane] : -1;
        const float myaff = c.lane < 16 ? WSP(float, WS_AFF)[(size_t)m * 16 + c.lane] : 0.f;
        float f[16];
#pragma unroll
        for (int i = 0; i < 16; ++i) f[i] = 0.f;
        for (int e = 0; e < 16; ++e) {
            const int row = __shfl(myinv, e); const float a = __shfl(myaff, e);
            if (row >= 0) { const v4u* src = (const v4u*)(WSP(bf16, WS_Y) + (size_t)row * 1024);
#pragma unroll
                for (int j = 0; j < 2; ++j) { const v4u v = src[c.lane + 64 * j];
                    f[8 * j + 0] += a * bflo(v.x); f[8 * j + 1] += a * bfhi(v.x); f[8 * j + 2] += a * bflo(v.y); f[8 * j + 3] += a * bfhi(v.y);
                    f[8 * j + 4] += a * bflo(v.z); f[8 * j + 5] += a * bfhi(v.z); f[8 * j + 6] += a * bflo(v.w); f[8 * j + 7] += a * bfhi(v.w); } }
        }
        float ss = 0.f;
#pragma unroll
        for (int i = 0; i < 16; ++i) ss += f[i] * f[i];
        const float rf = 1.0f / sqrtf(wave_sum(ss) * (1.0f / 1024.0f) + EPS);
        float* x1r = WSP(float, WS_X1) + (size_t)m * 1024;
        float x[16]; float s2 = 0.f;
#pragma unroll
        for (int j = 0; j < 2; ++j)
#pragma unroll
            for (int i = 0; i < 8; ++i) { const int k = 8 * c.lane + 512 * j + i; x[8 * j + i] = x1r[k] + mod[5 * 1024 + k] * (f[8 * j + i] * rf * ng[3 * 1024 + k]); s2 += x[8 * j + i] * x[8 * j + i]; }
        if (layer == 0) {
            const float r2 = 1.0f / sqrtf(wave_sum(s2) * (1.0f / 1024.0f) + EPS);
            const float* ng1 = c.a->in[I_NORMG] + (size_t)4 * 1024;
            const float* mod1 = WSP(float, WS_MOD) + (size_t)(3 + s) * 6144;
            bf16* ho = WSP(bf16, WS_H) + (size_t)m * 1024;
#pragma unroll
            for (int j = 0; j < 2; ++j) { float o[8];
#pragma unroll
                for (int i = 0; i < 8; ++i) { const int k = 8 * c.lane + 512 * j + i; x1r[k] = x[8 * j + i]; o[i] = x[8 * j + i] * r2 * ng1[k] * (1.0f + mod1[1024 + k]) + mod1[k]; }
                v4u pk; pk.x = pk2(o[0], o[1]); pk.y = pk2(o[2], o[3]); pk.z = pk2(o[4], o[5]); pk.w = pk2(o[6], o[7]);
                *(v4u*)(ho + 8 * c.lane + 512 * j) = pk; }
        } else {
            float* orow = c.out + (size_t)m * 1024;
#pragma unroll
            for (int j = 0; j < 2; ++j)
#pragma unroll
                for (int i = 0; i < 8; ++i) orow[8 * c.lane + 512 * j + i] = x[8 * j + i];
        }
    }
}

__device__ __forceinline__ void ph_prep_odd(const Ctx& c) {
    const bf16* P = WSP(bf16, WS_PBUF);
    for (int it = blockIdx.x * 512 + c.tid; it < NLAT * 64; it += c.G * 512) {
        const int m = it >> 6, c8 = (it & 63) * 8, t = m & (SEQ - 1), b0 = m - t;
        const int win = 2 << (c8 >> 7), lo = max(t - win / 2, 0), hi = min(t + win / 2, SEQ);
        float sum[8];
#pragma unroll
        for (int j = 0; j < 8; ++j) sum[j] = 0.f;
        for (int tt = lo; tt < hi; ++tt) { const v4u a = *(const v4u*)(P + (size_t)(b0 + tt) * 2048 + c8);
            sum[0] += bflo(a.x); sum[1] += bfhi(a.x); sum[2] += bflo(a.y); sum[3] += bfhi(a.y); sum[4] += bflo(a.z); sum[5] += bfhi(a.z); sum[6] += bflo(a.w); sum[7] += bfhi(a.w); }
        const v4u a = *(const v4u*)(P + (size_t)m * 2048 + c8); const float inv = 1.0f / (float)(hi - lo);
        v4u o; o.x = pk2(sum[0] * inv - bflo(a.x), sum[1] * inv - bfhi(a.x)); o.y = pk2(sum[2] * inv - bflo(a.y), sum[3] * inv - bfhi(a.y));
        o.z = pk2(sum[4] * inv - bflo(a.z), sum[5] * inv - bfhi(a.z)); o.w = pk2(sum[6] * inv - bflo(a.w), sum[7] * inv - bfhi(a.w));
        *(v4u*)(WSP(bf16, WS_DPOOL) + (size_t)m * 512 + c8) = o;
    }
    const int hd = c.tid & 255, d = hd & 63;
    float gw0[16], gw1[16];
#pragma unroll
    for (int r = 0; r < 16; ++r) { gw0[r] = c.a->in[I_GATEW][r * 256 + hd]; gw1[r] = c.a->in[I_GATEW][(16 + r) * 256 + hd]; }
    const float gb0 = c.a->in[I_GATEB][hd], gb1 = c.a->in[I_GATEB][256 + hd];
    const float* rope = WSP(float, WS_ROPE);
    for (int m = blockIdx.x * 2 + (c.tid >> 8); m < NTOK; m += c.G * 2) {
        const float* lr = WSP(float, WS_LR) + (size_t)m * 32;
        float z0 = gb0, z1 = gb1;
#pragma unroll
        for (int r = 0; r < 16; ++r) { z0 += lr[r] * gw0[r]; z1 += lr[16 + r] * gw1[r]; }
        const float l0 = fminf(z0, 0.f) - log1pf(expf(-fabsf(z0))), l1 = fminf(z1, 0.f) - log1pf(expf(-fabsf(z1)));
        WSP(float, WS_GF)[(size_t)m * 256 + hd] = l0 * (1.0f / 16.0f); WSP(float, WS_GB)[(size_t)m * 256 + hd] = l1 * (1.0f / 16.0f);
        const bf16* pr = P + (size_t)m * 2048;
        if (m < NLAT) {
            const int t = m & (SEQ - 1), pos = (d & 32) ? 128 + (t & 63) : (t >> 6), f = d & 15;
            const float cs = rope[(pos * 16 + f) * 2], sn = rope[(pos * 16 + f) * 2 + 1];
            const int d1 = hd & ~16, d2 = hd | 16;
            const float q1 = bf2f(pr[512 + d1]), q2 = bf2f(pr[512 + d2]), k1 = bf2f(pr[768 + d1]), k2 = bf2f(pr[768 + d2]);
            const bool second = (d & 16) != 0;
            WSP(float, WS_QR)[(size_t)m * 256 + hd] = (second ? q1 * sn + q2 * cs : q1 * cs - q2 * sn) * 0.125f;
            WSP(float, WS_KR)[(size_t)m * 256 + hd] = second ? k1 * sn + k2 * cs : k1 * cs - k2 * sn;
        } else WSP(float, WS_KR)[(size_t)m * 256 + hd] = bf2f(pr[768 + hd]);
    }
}

__device__ __forceinline__ void ph_gla_naive(const Ctx& c) {
    const bf16* P = WSP(bf16, WS_PBUF);
    for (int item = blockIdx.x; item < 256; item += c.G) {
        const int es = item & 15, dir = (item >> 4) & 1, h = (item >> 5) & 3, b = item >> 7;
        const int e = es * 8 + c.wave, d = c.lane;
        const float* G = dir ? WSP(float, WS_GB) : WSP(float, WS_GF);
        float* O = WSP(float, WS_OACC) + (size_t)dir * NLAT * 512;
        float S = 0.f;
        for (int blk = 0; blk < (CTXL + SEQ) / 8; ++blk) {
            float gg[8], kk[8], vv[8], qq[8]; int mm[8];
#pragma unroll
            for (int j = 0; j < 8; ++j) { const int step = blk * 8 + j; int m;
                if (step < CTXL) m = NLAT + b * CTXL + (dir ? CTXL - 1 - step : step); else { const int t = step - CTXL; m = b * SEQ + (dir ? SEQ - 1 - t : t); }
                mm[j] = m; gg[j] = G[(size_t)m * 256 + h * 64 + d]; kk[j] = WSP(float, WS_KR)[(size_t)m * 256 + h * 64 + d]; vv[j] = bf2f(P[(size_t)m * 2048 + 1024 + h * 128 + e]);
                qq[j] = m < NLAT ? WSP(float, WS_QR)[(size_t)m * 256 + h * 64 + d] : 0.f; }
#pragma unroll
            for (int j = 0; j < 8; ++j) { S = expf(gg[j]) * S + kk[j] * vv[j];
                if (blk >= CTXL / 8) { const float o = wave_sum(qq[j] * S); if (c.lane == 0) O[(size_t)mm[j] * 512 + h * 128 + e] = o; } }
        }
    }
}
__device__ __forceinline__ void ph_gla_out(const Ctx& c) {
    for (int m = c.gw; m < NLAT; m += c.ngw) {
        const float* o0 = WSP(float, WS_OACC) + (size_t)m * 512 + 8 * c.lane; const float* o1 = o0 + (size_t)NLAT * 512;
        float o[8]; float ss = 0.f;
#pragma unroll
        for (int j = 0; j < 8; ++j) { o[j] = o0[j] + o1[j]; ss += o[j] * o[j]; }
        ss += __shfl_xor(ss, 1); ss += __shfl_xor(ss, 2); ss += __shfl_xor(ss, 4); ss += __shfl_xor(ss, 8);
        const float rn = 1.0f / sqrtf(ss * (1.0f / 128.0f) + EPS);
        const v4u rr = *(const v4u*)(WSP(bf16, WS_PBUF) + (size_t)m * 2048 + 1536 + 8 * c.lane);
        const float r[8] = {bflo(rr.x), bfhi(rr.x), bflo(rr.y), bfhi(rr.y), bflo(rr.z), bfhi(rr.z), bflo(rr.w), bfhi(rr.w)};
        float v[8];
#pragma unroll
        for (int j = 0; j < 8; ++j) v[j] = o[j] * rn * c.a->in[I_HEADG][8 * c.lane + j] * silu(r[j]);
        v4u pk; pk.x = pk2(v[0], v[1]); pk.y = pk2(v[2], v[3]); pk.z = pk2(v[4], v[5]); pk.w = pk2(v[6], v[7]);
        *(v4u*)(WSP(bf16, WS_MIX) + (size_t)m * 1024 + 512 + 8 * c.lane) = pk;
    }
}

#ifndef MK_ONE_LAUNCH
#define MK_ONE_LAUNCH 0
#endif
constexpr int NPH = 22;
#define MKCTX() Ctx c; c.lds = lds; c.a = a; c.out = a->out; c.ws = a->ws; c.tid = threadIdx.x; c.lane = c.tid & 63; c.wave = __builtin_amdgcn_readfirstlane(c.tid >> 6); c.G = gridDim.x; \
    c.gw = blockIdx.x * NWAVES + c.wave; c.ngw = c.G * NWAVES
__device__ __forceinline__ void P_prologue(LAS unsigned char* lds, const Args* a) { MKCTX(); ph_prologue(c); }
__device__ __forceinline__ void P_adaln0(LAS unsigned char* lds, const Args* a) { MKCTX(); ph_adaln0(c); }
__device__ __forceinline__ void P_conv(LAS unsigned char* lds, const Args* a) { MKCTX(); ph_conv(c); }
__device__ __forceinline__ void P_na(LAS unsigned char* lds, const Args* a) { MKCTX(); ph_na_naive(c); }
__device__ __forceinline__ void P_outproj_ctx(LAS unsigned char* lds, const Args* a) { MKCTX(); ph_outproj_ctx_tiles(c, WS_WOUTE); }
__device__ __forceinline__ void P_inproj_odd_tiles(LAS unsigned char* lds, const Args* a) { MKCTX(); ph_inproj_odd_tiles(c); }
__device__ __forceinline__ void P_prep_odd(LAS unsigned char* lds, const Args* a) { MKCTX(); ph_prep_odd(c); }
__device__ __forceinline__ void P_pool(LAS unsigned char* lds, const Args* a) { MKCTX(); ph_pool_tiles(c); }
__device__ __forceinline__ void P_gla_naive(LAS unsigned char* lds, const Args* a) { MKCTX(); ph_gla_naive(c); }
__device__ __forceinline__ void P_gla_out(LAS unsigned char* lds, const Args* a) { MKCTX(); ph_gla_out(c); }
__device__ __forceinline__ void P_post(LAS unsigned char* lds, const Args* a, int layer, int ntok) { MKCTX(); ph_post(c, layer, ntok); }
__device__ __forceinline__ void P_topk(LAS unsigned char* lds, const Args* a, int nlists) { MKCTX(); ph_topk(c, nlists); }
__device__ __forceinline__ void P_gather(LAS unsigned char* lds, const Args* a, int nrows) { MKCTX(); ph_gather(c, nrows); }
__device__ __forceinline__ void P_combine(LAS unsigned char* lds, const Args* a, int layer, int ntok) { MKCTX(); ph_combine(c, layer, ntok); }
__device__ __forceinline__ void P_gemm_bf16(LAS unsigned char* lds, const bf16* A, const bf16* Bt, bf16* O, int K, int nM, int nN, int ldc, int moe) {
    pg8::Gemm g{A, Bt, K}; pg8::Order S; S.init(nM, nN, (int)gridDim.x, (int)blockIdx.x, moe);
    pg8::EpiBf16 E{O, ldc}; pg8::gemm_phase<pg8::EpiBf16, pg8::Order, PG8_ALIGN, PG8_SP2>(lds, g, S, E);
}
__device__ __forceinline__ void P_gemm_swiglu(LAS unsigned char* lds, const bf16* A, const bf16* Bt, bf16* O, int K, int nM, int nN, int ldc) {
    pg8::Gemm g{A, Bt, K}; pg8::Order S; S.init(nM, nN, (int)gridDim.x, (int)blockIdx.x, 1);
    pg8::EpiSwiglu E{O, ldc}; pg8::gemm_phase<pg8::EpiSwiglu, pg8::Order, PG8_ALIGN, PG8_SP2>(lds, g, S, E);
}

__global__ void __launch_bounds__(NWAVES * 64, 2) fwd(Args args) {
    extern __shared__ __attribute__((aligned(16))) unsigned char lds_raw[];
    LAS unsigned char* lds = (LAS unsigned char*)lds_raw;
    const Args* a = &args;
    unsigned char* ws = args.ws;
    const int tid = threadIdx.x;
    volatile LAS unsigned* MISC = (volatile LAS unsigned*)(lds + MISC_OFF);
    for (int u = tid; u < (LDS_BYTES - LDSCTL_OFF) / 4; u += NWAVES * 64) ((LAS unsigned*)(lds + LDSCTL_OFF))[u] = 0u;
    __syncthreads();
    const int lo = args.ph_lo, hi = args.ph_hi;
    XcdBarrier bar; bar.bar = (unsigned*)(ws + WS_CTL) + CW_BAR; bar.x = 0; bar.st = nullptr;
    if (hi - lo > 1) bar = xcd_barrier_post((unsigned*)(ws + WS_CTL) + CW_BAR, MISC + 8);
#define IN(k) (lo <= (k) && (k) < hi)
#define SEAM(k) do { if (IN(k) && IN((k) + 1)) xcd_barrier(bar); } while (0)
#define WP(off) ((bf16*)(ws + (off)))
    if (IN(0)) { P_prologue(lds, a); } SEAM(0);
    if (IN(1)) { P_adaln0(lds, a); } SEAM(1);
    if (IN(2)) { P_gemm_bf16(lds, WP(WS_H), WP(WS_WINE), WP(WS_PBUF), 1024, NTOK / 256, EVEN_IN / 256, EVEN_IN, 0); } SEAM(2);
    if (IN(3)) { P_conv(lds, a); P_na(lds, a); } SEAM(3);
    if (IN(4)) { P_gemm_bf16(lds, WP(WS_MIX), WP(WS_WOUTE), WP(WS_YO), 1024, NLAT / 256, 4, 1024, 0); P_outproj_ctx(lds, a); } SEAM(4);
#define COMMON(layer, p0, ntok, nlists, nrows) \
    if (IN(p0 + 0)) { P_post(lds, a, layer, ntok); } SEAM(p0 + 0); \
    if (IN(p0 + 1)) { P_topk(lds, a, nlists); } SEAM(p0 + 1); \
    if (IN(p0 + 2)) { P_gather(lds, a, nrows); } SEAM(p0 + 2); \
    if (IN(p0 + 3)) { P_gemm_swiglu(lds, WP(WS_XG), WP(WS_W1) + (size_t)layer * 16 * 5632 * 1024, WP(WS_HID), 1024, (nrows) / 256, 22, FF); } SEAM(p0 + 3); \
    if (IN(p0 + 4)) { P_gemm_bf16(lds, WP(WS_HID), WP(WS_W2) + (size_t)layer * 16 * 1024 * 2816, WP(WS_Y), FF, (nrows) / 256, 4, 1024, 1); } SEAM(p0 + 4); \
    if (IN(p0 + 5)) { P_combine(lds, a, layer, ntok); }
    COMMON(0, 5, NTOK, 64, MOE_ROWS) SEAM(10);
    if (IN(11)) { P_gemm_bf16(lds, WP(WS_H), WP(WS_WINO), WP(WS_PBUF), 1024, NLAT / 256, 8, 2048, 0); P_inproj_odd_tiles(lds, a); } SEAM(11);
    if (IN(12)) { P_prep_odd(lds, a); } SEAM(12);
    if (IN(13)) { P_pool(lds, a); P_gla_naive(lds, a); } SEAM(13);
    if (IN(14)) { P_gla_out(lds, a); } SEAM(14);
    if (IN(15)) { P_gemm_bf16(lds, WP(WS_MIX), WP(WS_WOUTO), WP(WS_YO), 1024, NLAT / 256, 4, 1024, 0); } SEAM(15);
    COMMON(1, 16, NLAT, 32, MOE_LAT)
#undef COMMON
#undef IN
#undef SEAM
#undef WP
}

extern "C" void kernel_launch(void* const* d_in, const int* in_sizes, int n_in, void* d_out, int out_size, void* d_ws, size_t ws_size, hipStream_t stream) {
    static int grid = 0;
    if (grid == 0) {
        if (n_in != N_IN || out_size != NLAT * D || ws_size < WS_END) { fprintf(stderr, "kernel_launch: unexpected shapes (n_in %d, out %d, ws %zu, need %zu)\n", n_in, out_size, ws_size, (size_t)WS_END); grid = -1; return; }
        int dev = 0, cus = 0, per_cu = 0;
        if (hipGetDevice(&dev) != hipSuccess || hipDeviceGetAttribute(&cus, hipDeviceAttributeMultiprocessorCount, dev) != hipSuccess) { grid = -1; return; }
        if (hipFuncSetAttribute((const void*)fwd, hipFuncAttributeMaxDynamicSharedMemorySize, LDS_BYTES) != hipSuccess) { fprintf(stderr, "kernel_launch: hipFuncSetAttribute failed\n"); grid = -1; return; }
        if (hipOccupancyMaxActiveBlocksPerMultiprocessor(&per_cu, (const void*)fwd, NWAVES * 64, LDS_BYTES) != hipSuccess || per_cu < 1) fprintf(stderr, "kernel_launch: occupancy query reports %d\n", per_cu);
        (void)hipGetLastError();
        grid = cus;
    }
    if (grid < 0) return;
    (void)in_sizes;
    if (hipMemsetAsync((char*)d_ws + WS_CTL, 0, CTL_ZERO_BYTES, stream) != hipSuccess) return;
    Args a{};
    for (int i = 0; i < N_IN; ++i) a.in[i] = (const float*)d_in[i];
    a.out = (float*)d_out; a.ws = (unsigned char*)d_ws;
#if MK_ONE_LAUNCH
    a.ph_lo = 0; a.ph_hi = NPH;
    hipLaunchKernelGGL(fwd, dim3(grid), dim3(NWAVES * 64), LDS_BYTES, stream, a);
#else
    for (int li = 0; li < NPH; ++li) { a.ph_lo = li; a.ph_hi = li + 1; hipLaunchKernelGGL(fwd, dim3(grid), dim3(NWAVES * 64), LDS_BYTES, stream, a); }
#endif
}
```

```cpp
#include <hip/hip_runtime.h>
#include <cstdio>
#include <cstdint>
namespace pg8 {
#define PG8_LAS __attribute__((address_space(3)))
typedef unsigned short bf16_t;
typedef short bf16x8 __attribute__((ext_vector_type(8)));
typedef float f32x4 __attribute__((ext_vector_type(4)));
typedef unsigned u32x4 __attribute__((ext_vector_type(4)));
typedef int v4i_t __attribute__((ext_vector_type(4)));
typedef int v8i_t __attribute__((ext_vector_type(8)));
#ifndef PG8_F8_SCALE
#define PG8_F8_SCALE 0
#endif
constexpr int BM = 256, BK = 64, HALF = 128, HTB = HALF * BK * 2  , STAGE_BYTES = 8 * HTB, NXCD = 8, WGM = 8;

__host__ __device__ __forceinline__ int lds_byte(int r, int c) { const int st = (r >> 4) * 2 + (c >> 5), rr = r & 15, cc = c & 31, ob = rr * 64 + cc * 2; return st * 1024 + (ob ^ (((ob >> 9) & 1) << 5)); }
__host__ __device__ __forceinline__ void stage_rc(int b, int& R, int& C) { const int st = b / 1024, sb = b % 1024, swz = sb ^ (((sb >> 9) & 1) << 5); R = (st >> 1) * 16 + swz / 64; C = (st & 1) * 32 + (swz % 64) / 2; }
__host__ __device__ __forceinline__ int perm32(int rho) { const int n = rho >> 4, i = rho & 15; return 8 * (i >> 2) + 4 * n + (i & 3); }

struct Unit { int pm, pn, pb; };
struct Gemm { const bf16_t* A; const bf16_t* Bt; int K; };

struct Order {
    int nM, nN, nwg, G, c, moe;
    __device__ void init(int nM_, int nN_, int G_, int c_, int moe_) { nM = nM_; nN = nN_; nwg = nM * nN; G = G_; c = c_; moe = moe_; }
    __device__ bool next(int i, Unit& u) const {
        const long L = (long)i * G + c; if (L >= nwg) return false;
        int wgid = (int)L; { const int q = nwg / NXCD, r = nwg % NXCD, xcd = wgid % NXCD, off = wgid / NXCD; wgid = (xcd < r ? xcd * (q + 1) : r * (q + 1) + (xcd - r) * q) + off; }
        const int nig = WGM * nN, gid = wgid / nig, fm = gid * WGM, gsz = (nM - fm) < WGM ? (nM - fm) : WGM;
        u.pm = fm + ((wgid % nig) % gsz); u.pn = (wgid % nig) / gsz;
        u.pb = moe ? ((u.pm < 128 ? (u.pm >> 3) : (u.pm - 128)) * nN + u.pn) : u.pn;
        return true;
    }
    __device__ __forceinline__ void a_ready(const Unit&) const {}
    __device__ __forceinline__ void done(const Unit&) const {}
};

__device__ __forceinline__ unsigned cvt_pk_bf16(float lo, float hi) { unsigned r; asm volatile("v_cvt_pk_bf16_f32 %0, %1, %2" : "=v"(r) : "v"(lo), "v"(hi)); return r; }

template <bool F8_> struct EpiBf16T {
    static constexpr bool PERM = true, AFTER_DRAIN = false, F8 = F8_;
    bf16_t* O; int ldc; float scale;
    __device__ __forceinline__ void operator()(const f32x4 (&acc)[2][2][4][2], const Unit& u, int wr, int wc, int fr, int fq) const {
        const int row0 = u.pm * BM + wr * 64 + fr; const int col0 = u.pn * BM + wc * 32 + 8 * fq;
#pragma unroll
        for (int ai = 0; ai < 2; ++ai)
#pragma unroll
            for (int m = 0; m < 4; ++m) { bf16_t* rowp = O + (size_t)(row0 + ai * HALF + m * 16) * ldc + col0;
#pragma unroll
                for (int bj = 0; bj < 2; ++bj) { const f32x4 v0 = acc[ai][bj][m][0] * scale, v1 = acc[ai][bj][m][1] * scale;
                    u32x4 w; w.x = cvt_pk_bf16(v0[0], v0[1]); w.y = cvt_pk_bf16(v0[2], v0[3]); w.z = cvt_pk_bf16(v1[0], v1[1]); w.w = cvt_pk_bf16(v1[2], v1[3]);
                    *(u32x4*)(rowp + bj * HALF) = w; } }
    }
};
__device__ __forceinline__ float silu_f(float x) { return x * __builtin_amdgcn_rcpf(1.0f + __expf(-x)); }
typedef EpiBf16T<false> EpiBf16;
typedef EpiBf16T<true> EpiBf16F8;
__device__ __forceinline__ float clamp448(float x) { return __builtin_fminf(__builtin_fmaxf(x, -448.0f), 448.0f); }
__device__ __forceinline__ unsigned pk4_fp8(float a, float b, float c, float d) { unsigned w = 0u; w = __builtin_amdgcn_cvt_pk_fp8_f32(a, b, w, false); w = __builtin_amdgcn_cvt_pk_fp8_f32(c, d, w, true); return w; }
struct EpiSwigluF8 {
    static constexpr bool PERM = true, AFTER_DRAIN = false, F8 = true;
    unsigned char* O; int ldc; float in_inv, out_scale;
    __device__ __forceinline__ void operator()(const f32x4 (&acc)[2][2][4][2], const Unit& u, int wr, int wc, int fr, int fq) const {
        const int row0 = u.pm * BM + wr * 64 + fr; const int col0 = u.pn * HALF + wc * 32 + 8 * fq;
#pragma unroll
        for (int ai = 0; ai < 2; ++ai)
#pragma unroll
            for (int m = 0; m < 4; ++m) { unsigned char* rowp = O + (size_t)(row0 + ai * HALF + m * 16) * ldc + col0;
                const f32x4 G0 = acc[ai][0][m][0], G1 = acc[ai][0][m][1], U0 = acc[ai][1][m][0], U1 = acc[ai][1][m][1];
                const float ce = -in_inv * 1.4426950408889634f, cm = in_inv * in_inv * out_scale;
                float h0[4], h1[4];
#pragma unroll
                for (int j = 0; j < 4; ++j) { h0[j] = clamp448((G0[j] * U0[j]) * (cm * __builtin_amdgcn_rcpf(1.0f + __builtin_amdgcn_exp2f(G0[j] * ce)))); h1[j] = clamp448((G1[j] * U1[j]) * (cm * __builtin_amdgcn_rcpf(1.0f + __builtin_amdgcn_exp2f(G1[j] * ce)))); }
                typedef unsigned u32x2 __attribute__((ext_vector_type(2)));
                u32x2 w; w.x = pk4_fp8(h0[0], h0[1], h0[2], h0[3]); w.y = pk4_fp8(h1[0], h1[1], h1[2], h1[3]);
                *(u32x2*)rowp = w; }
    }
};
struct EpiSwiglu {
    static constexpr bool PERM = true, AFTER_DRAIN = false, F8 = false;
    bf16_t* O; int ldc;
    __device__ __forceinline__ void operator()(const f32x4 (&acc)[2][2][4][2], const Unit& u, int wr, int wc, int fr, int fq) const {
        const int row0 = u.pm * BM + wr * 64 + fr; const int col0 = u.pn * HALF + wc * 32 + 8 * fq;
#pragma unroll
        for (int ai = 0; ai < 2; ++ai)
#pragma unroll
            for (int m = 0; m < 4; ++m) { bf16_t* rowp = O + (size_t)(row0 + ai * HALF + m * 16) * ldc + col0;
                const f32x4 g0 = acc[ai][0][m][0], g1 = acc[ai][0][m][1], u0 = acc[ai][1][m][0], u1 = acc[ai][1][m][1];
                u32x4 w; w.x = cvt_pk_bf16(silu_f(g0[0]) * u0[0], silu_f(g0[1]) * u0[1]); w.y = cvt_pk_bf16(silu_f(g0[2]) * u0[2], silu_f(g0[3]) * u0[3]);
                w.z = cvt_pk_bf16(silu_f(g1[0]) * u1[0], silu_f(g1[1]) * u1[1]); w.w = cvt_pk_bf16(silu_f(g1[2]) * u1[2], silu_f(g1[3]) * u1[3]);
                *(u32x4*)rowp = w; }
    }
};

template <class Epi, class Sched, bool ALIGN_EPI = false, bool SP2 = false>
__device__ __forceinline__ void gemm_phase(PG8_LAS unsigned char* lds, const Gemm g, const Sched& S, const Epi& E) {
    int tid_ = threadIdx.x; asm volatile("" : "+v"(tid_));
    const int tid = tid_ & 511, wid = __builtin_amdgcn_readfirstlane(tid >> 6), lane = tid & 63, wr = wid >> 2, wc = wid & 3, fr = lane & 15, fq = lane >> 4;
    const int K = g.K, nt = K / BK;
    unsigned voffA[2], voffB[2];
#pragma unroll
    for (int i = 0; i < 2; ++i) { int R, C; stage_rc(tid * 16 + i * 8192, R, C); const int Rb = Epi::PERM ? ((R & ~31) + perm32(R & 31)) : R;
        voffA[i] = (unsigned)(R * K + C) * 2u; voffB[i] = (unsigned)(Rb * K + C) * 2u; }
    const size_t kstep = (size_t)(BK * 2);
    const size_t hstep = (size_t)HALF * K * 2;
    const size_t tstep = 2 * hstep;
    const unsigned ldsw = (unsigned)wid * 1024u;
    const int aoff = lds_byte(wr * 64 + fr, fq * 8), boff = lds_byte(wc * 32 + fr, fq * 8);
#define PG8_SA(b, h) (((b) * 2 + (h)) * HTB)
#define PG8_SB(b, h) ((4 + (b) * 2 + (h)) * HTB)
#define PG8_STAGE(bufoff, gbase, voff) do { _Pragma("unroll") for (int _i = 0; _i < 2; ++_i) \
        __builtin_amdgcn_global_load_lds((const unsigned*)((const char*)(gbase) + (voff)[_i]), (PG8_LAS unsigned*)(lds + (bufoff) + ldsw + _i * 8192), 16, 0, 0); } while (0)
#define PG8_LD16(off) (*(const PG8_LAS v4i_t*)(lds + (off)))
#define PG8_LDA(dst, b, h) do { _Pragma("unroll") for (int m = 0; m < 4; ++m) { if constexpr (Epi::F8) { const v4i_t lo_ = PG8_LD16(PG8_SA(b, h) + aoff + m * 2048), hi_ = PG8_LD16(PG8_SA(b, h) + aoff + m * 2048 + 1024); dst##8[m] = __builtin_shufflevector(lo_, hi_, 0, 1, 2, 3, 4, 5, 6, 7); } \
        else { _Pragma("unroll") for (int k = 0; k < 2; ++k) dst[m][k] = *(const PG8_LAS bf16x8*)(lds + PG8_SA(b, h) + aoff + m * 2048 + k * 1024); } } } while (0)
#define PG8_LDB(dst, b, h) do { _Pragma("unroll") for (int n = 0; n < 2; ++n) { if constexpr (Epi::F8) { const v4i_t lo_ = PG8_LD16(PG8_SB(b, h) + boff + n * 2048), hi_ = PG8_LD16(PG8_SB(b, h) + boff + n * 2048 + 1024); dst##8[n] = __builtin_shufflevector(lo_, hi_, 0, 1, 2, 3, 4, 5, 6, 7); } \
        else { _Pragma("unroll") for (int k = 0; k < 2; ++k) dst[n][k] = *(const PG8_LAS bf16x8*)(lds + PG8_SB(b, h) + boff + n * 2048 + k * 1024); } } } while (0)
#define PG8_MMA(ai, bj, At, Bt) do { __builtin_amdgcn_s_setprio(1); _Pragma("unroll") for (int m = 0; m < 4; ++m) _Pragma("unroll") for (int n = 0; n < 2; ++n) { \
        if constexpr (Epi::F8) { asm volatile("v_mfma_f32_16x16x128_f8f6f4 %0, %1, %2, %0" : "+v"(acc[ai][bj][m][n]) : "v"(Bt##8[n]), "v"(At##8[m])); } \
        else { _Pragma("unroll") for (int k = 0; k < 2; ++k) acc[ai][bj][m][n] = __builtin_amdgcn_mfma_f32_16x16x32_bf16(Bt[n][k], At[m][k], acc[ai][bj][m][n], 0, 0, 0); } } \
        __builtin_amdgcn_s_setprio(0); } while (0)
#define PG8_WAIT_V(n) asm volatile("s_waitcnt vmcnt(" #n ")" ::: "memory")
#define PG8_WAIT_L(n) asm volatile("s_waitcnt lgkmcnt(" #n ")" ::: "memory")
#define PG8_BAR __builtin_amdgcn_s_barrier()
#define PG8_SCHED __builtin_amdgcn_sched_barrier(0)
    Unit cur, nxt; int ui = 0;
    if (!S.next(0, cur)) return;
    f32x4 acc[2][2][4][2];
#pragma unroll
    for (int a = 0; a < 2; ++a)
#pragma unroll
        for (int b = 0; b < 2; ++b)
#pragma unroll
            for (int m = 0; m < 4; ++m)
#pragma unroll
                for (int n = 0; n < 2; ++n) acc[a][b][m][n] = (f32x4){0.f, 0.f, 0.f, 0.f};
    bf16x8 At[4][2], B0[2][2], B1[2][2]; v8i_t At8[4], B08[2], B18[2];
    const char* cA = (const char*)g.A + (size_t)cur.pm * tstep; const char* cB = (const char*)g.Bt + (size_t)cur.pb * tstep;
    S.a_ready(cur);
    if constexpr (SP2) {
        PG8_STAGE(PG8_SB(0, 0), cB, voffB); PG8_STAGE(PG8_SB(0, 1), cB + hstep, voffB); PG8_STAGE(PG8_SA(0, 0), cA, voffA); PG8_STAGE(PG8_SA(0, 1), cA + hstep, voffA);
        if (wr == 1) PG8_BAR;
        PG8_WAIT_V(2); PG8_BAR;
        PG8_STAGE(PG8_SB(1, 0), cB + kstep, voffB); PG8_STAGE(PG8_SA(1, 0), cA + kstep, voffA); PG8_STAGE(PG8_SB(1, 1), cB + hstep + kstep, voffB);
        PG8_WAIT_V(6); PG8_BAR;
    } else {
        PG8_STAGE(PG8_SB(0, 0), cB, voffB); PG8_STAGE(PG8_SA(0, 0), cA, voffA); PG8_STAGE(PG8_SB(0, 1), cB + hstep, voffB); PG8_STAGE(PG8_SA(0, 1), cA + hstep, voffA);
        if (wr == 1) PG8_BAR;
        PG8_WAIT_V(4); PG8_BAR;
        PG8_STAGE(PG8_SB(1, 0), cB + kstep, voffB); PG8_STAGE(PG8_SA(1, 0), cA + kstep, voffA); PG8_STAGE(PG8_SB(1, 1), cB + hstep + kstep, voffB);
        PG8_WAIT_V(6); PG8_BAR;
    }
    for (;;) {
        const bool has_next = S.next(ui + 1, nxt);
        const char* nA = has_next ? (const char*)g.A + (size_t)nxt.pm * tstep : cA; const char* nB = has_next ? (const char*)g.Bt + (size_t)nxt.pb * tstep : cB;
        for (int t = 0; t < nt; t += 2) {
            const bool last = (t == nt - 2);
            const char* a1 = cA + (size_t)(t + 1) * kstep;
            const char* a2 = last ? nA : cA + (size_t)(t + 2) * kstep; const char* b2 = last ? nB : cB + (size_t)(t + 2) * kstep;
            const char* a3 = a2 + kstep; const char* b3 = b2 + kstep;
            if (last && has_next) S.a_ready(nxt);
            if constexpr (SP2) {
            PG8_LDB(B0, 0, 0); PG8_LDB(B1, 0, 1); PG8_SCHED; PG8_LDA(At, 0, 0); PG8_STAGE(PG8_SA(1, 1), a1 + hstep, voffA);
            PG8_WAIT_V(8); PG8_WAIT_L(0); PG8_BAR; PG8_MMA(0, 0, At, B0); PG8_MMA(0, 1, At, B1); PG8_BAR; PG8_SCHED;
            PG8_LDA(At, 0, 1); PG8_STAGE(PG8_SB(0, 0), b2, voffB); PG8_STAGE(PG8_SB(0, 1), b2 + hstep, voffB); PG8_STAGE(PG8_SA(0, 0), a2, voffA);
            PG8_WAIT_V(8); PG8_WAIT_L(0); PG8_BAR; PG8_MMA(1, 0, At, B0); PG8_MMA(1, 1, At, B1); PG8_BAR; PG8_SCHED;
            PG8_LDB(B0, 1, 0); PG8_LDB(B1, 1, 1); PG8_SCHED; PG8_LDA(At, 1, 0); PG8_STAGE(PG8_SA(0, 1), a2 + hstep, voffA);
            PG8_WAIT_V(8); PG8_WAIT_L(0); PG8_BAR; PG8_MMA(0, 0, At, B0); PG8_MMA(0, 1, At, B1); PG8_BAR; PG8_SCHED;
            PG8_LDA(At, 1, 1); PG8_STAGE(PG8_SB(1, 0), b3, voffB); PG8_STAGE(PG8_SB(1, 1), b3 + hstep, voffB); PG8_STAGE(PG8_SA(1, 0), a3, voffA);
            PG8_WAIT_V(8); PG8_WAIT_L(0); PG8_BAR; PG8_MMA(1, 0, At, B0); PG8_MMA(1, 1, At, B1); PG8_BAR; PG8_SCHED;
            } else {
            PG8_LDB(B0, 0, 0); PG8_SCHED; PG8_LDA(At, 0, 0); PG8_STAGE(PG8_SA(1, 1), a1 + hstep, voffA);
            PG8_WAIT_L(8); PG8_BAR; PG8_WAIT_L(0); PG8_MMA(0, 0, At, B0); PG8_BAR; PG8_SCHED;
            PG8_LDB(B1, 0, 1); PG8_STAGE(PG8_SB(0, 0), b2, voffB);
            PG8_BAR; PG8_WAIT_L(0); PG8_MMA(0, 1, At, B1); PG8_BAR;
            PG8_LDA(At, 0, 1); PG8_STAGE(PG8_SA(0, 0), a2, voffA);
            PG8_BAR; PG8_WAIT_L(0); PG8_MMA(1, 0, At, B0); PG8_BAR; PG8_SCHED;
            PG8_STAGE(PG8_SB(0, 1), b2 + hstep, voffB);
            PG8_WAIT_V(6); PG8_BAR; PG8_MMA(1, 1, At, B1); PG8_BAR;
            PG8_LDB(B0, 1, 0); PG8_SCHED; PG8_LDA(At, 1, 0); PG8_STAGE(PG8_SA(0, 1), a2 + hstep, voffA);
            PG8_WAIT_L(8); PG8_BAR; PG8_WAIT_L(0); PG8_MMA(0, 0, At, B0); PG8_BAR; PG8_SCHED;
            PG8_LDB(B1, 1, 1); PG8_STAGE(PG8_SB(1, 0), b3, voffB);
            PG8_BAR; PG8_WAIT_L(0); PG8_MMA(0, 1, At, B1); PG8_BAR;
            PG8_LDA(At, 1, 1); PG8_STAGE(PG8_SA(1, 0), a3, voffA);
            PG8_BAR; PG8_WAIT_L(0); PG8_MMA(1, 0, At, B0); PG8_BAR; PG8_SCHED;
            PG8_STAGE(PG8_SB(1, 1), b3 + hstep, voffB);
            PG8_WAIT_V(6); PG8_BAR; PG8_MMA(1, 1, At, B1); PG8_BAR;
            }
        }
        if constexpr (Epi::F8) { asm volatile("s_nop 15\n\ts_nop 15" ::: "memory"); }
        if constexpr (ALIGN_EPI) { if (wr == 0) PG8_BAR; }
        if constexpr (!Epi::AFTER_DRAIN) { E(acc, cur, wr, wc, fr, fq); S.done(cur); }
        if (!has_next) break;
#pragma unroll
        for (int a = 0; a < 2; ++a)
#pragma unroll
            for (int b = 0; b < 2; ++b)
#pragma unroll
                for (int m = 0; m < 4; ++m)
#pragma unroll
                    for (int n = 0; n < 2; ++n) acc[a][b][m][n] = (f32x4){0.f, 0.f, 0.f, 0.f};
        cur = nxt; cA = nA; cB = nB; ++ui;
        if constexpr (ALIGN_EPI) { if (wr == 1) PG8_BAR; }
    }
    PG8_WAIT_V(0);
    if constexpr (!ALIGN_EPI) { if (wr == 0) PG8_BAR; }
    PG8_BAR;
    if constexpr (Epi::AFTER_DRAIN) { E.fused(acc, cur, wr, wc, fr, fq, lds, wid, lane); S.done(cur); }
#undef PG8_SA
#undef PG8_SB
#undef PG8_STAGE
#undef PG8_LDA
#undef PG8_LDB
#undef PG8_MMA
#undef PG8_LD16
#undef PG8_WAIT_V
#undef PG8_WAIT_L
#undef PG8_BAR
#undef PG8_SCHED
}
}

#ifndef PG8_SP2
#define PG8_SP2 true
#endif
#ifndef PG8_ALIGN
#define PG8_ALIGN true
#endif
constexpr int D = 1024, SEQ = 8192, NLAT = 16384, CTXL = 256, NCTX = 512, NTOK = NLAT + NCTX;
constexpr int NE = 16, FF = 2816, EVEN_IN = 2560, ODD_IN = 2080;
constexpr int MOE_LAT = 32768, MOE_ROWS = 36864;
constexpr float EPS = 1e-6f;
constexpr int NWAVES = 8;
enum { I_X = 0, I_C, I_CTX, I_CCTX, I_WMOD, I_BMOD, I_NORMG, I_WINE, I_WOUTE, I_CONVW, I_CONVB, I_CLNG, I_CLNB, I_RPB, I_WINO, I_WOUTO, I_POOLW, I_POOLS, I_GATEW, I_GATEB, I_HEADG, I_ROUTER, I_WG, I_WU, I_WD, N_IN };

constexpr size_t MiB = 1u << 20;
constexpr size_t alup(size_t x) { return (x + MiB - 1) / MiB * MiB; }
constexpr size_t WS_CTL = 0, CTL_ZERO_BYTES = MiB;
constexpr size_t WS_MOD = WS_CTL + MiB;
constexpr size_t WS_ROPE = WS_MOD + alup((size_t)2 * 3 * 6144 * 4);
constexpr size_t WS_AFF = WS_ROPE + MiB;
constexpr size_t WS_INV = WS_AFF + alup((size_t)NTOK * 16 * 4);
constexpr size_t WS_ROWTOK = WS_INV + alup((size_t)NTOK * 16 * 4);
constexpr size_t WS_LR = WS_ROWTOK + alup((size_t)MOE_ROWS * 4);
constexpr size_t WS_WINE = WS_LR + alup((size_t)NTOK * 32 * 4);
constexpr size_t WS_WOUTE = WS_WINE + alup((size_t)2560 * 1024 * 2);
constexpr size_t WS_WINO = WS_WOUTE + alup((size_t)1024 * 1024 * 2);
constexpr size_t WS_WOUTO = WS_WINO + alup((size_t)2080 * 1024 * 2);
constexpr size_t WS_POOLW = WS_WOUTO + alup((size_t)1024 * 1024 * 2);
constexpr size_t WS_W1 = WS_POOLW + MiB;
constexpr size_t WS_W2 = WS_W1 + alup((size_t)2 * 16 * 5632 * 1024 * 2);
constexpr size_t WS_H = WS_W2 + alup((size_t)2 * 16 * 1024 * 2816 * 2);
constexpr size_t WS_X1 = WS_H + alup((size_t)NTOK * 1024 * 2);
constexpr size_t WS_XN2 = WS_X1 + alup((size_t)NTOK * 1024 * 4);
constexpr size_t WS_PBUF = WS_XN2 + alup((size_t)NTOK * 1024 * 2);
constexpr size_t WS_MIX = WS_PBUF + alup((size_t)NTOK * 2560 * 2);
constexpr size_t WS_YO = WS_MIX + alup((size_t)NTOK * 1024 * 2);
constexpr size_t WS_MOE = WS_YO + alup((size_t)NTOK * 1024 * 2);
constexpr size_t WS_XG = WS_MOE;
constexpr size_t WS_HID = WS_XG + alup((size_t)MOE_ROWS * 1024 * 2);
constexpr size_t WS_Y = WS_HID + alup((size_t)MOE_ROWS * 2816 * 2);
constexpr size_t WS_END = WS_Y + alup((size_t)MOE_ROWS * 1024 * 2);
constexpr size_t WS_DPOOL = WS_MOE;
constexpr size_t WS_QR = WS_DPOOL + alup((size_t)NLAT * 512 * 2);
constexpr size_t WS_KR = WS_QR + alup((size_t)NLAT * 256 * 4);
constexpr size_t WS_GF = WS_KR + alup((size_t)NTOK * 256 * 4);
constexpr size_t WS_GB = WS_GF + alup((size_t)NTOK * 256 * 4);
constexpr size_t WS_QE = WS_GB + alup((size_t)NTOK * 256 * 4);
constexpr size_t WS_KD = WS_QE + alup((size_t)2 * NLAT * 256 * 2);
constexpr size_t WS_UT = WS_KD + alup((size_t)2 * NLAT * 256 * 2);
constexpr size_t WS_DC = WS_UT + alup((size_t)16 * 132 * 8192 * 4);
constexpr size_t WS_ST = WS_DC + MiB;
constexpr size_t WS_OACC = WS_ST + alup((size_t)16 * 128 * 8192 * 2);
constexpr size_t WS_GLA_END = WS_OACC + alup((size_t)2 * NLAT * 512 * 4);
static_assert(WS_GLA_END <= WS_END, "overlay fits");
constexpr int CW_TMO = 0, CW_BAR = 4096;

constexpr int RING_OFF = 0, RING_BYTES = 131072;
constexpr int LDSCTL_OFF = RING_BYTES, MISC_OFF = LDSCTL_OFF + 320;
constexpr int LDS_BYTES = 147456;

#define GAS __attribute__((address_space(1)))
#define LAS __attribute__((address_space(3)))
typedef unsigned short bf16;
typedef unsigned v4u __attribute__((ext_vector_type(4)));
typedef unsigned v2u __attribute__((ext_vector_type(2)));
typedef float f32x4 __attribute__((ext_vector_type(4)));
typedef short bf16x8 __attribute__((ext_vector_type(8)));
typedef GAS unsigned gu32;
#define RLX_AGENT __ATOMIC_RELAXED, __HIP_MEMORY_SCOPE_AGENT
#define LDS_WAIT() asm volatile("s_waitcnt lgkmcnt(0)" ::: "memory")
#define VM_WAIT() asm volatile("s_waitcnt vmcnt(0)" ::: "memory")
__device__ __forceinline__ unsigned f2bf(float f) { unsigned u = __builtin_bit_cast(unsigned, f); return (u + 0x7fffu + ((u >> 16) & 1u)) >> 16; }
typedef float f32x2_c __attribute__((ext_vector_type(2)));
typedef __bf16 bf16x2_c __attribute__((ext_vector_type(2)));
__device__ __forceinline__ unsigned pk2(float lo, float hi) { f32x2_c v; v.x = lo; v.y = hi; const bf16x2_c r = __builtin_convertvector(v, bf16x2_c); return __builtin_bit_cast(unsigned, r); }
__device__ __forceinline__ float bflo(unsigned w) { return __builtin_bit_cast(float, w << 16); }
__device__ __forceinline__ float bfhi(unsigned w) { return __builtin_bit_cast(float, w & 0xffff0000u); }
__device__ __forceinline__ float bf2f(bf16 b) { return __builtin_bit_cast(float, ((unsigned)b) << 16); }
template <int CTRL> __device__ __forceinline__ float dpp_mov(float v) { return __builtin_bit_cast(float, __builtin_amdgcn_update_dpp(0, __builtin_bit_cast(int, v), CTRL, 0xF, 0xF, true)); }
__device__ __forceinline__ float lane_xor1(float v) { return dpp_mov<0xB1>(v); }
__device__ __forceinline__ float lane_xor2(float v) { return dpp_mov<0x4E>(v); }
__device__ __forceinline__ float lane_xor4(float v) { return dpp_mov<0x1B>(dpp_mov<0x141>(v)); }
__device__ __forceinline__ float lane_xor8(float v) { return dpp_mov<0x141>(dpp_mov<0x140>(v)); }
__device__ __forceinline__ float row16_sum(float v) { v += lane_xor1(v); v += lane_xor2(v); v += dpp_mov<0x141>(v); v += dpp_mov<0x140>(v); return v; }
__device__ __forceinline__ float wave_sum(float v) {
    v = row16_sum(v); const int b = __builtin_bit_cast(int, v);
    const float r0 = __builtin_bit_cast(float, __builtin_amdgcn_readlane(b, 0)), r1 = __builtin_bit_cast(float, __builtin_amdgcn_readlane(b, 16)), r2 = __builtin_bit_cast(float, __builtin_amdgcn_readlane(b, 32)), r3 = __builtin_bit_cast(float, __builtin_amdgcn_readlane(b, 48));
    return (r0 + r1) + (r2 + r3);
}
typedef unsigned u32x2_t __attribute__((ext_vector_type(2)));
__device__ __forceinline__ void swap16(float v, float& own, float& other) { const u32x2_t r = __builtin_amdgcn_permlane16_swap(__builtin_bit_cast(unsigned, v), __builtin_bit_cast(unsigned, v), false, false); const unsigned r0 = r.x, r1 = r.y; own = __builtin_bit_cast(float, r0); other = __builtin_bit_cast(float, r1); }
__device__ __forceinline__ void swap32(float v, float& own, float& other) { const u32x2_t r = __builtin_amdgcn_permlane32_swap(__builtin_bit_cast(unsigned, v), __builtin_bit_cast(unsigned, v), false, false); const unsigned r0 = r.x, r1 = r.y; own = __builtin_bit_cast(float, r0); other = __builtin_bit_cast(float, r1); }
__device__ __forceinline__ float xor16_max(float v) { float a, b; swap16(v, a, b); return fmaxf(a, b); }
__device__ __forceinline__ float xor32_max(float v) { float a, b; swap32(v, a, b); return fmaxf(a, b); }
__device__ __forceinline__ float xor16_sum(float v) { float a, b; swap16(v, a, b); return a + b; }
__device__ __forceinline__ float xor32_sum(float v) { float a, b; swap32(v, a, b); return a + b; }
__device__ __forceinline__ float silu(float x) { return x / (1.0f + __expf(-x)); }
__device__ __forceinline__ float sigmoidf(float x) { return 1.0f / (1.0f + __expf(-x)); }
#define XB_TMO      128
#define XB_XCNT(j)  (256  + 64 * (j))
#define XB_XSUB(j)  (1280 + 64 * (j))
#define XB_XGEN(j)  (2304 + 64 * (j))
#define XB_TOP      3328
#define XB_TOPGEN   3392
#define XCD_BAR_WORDS 3456
#define XB_SPIN_CAP (1u << 18)

__device__ __forceinline__ unsigned xb_ld(unsigned* p)              { return __hip_atomic_load(p, __ATOMIC_RELAXED, __HIP_MEMORY_SCOPE_AGENT); }
__device__ __forceinline__ unsigned xb_add(unsigned* p, unsigned v) { return __hip_atomic_fetch_add(p, v, __ATOMIC_RELAXED, __HIP_MEMORY_SCOPE_AGENT); }
__device__ __forceinline__ unsigned xb_xcc_id() { return (unsigned)__builtin_amdgcn_s_getreg((3 << 11) | 20) & 0xFu; }
#define XB_SPIN(cond, bar) do { unsigned _sp = 0; while (cond) { __builtin_amdgcn_s_sleep(1); \
    if ((++_sp & 255u) == 0u) { if (xb_ld(&(bar)[XB_TMO])) break; if (_sp > XB_SPIN_CAP) { atomicAdd(&(bar)[XB_TMO], 1u); break; } } } } while (0)

struct XcdBarrier {
    unsigned* bar; unsigned x;
    volatile LAS unsigned* st;
};

__device__ __forceinline__ XcdBarrier xcd_barrier_post(unsigned* bar, volatile LAS unsigned* st) {
    XcdBarrier b; b.bar = bar; b.x = xb_xcc_id(); b.st = st;
    if (threadIdx.x == 0) (void)xb_add(&bar[XB_XCNT(b.x)], 1u);
    return b;
}
__device__ __forceinline__ void xcd_barrier_complete(unsigned* bar, unsigned x, unsigned& nloc, unsigned& nx) {
    const unsigned G = gridDim.x * gridDim.y * gridDim.z;
    unsigned sum, cnt, mine, sp = 0u;
    for (;;) {
        sum = 0u; cnt = 0u; mine = 0u;
#pragma unroll
        for (unsigned j = 0; j < 16; ++j) { const unsigned c = xb_ld(&bar[XB_XCNT(j)]); sum += c; cnt += (c > 0u) ? 1u : 0u; mine = (j == x) ? c : mine; }
        if (sum == G) break;
        __builtin_amdgcn_s_sleep(1);
        if ((++sp & 255u) == 0u) { if (xb_ld(&bar[XB_TMO])) break; if (sp > XB_SPIN_CAP) { atomicAdd(&bar[XB_TMO], 1u); break; } }
    }
    nloc = mine > 0u ? mine : 1u; nx = cnt > 0u ? cnt : 1u;
}

__device__ __forceinline__ void xcd_barrier(const XcdBarrier& b) {
    asm volatile("s_waitcnt vmcnt(0)" ::: "memory");
    __syncthreads();
    if (threadIdx.x == 0) {
        unsigned* bar = b.bar;
        __builtin_amdgcn_s_waitcnt(0);
        unsigned nloc = b.st[0], nx = b.st[1];
        if (nloc == 0u) { xcd_barrier_complete(bar, b.x, nloc, nx); b.st[0] = nloc; b.st[1] = nx; }
        const unsigned old = xb_add(&bar[XB_XSUB(b.x)], 1u);
        const unsigned gen = old / nloc;
        if (old + 1u == (gen + 1u) * nloc) {
            __builtin_amdgcn_fence(__ATOMIC_RELEASE, "agent");
            asm volatile("s_waitcnt vmcnt(0)" ::: "memory");
            const unsigned og = xb_add(&bar[XB_TOP], 1u);
            const unsigned tg = og / nx;
            if (og + 1u == (tg + 1u) * nx) xb_add(&bar[XB_TOPGEN], 1u);
            else XB_SPIN(xb_ld(&bar[XB_TOPGEN]) == tg, bar);
            __builtin_amdgcn_fence(__ATOMIC_ACQUIRE, "agent");
            xb_add(&bar[XB_XGEN(b.x)], 1u);
            asm volatile("s_waitcnt vmcnt(0)" ::: "memory");
        } else {
            XB_SPIN(xb_ld(&bar[XB_XGEN(b.x)]) == gen, bar);
            __builtin_amdgcn_fence(__ATOMIC_ACQUIRE, "agent");
            asm volatile("s_waitcnt vmcnt(0)" ::: "memory");
        }
    }
    __syncthreads();
}

#define CAS __attribute__((address_space(4)))
struct Args { const float* in[N_IN]; float* out; unsigned char* ws; int ph_lo, ph_hi; };
struct Ctx {
    LAS unsigned char* lds;
    const CAS Args* a; float* out; unsigned char* ws;
    int tid, lane, wave, G, gw, ngw;
};
#define WSP(T, off) ((T*)(c.ws + (off)))

__device__ __forceinline__ f32x4 wave_tile16(const bf16* A, int lda, const bf16* Bt, int ldb, int K, int lane) {
    const bf16* ap = A + (size_t)(lane & 15) * lda + 8 * (lane >> 4);
    const bf16* bp = Bt + (size_t)(lane & 15) * ldb + 8 * (lane >> 4);
    f32x4 acc = {0.f, 0.f, 0.f, 0.f};
#pragma unroll 8
    for (int k = 0; k < K; k += 32) {
        const bf16x8 a = *(const bf16x8*)(ap + k), b = *(const bf16x8*)(bp + k);
        acc = __builtin_amdgcn_mfma_f32_16x16x32_bf16(b, a, acc, 0, 0, 0);
    }
    return acc;
}

__device__ __forceinline__ void transpose_tile(const float* W, int N, int k0, int n0, bf16* dst, int ldd, LAS float* scr, int lane) {
#pragma unroll 8
    for (int i = 0; i < 32; ++i) { const int kk = 2 * i + (lane >> 5); scr[kk * 33 + (lane & 31)] = W[(size_t)(k0 + kk) * N + n0 + (lane & 31)]; }
    LDS_WAIT(); asm volatile("" ::: "memory");
    const int cc = lane & 7;
#pragma unroll
    for (int j = 0; j < 4; ++j) { const int n = (lane >> 3) + 8 * j; const LAS float* s = scr + (8 * cc) * 33 + n;
        v4u o; o.x = pk2(s[0 * 33], s[1 * 33]); o.y = pk2(s[2 * 33], s[3 * 33]); o.z = pk2(s[4 * 33], s[5 * 33]); o.w = pk2(s[6 * 33], s[7 * 33]);
        *(v4u*)(dst + (size_t)n * ldd + 8 * cc) = o; }
    LDS_WAIT(); asm volatile("" ::: "memory");
}

constexpr float SC_W = 64.0f, SC_X = 16.0f, SC_H = 8.0f;
__device__ __forceinline__ void transpose64_f8(const float* W, int N, int k0, int n0, unsigned char* dst, int ldd, LAS float* scr, int lane) {
    const int cq = lane & 15, rq = lane >> 4;
    f32x4 v[16];
#pragma unroll
    for (int i = 0; i < 16; ++i) v[i] = *(const f32x4*)(W + (size_t)(k0 + rq + 4 * i) * N + n0 + 4 * cq);
#pragma unroll
    for (int i = 0; i < 16; ++i) *(LAS f32x4*)(scr + (rq + 4 * i) * 64 + 4 * cq) = v[i];
    LDS_WAIT(); asm volatile("" ::: "memory");
    unsigned o[16];
#pragma unroll
    for (int j = 0; j < 16; ++j) o[j] = pg8::pk4_fp8(scr[(4 * j) * 64 + lane] * SC_W, scr[(4 * j + 1) * 64 + lane] * SC_W, scr[(4 * j + 2) * 64 + lane] * SC_W, scr[(4 * j + 3) * 64 + lane] * SC_W);
#pragma unroll
    for (int t = 0; t < 4; ++t) { v4u w; w.x = o[4 * t]; w.y = o[4 * t + 1]; w.z = o[4 * t + 2]; w.w = o[4 * t + 3]; *(v4u*)(dst + (size_t)lane * ldd + 16 * t) = w; }
    LDS_WAIT(); asm volatile("" ::: "memory");
}

constexpr int TI_WINE = (1024 / 64) * (2560 / 32), TI_WOUT = (1024 / 64) * (1024 / 32), TI_WINO = (1024 / 64) * (2080 / 32), TI_POOL = 4 * 2 * 4;
constexpr int TI_SMALL = TI_WINE + 2 * TI_WOUT + TI_WINO + TI_POOL;
constexpr int TI_GU = (1024 / 64) * (2816 / 64), TI_DN = (2816 / 64) * (1024 / 64);
constexpr int TI_PER_LE = 2 * TI_GU + TI_DN;
constexpr int TI_TOTAL = TI_SMALL + 32 * TI_PER_LE;

__device__ __forceinline__ void ph_prologue(const Ctx& c) {
    if (blockIdx.x < 192) {
        LAS float* sl = (LAS float*)c.lds;
        LAS float* red = sl + 3 * 1024;
        for (int i = c.tid; i < 3072; i += 512) { const int s = i >> 10, k = i & 1023; const float v = s < 2 ? c.a->in[I_C][s * 1024 + k] : c.a->in[I_CCTX][k]; sl[i] = silu(v); }
        __syncthreads();
        const int item = blockIdx.x, l = item / 96, j = 64 * (item % 96) + c.lane;
        const float* W = c.a->in[I_WMOD] + (size_t)l * 1024 * 6144 + j;
        float a0 = 0.f, a1 = 0.f, a2 = 0.f;
#pragma unroll 8
        for (int kk = 0; kk < 128; ++kk) { const int k = c.wave * 128 + kk; const float w = W[(size_t)k * 6144]; a0 += sl[k] * w; a1 += sl[1024 + k] * w; a2 += sl[2048 + k] * w; }
        red[(c.wave * 3 + 0) * 64 + c.lane] = a0; red[(c.wave * 3 + 1) * 64 + c.lane] = a1; red[(c.wave * 3 + 2) * 64 + c.lane] = a2;
        __syncthreads();
        if (c.wave < 3) { float s = 0.f;
#pragma unroll
            for (int w = 0; w < 8; ++w) s += red[(w * 3 + c.wave) * 64 + c.lane];
            WSP(float, WS_MOD)[(l * 3 + c.wave) * 6144 + j] = s + c.a->in[I_BMOD][l * 6144 + j]; }
        __syncthreads();
    }
    { const int g = blockIdx.x * 512 + c.tid;
      if (g < 192 * 16) { const int pos = g >> 4, f = g & 15; const float inv = powf(10000.0f, -(float)f / 16.0f); const float ang = (float)(pos < 128 ? pos : pos - 128) * inv;
          float sn, cs; sincosf(ang, &sn, &cs); float* T = WSP(float, WS_ROPE); T[g * 2] = cs; T[g * 2 + 1] = sn; } }
    LAS float* scr = (LAS float*)(c.lds + c.wave * 16384);
    for (int it = c.gw; it < TI_SMALL; it += c.ngw) {
        int r = it;
        {
            if (r < TI_WINE) { const int nb = 2560 / 32, kb = r / nb, n0 = 32 * (r % nb); transpose_tile(c.a->in[I_WINE], 2560, 64 * kb, n0, WSP(bf16, WS_WINE) + (size_t)n0 * 1024 + 64 * kb, 1024, scr, c.lane); continue; } r -= TI_WINE;
            if (r < TI_WOUT) { const int nb = 32, kb = r / nb, n0 = 32 * (r % nb); transpose_tile(c.a->in[I_WOUTE], 1024, 64 * kb, n0, WSP(bf16, WS_WOUTE) + (size_t)n0 * 1024 + 64 * kb, 1024, scr, c.lane); continue; } r -= TI_WOUT;
            if (r < TI_WOUT) { const int nb = 32, kb = r / nb, n0 = 32 * (r % nb); transpose_tile(c.a->in[I_WOUTO], 1024, 64 * kb, n0, WSP(bf16, WS_WOUTO) + (size_t)n0 * 1024 + 64 * kb, 1024, scr, c.lane); continue; } r -= TI_WOUT;
            if (r < TI_WINO) { const int nb = 2080 / 32, kb = r / nb, n0 = 32 * (r % nb); transpose_tile(c.a->in[I_WINO], 2080, 64 * kb, n0, WSP(bf16, WS_WINO) + (size_t)n0 * 1024 + 64 * kb, 1024, scr, c.lane); continue; } r -= TI_WINO;
            { const int g = r / 8, kb = (r % 8) / 4, n0 = 32 * (r % 4);
              transpose_tile(c.a->in[I_POOLW] + (size_t)g * 128 * 128, 128, 64 * kb, n0, WSP(bf16, WS_POOLW) + (size_t)g * 128 * 128 + (size_t)n0 * 128 + 64 * kb, 128, scr, c.lane); continue; }
        }
    }
    __syncthreads();
    {
        constexpr int NIT = 32 * 528;
        f32x4 v[8];
        const bool deal = (c.G == 256);
        const int nmine = deal ? ((int)blockIdx.x < 192 ? 65 : 69) : (NIT - (int)blockIdx.x + (int)c.G - 1) / (int)c.G;
        const int it0 = deal ? ((int)blockIdx.x < 192 ? (int)blockIdx.x : 192 * 65 + ((int)blockIdx.x - 192)) : (int)blockIdx.x, itstep = deal ? ((int)blockIdx.x < 192 ? 192 : 64) : (int)c.G;
        int it = it0, buf = 0;
        const float* src = nullptr; int N = 0, k0 = 0, n0 = 0, le = 0, which = 0;
#define PRO_DECODE(IT) do { le = (IT) / 528; const int q_ = (IT) % 528; which = q_ / 176; const int r_ = q_ % 176; \
            if (which < 2) { n0 = 256 * (r_ / 16); k0 = 64 * (r_ % 16); N = 2816; src = c.a->in[which ? I_WU : I_WG] + (size_t)le * 1024 * 2816; } \
            else { n0 = 256 * (r_ / 44); k0 = 64 * (r_ % 44); N = 1024; src = c.a->in[I_WD] + (size_t)le * 2816 * 1024; } } while (0)
#define PRO_LOAD() do { _Pragma("unroll") for (int i = 0; i < 8; ++i) v[i] = __builtin_nontemporal_load((const f32x4*)(src + (size_t)(k0 + 8 * c.wave + i) * N + n0 + 4 * c.lane)); } while (0)
        if (nmine > 0) { PRO_DECODE(it); PRO_LOAD(); }
        for (int ii = 0; ii < nmine; ++ii, it += itstep, buf ^= 1) {
            LAS float* img = (LAS float*)(c.lds + buf * 65536);
#pragma unroll
            for (int i = 0; i < 8; ++i) *(LAS f32x4*)(img + (8 * c.wave + i) * 256 + 4 * c.lane) = v[i];
            const int n = n0 + (c.tid & 255), kh = c.tid >> 8;
            unsigned char* dst = which < 2 ? WSP(unsigned char, WS_W1) + ((size_t)le * 5632 + (n / 128) * 256 + (n % 128) + which * 128) * 1024 + k0 + 32 * kh
                                           : WSP(unsigned char, WS_W2) + ((size_t)le * 1024 + n) * 2816 + k0 + 32 * kh;
            if (ii + 1 < nmine) { PRO_DECODE(it + itstep); PRO_LOAD(); }
            __syncthreads();
            const LAS float* s = img + (32 * kh) * 256 + (c.tid & 255);
#pragma unroll
            for (int t = 0; t < 2; ++t) { v4u w;
                w.x = pg8::pk4_fp8(s[(16 * t + 0) * 256] * SC_W, s[(16 * t + 1) * 256] * SC_W, s[(16 * t + 2) * 256] * SC_W, s[(16 * t + 3) * 256] * SC_W);
                w.y = pg8::pk4_fp8(s[(16 * t + 4) * 256] * SC_W, s[(16 * t + 5) * 256] * SC_W, s[(16 * t + 6) * 256] * SC_W, s[(16 * t + 7) * 256] * SC_W);
                w.z = pg8::pk4_fp8(s[(16 * t + 8) * 256] * SC_W, s[(16 * t + 9) * 256] * SC_W, s[(16 * t + 10) * 256] * SC_W, s[(16 * t + 11) * 256] * SC_W);
                w.w = pg8::pk4_fp8(s[(16 * t + 12) * 256] * SC_W, s[(16 * t + 13) * 256] * SC_W, s[(16 * t + 14) * 256] * SC_W, s[(16 * t + 15) * 256] * SC_W);
                *(v4u*)(dst + 16 * t) = w; }
        }
        __syncthreads();
#undef PRO_DECODE
#undef PRO_LOAD
    }
}

__device__ __forceinline__ void ph_adaln0(const Ctx& c) {
    const f32x4* g4 = (const f32x4*)c.a->in[I_NORMG];
    for (int m = c.gw; m < NTOK; m += c.ngw) {
        const f32x4* xr = (const f32x4*)(m < NLAT ? c.a->in[I_X] + (size_t)m * 1024 : c.a->in[I_CTX] + (size_t)(m - NLAT) * 1024);
        const int s = m < NLAT ? m / SEQ : 2;
        const f32x4* mod4 = (const f32x4*)(WSP(float, WS_MOD) + (size_t)s * 6144);
        f32x4 x[4]; float ss = 0.f;
#pragma unroll
        for (int j = 0; j < 4; ++j) { x[j] = xr[c.lane + 64 * j]; ss += (x[j][0] * x[j][0] + x[j][1] * x[j][1]) + (x[j][2] * x[j][2] + x[j][3] * x[j][3]); }
        const float rs = 1.0f / sqrtf(wave_sum(ss) * (1.0f / 1024.0f) + EPS);
        v2u* ho = (v2u*)(WSP(bf16, WS_H) + (size_t)m * 1024);
#pragma unroll
        for (int j = 0; j < 4; ++j) { const int idx = c.lane + 64 * j; const f32x4 o = x[j] * rs * g4[idx] * (mod4[256 + idx] + 1.0f) + mod4[idx];
            v2u pk; pk.x = pk2(o[0], o[1]); pk.y = pk2(o[2], o[3]); ho[idx] = pk; }
    }
}

__device__ __forceinline__ void ph_conv(const Ctx& c) {
    LAS bf16* glu = (LAS bf16*)c.lds;
    LAS float* yb = (LAS float*)(c.lds + 65536);
    const bf16* P = WSP(bf16, WS_PBUF);
    const int ch = c.tid;
    float w[31];
#pragma unroll
    for (int i = 0; i < 31; ++i) w[i] = c.a->in[I_CONVW][i * 512 + ch];
    const float cb = c.a->in[I_CONVB][ch];
    const bool g256 = (c.G == 256); const int nrnd = g256 ? 3 : (NTOK / 32 + (int)c.G - 1) / (int)c.G;
    for (int rnd = 0; rnd < nrnd; ++rnd) {
        const int item = (g256 && rnd == 2) ? 512 + (int)blockIdx.x - 16 : (int)blockIdx.x + rnd * (int)c.G;
        if (item >= NTOK / 32 || item < 0 || (g256 && rnd == 2 && (int)blockIdx.x < 16)) continue;
        const int t0 = item * 32;
        int lo, hi; if (t0 < NLAT) { lo = (t0 / SEQ) * SEQ; hi = lo + SEQ; } else { lo = NLAT + ((t0 - NLAT) / CTXL) * CTXL; hi = lo + CTXL; }
        for (int i = c.tid; i < 62 * 64; i += 512) { const int rr = i >> 6, c8 = (i & 63) * 8, row = t0 - 15 + rr;
            v4u o = {0u, 0u, 0u, 0u};
            if (row >= lo && row < hi) { const v4u a = *(const v4u*)(P + (size_t)row * 2560 + c8), b = *(const v4u*)(P + (size_t)row * 2560 + 512 + c8);
                o.x = pk2(bflo(a.x) * sigmoidf(bflo(b.x)), bfhi(a.x) * sigmoidf(bfhi(b.x))); o.y = pk2(bflo(a.y) * sigmoidf(bflo(b.y)), bfhi(a.y) * sigmoidf(bfhi(b.y)));
                o.z = pk2(bflo(a.z) * sigmoidf(bflo(b.z)), bfhi(a.z) * sigmoidf(bfhi(b.z))); o.w = pk2(bflo(a.w) * sigmoidf(bflo(b.w)), bfhi(a.w) * sigmoidf(bfhi(b.w))); }
            *(LAS v4u*)(glu + rr * 512 + c8) = o; }
        __syncthreads();
        float acc[32];
#pragma unroll
        for (int t = 0; t < 32; ++t) acc[t] = cb;
#pragma unroll
        for (int rr = 0; rr < 62; ++rr) { const float gv = bf2f(glu[rr * 512 + ch]);
#pragma unroll
            for (int t = 0; t < 32; ++t) if (rr - t >= 0 && rr - t <= 30) acc[t] += gv * w[rr - t]; }
#pragma unroll
        for (int t = 0; t < 32; ++t) yb[t * 512 + ch] = acc[t];
        __syncthreads();
#pragma unroll
        for (int tt = 0; tt < 4; ++tt) { const int t = c.wave * 4 + tt;
            const f32x4 v0 = *(const LAS f32x4*)(yb + t * 512 + 8 * c.lane), v1 = *(const LAS f32x4*)(yb + t * 512 + 8 * c.lane + 4);
            const float mu = wave_sum((v0[0] + v0[1]) + (v0[2] + v0[3]) + (v1[0] + v1[1]) + (v1[2] + v1[3])) * (1.0f / 512.0f);
            float q = 0.f; float d[8];
#pragma unroll
            for (int j = 0; j < 4; ++j) { d[j] = v0[j] - mu; d[4 + j] = v1[j] - mu; }
#pragma unroll
            for (int j = 0; j < 8; ++j) q += d[j] * d[j];
            const float rstd = 1.0f / sqrtf(wave_sum(q) * (1.0f / 512.0f) + EPS);
            float o[8];
#pragma unroll
            for (int j = 0; j < 8; ++j) { const int k = 8 * c.lane + j; o[j] = silu(d[j] * rstd * c.a->in[I_CLNG][k] + c.a->in[I_CLNB][k]); }
            v4u pk; pk.x = pk2(o[0], o[1]); pk.y = pk2(o[2], o[3]); pk.z = pk2(o[4], o[5]); pk.w = pk2(o[6], o[7]);
            *(v4u*)(WSP(bf16, WS_MIX) + (size_t)(t0 + t) * 1024 + 8 * c.lane) = pk; }
        __syncthreads();
    }
}

__device__ __forceinline__ void ph_na_naive(const Ctx& c) {
    const bf16* P = WSP(bf16, WS_PBUF);
    const int qc = c.tid & 63, h = c.tid >> 6;
    for (int item = blockIdx.x; item < 256 + 8; item += c.G) {
        int b, r = 0, m; const bool lat = item < 256;
        if (lat) { b = item >> 7; r = item & 127; m = b * SEQ + r * 64 + qc; } else { const int ci = item - 256; b = ci >> 2; m = NLAT + b * CTXL + (ci & 3) * 64 + qc; }
        float q[64], o[64];
        { const bf16* qp = P + (size_t)m * 2560 + 1024 + h * 64;
#pragma unroll
          for (int d = 0; d < 64; d += 8) { const v4u a = *(const v4u*)(qp + d); q[d] = bflo(a.x) * 0.125f; q[d + 1] = bfhi(a.x) * 0.125f; q[d + 2] = bflo(a.y) * 0.125f; q[d + 3] = bfhi(a.y) * 0.125f;
              q[d + 4] = bflo(a.z) * 0.125f; q[d + 5] = bfhi(a.z) * 0.125f; q[d + 6] = bflo(a.w) * 0.125f; q[d + 7] = bfhi(a.w) * 0.125f; } }
#pragma unroll
        for (int d = 0; d < 64; ++d) o[d] = 0.f;
        float mx = -1e30f, l = 0.f;
        const int rs = lat ? min(max(r - 4, 0), 120) : 0, cs = min(max(qc - 8, 0), 48);
        const int nwin = lat ? 128 : 0;
        for (int kk = 0; kk < nwin + 256; ++kk) {
            int tok; float bias = 0.f;
            if (kk < nwin) { const int i = kk >> 4, j = kk & 15; tok = b * SEQ + (rs + i) * 64 + cs + j; bias = c.a->in[I_RPB][(h * 15 + (rs + i - r + 7)) * 31 + (cs + j - qc + 15)]; }
            else tok = NLAT + b * CTXL + (kk - nwin);
            const bf16* kp = P + (size_t)tok * 2560 + 1536 + h * 64; const bf16* vp = kp + 512;
            float s = 0.f;
#pragma unroll
            for (int d = 0; d < 64; d += 8) { const v4u a = *(const v4u*)(kp + d);
                s += q[d] * bflo(a.x) + q[d + 1] * bfhi(a.x) + q[d + 2] * bflo(a.y) + q[d + 3] * bfhi(a.y) + q[d + 4] * bflo(a.z) + q[d + 5] * bfhi(a.z) + q[d + 6] * bflo(a.w) + q[d + 7] * bfhi(a.w); }
            s += bias;
            const float mn = fmaxf(mx, s), al = __expf(mx - mn), p = __expf(s - mn);
            l = l * al + p; mx = mn;
#pragma unroll
            for (int d = 0; d < 64; d += 8) { const v4u a = *(const v4u*)(vp + d);
                o[d] = o[d] * al + p * bflo(a.x); o[d + 1] = o[d + 1] * al + p * bfhi(a.x); o[d + 2] = o[d + 2] * al + p * bflo(a.y); o[d + 3] = o[d + 3] * al + p * bfhi(a.y);
                o[d + 4] = o[d + 4] * al + p * bflo(a.z); o[d + 5] = o[d + 5] * al + p * bfhi(a.z); o[d + 6] = o[d + 6] * al + p * bflo(a.w); o[d + 7] = o[d + 7] * al + p * bfhi(a.w); }
        }
        const float il = 1.0f / l;
        bf16* op = WSP(bf16, WS_MIX) + (size_t)m * 1024 + 512 + h * 64;
#pragma unroll
        for (int d = 0; d < 64; d += 8) { v4u pk; pk.x = pk2(o[d] * il, o[d + 1] * il); pk.y = pk2(o[d + 2] * il, o[d + 3] * il); pk.z = pk2(o[d + 4] * il, o[d + 5] * il); pk.w = pk2(o[d + 6] * il, o[d + 7] * il);
            *(v4u*)(op + d) = pk; }
    }
}

__device__ __forceinline__ void ph_outproj_ctx_tiles(const Ctx& c, size_t ws_wout) {
    for (int t = c.gw; t < 32 * 64; t += c.ngw) { const int mt = t >> 6, nt = t & 63;
        const f32x4 a = wave_tile16(WSP(bf16, WS_MIX) + (size_t)(NLAT + 16 * mt) * 1024, 1024, WSP(bf16, ws_wout) + (size_t)(16 * nt) * 1024, 1024, 1024, c.lane);
        v2u pk; pk.x = pk2(a[0], a[1]); pk.y = pk2(a[2], a[3]);
        *(v2u*)(WSP(bf16, WS_YO) + (size_t)(NLAT + 16 * mt + (c.lane & 15)) * 1024 + 16 * nt + 4 * (c.lane >> 4)) = pk; }
}
__device__ __forceinline__ void ph_inproj_odd_tiles(const Ctx& c) {
    const bf16* H = WSP(bf16, WS_H); const bf16* W = WSP(bf16, WS_WINO);
    for (int t = c.gw; t < 2048 + 32 * 48 + 64; t += c.ngw) {
        if (t < 2048) { const int mt = t >> 1, nt = t & 1;
            const f32x4 a = wave_tile16(H + (size_t)(16 * mt) * 1024, 1024, W + (size_t)(2048 + 16 * nt) * 1024, 1024, 1024, c.lane);
            *(f32x4*)(WSP(float, WS_LR) + (size_t)(16 * mt + (c.lane & 15)) * 32 + 16 * nt + 4 * (c.lane >> 4)) = a; }
        else if (t < 2048 + 32 * 48) { const int u = t - 2048, mt = u / 48, nt = u % 48;
            const f32x4 a = wave_tile16(H + (size_t)(NLAT + 16 * mt) * 1024, 1024, W + (size_t)(768 + 16 * nt) * 1024, 1024, 1024, c.lane);
            v2u pk; pk.x = pk2(a[0], a[1]); pk.y = pk2(a[2], a[3]);
            *(v2u*)(WSP(bf16, WS_PBUF) + (size_t)(NLAT + 16 * mt + (c.lane & 15)) * 2048 + 768 + 16 * nt + 4 * (c.lane >> 4)) = pk; }
        else { const int u = t - 2048 - 32 * 48, mt = u >> 1, nt = u & 1;
            const f32x4 a = wave_tile16(H + (size_t)(NLAT + 16 * mt) * 1024, 1024, W + (size_t)(2048 + 16 * nt) * 1024, 1024, 1024, c.lane);
            *(f32x4*)(WSP(float, WS_LR) + (size_t)(NLAT + 16 * mt + (c.lane & 15)) * 32 + 16 * nt + 4 * (c.lane >> 4)) = a; }
    }
}
__device__ __forceinline__ void ph_pool_tiles(const Ctx& c) {
    for (int t = c.gw; t < 1024 * 32; t += c.ngw) { const int mt = t >> 5, g = (t >> 3) & 3, et = t & 7;
        const f32x4 a = wave_tile16(WSP(bf16, WS_DPOOL) + (size_t)(16 * mt) * 512 + g * 128, 512, WSP(bf16, WS_POOLW) + (size_t)g * 128 * 128 + (size_t)(16 * et) * 128, 128, 128, c.lane);
        const int col = g * 128 + 16 * et + 4 * (c.lane >> 4); const float* sc = c.a->in[I_POOLS] + col;
        v2u pk; pk.x = pk2(a[0] * sc[0], a[1] * sc[1]); pk.y = pk2(a[2] * sc[2], a[3] * sc[3]);
        *(v2u*)(WSP(bf16, WS_MIX) + (size_t)(16 * mt + (c.lane & 15)) * 1024 + col) = pk; }
}

__device__ __forceinline__ void ph_post(const Ctx& c, int layer, int nrows) {
    LAS float* rw = (LAS float*)c.lds;
    { const float* R = c.a->in[I_ROUTER] + (size_t)layer * 1024 * 16;
      for (int i = c.tid; i < 1024 * 16; i += 512) { const int k = i >> 4, e = i & 15, rho = (k & 3) * 256 + ((k >> 8) & 3) * 64 + ((k >> 2) & 63); rw[rho * 16 + 4 * ((e >> 2) ^ ((rho >> 2) & 3)) + (e & 3)] = R[i]; } }
    __syncthreads();
    const f32x4* ng4 = (const f32x4*)(c.a->in[I_NORMG] + (size_t)layer * 4 * 1024);
    const int per = (nrows + c.ngw - 1) / c.ngw, m0 = c.gw * per, m1 = min(m0 + per, nrows);
    const unsigned ln = (unsigned)c.lane;
    if (m0 < m1) {
        int scur = -1;
        f32x4 G1[4], G2[4], M2[4], M3[4], M4[4], xin[4]; v2u yy[4];
#define POST_LOADROW(M) do { const f32x4* xr_ = (const f32x4*)(layer == 0 ? ((M) < NLAT ? c.a->in[I_X] + (size_t)(M) * 1024 : c.a->in[I_CTX] + (size_t)((M) - NLAT) * 1024) : WSP(float, WS_X1) + (size_t)(M) * 1024); \
            const v2u* yr_ = (const v2u*)(WSP(bf16, WS_YO) + (size_t)(M) * 1024); _Pragma("unroll") for (int j = 0; j < 4; ++j) { xin[j] = __builtin_nontemporal_load(xr_ + ln + 64u * j); yy[j] = __builtin_nontemporal_load(yr_ + ln + 64u * j); } } while (0)
        POST_LOADROW(m0);
        for (int m = m0; m < m1; ++m) {
            const int s = m < NLAT ? m / SEQ : 2;
            if (s != scur) { scur = s; const f32x4* mod4 = (const f32x4*)(WSP(float, WS_MOD) + (size_t)(layer * 3 + s) * 6144);
                const f32x4* m2p = mod4 + 512; const f32x4* m3p = mod4 + 768; const f32x4* m4p = mod4 + 1024; const f32x4* g1p = ng4 + 256; const f32x4* g2p = ng4 + 512;
#pragma unroll
                for (int j = 0; j < 4; ++j) { const unsigned idx = ln + 64u * j; G1[j] = g1p[idx]; G2[j] = g2p[idx]; M2[j] = m2p[idx]; M3[j] = m3p[idx]; M4[j] = m4p[idx] + 1.0f; } }
            f32x4 x[4], xi[4]; float ss = 0.f;
#pragma unroll
            for (int j = 0; j < 4; ++j) { x[j] = (f32x4){bflo(yy[j].x), bfhi(yy[j].x), bflo(yy[j].y), bfhi(yy[j].y)}; xi[j] = xin[j]; ss += (x[j][0] * x[j][0] + x[j][1] * x[j][1]) + (x[j][2] * x[j][2] + x[j][3] * x[j][3]); }
            if (m + 1 < m1) POST_LOADROW(m + 1);
            const float ry = 1.0f / sqrtf(wave_sum(ss) * (1.0f / 1024.0f) + EPS);
            float s1 = 0.f;
            f32x4* x1r = (f32x4*)(WSP(float, WS_X1) + (size_t)m * 1024);
#pragma unroll
            for (int j = 0; j < 4; ++j) { x[j] = xi[j] + M2[j] * (x[j] * ry * G1[j]); s1 += (x[j][0] * x[j][0] + x[j][1] * x[j][1]) + (x[j][2] * x[j][2] + x[j][3] * x[j][3]); x1r[ln + 64u * j] = x[j]; }
            const float r1 = 1.0f / sqrtf(wave_sum(s1) * (1.0f / 1024.0f) + EPS);
            unsigned* xo = (unsigned*)(WSP(unsigned char, WS_XN2) + (size_t)m * 1024);
#pragma unroll
            for (int j = 0; j < 4; ++j) { x[j] = x[j] * r1 * G2[j] * M4[j] + M3[j];
                xo[ln + 64u * j] = pg8::pk4_fp8(pg8::clamp448(x[j][0] * SC_X), pg8::clamp448(x[j][1] * SC_X), pg8::clamp448(x[j][2] * SC_X), pg8::clamp448(x[j][3] * SC_X)); }
            float lg[16];
#pragma unroll
            for (int e = 0; e < 16; ++e) lg[e] = 0.f;
#pragma unroll
            for (int j = 0; j < 4; ++j)
#pragma unroll
                for (int t = 0; t < 4; ++t) { const float xn = x[j][t];
                    const LAS float* wr = rw + (t * 256 + 64 * j) * 16 + c.lane * 16; const int sw = (c.lane >> 2) & 3;
                    const f32x4 w0 = *(const LAS f32x4*)(wr + 4 * (0 ^ sw)), w1 = *(const LAS f32x4*)(wr + 4 * (1 ^ sw)), w2 = *(const LAS f32x4*)(wr + 4 * (2 ^ sw)), w3 = *(const LAS f32x4*)(wr + 4 * (3 ^ sw));
#pragma unroll
                    for (int u = 0; u < 4; ++u) { lg[u] += xn * w0[u]; lg[4 + u] += xn * w1[u]; lg[8 + u] += xn * w2[u]; lg[12 + u] += xn * w3[u]; }
                    asm volatile("" ::: "memory"); }
            float a8[8], a4[4], a2[2], a1;
            { const bool hi = (c.lane & 1) != 0;
#pragma unroll
              for (int i = 0; i < 8; ++i) { const float snd = hi ? lg[i] : lg[8 + i]; const float rcv = lane_xor1(snd); a8[i] = (hi ? lg[8 + i] : lg[i]) + rcv; } }
            { const bool hi = (c.lane & 2) != 0;
#pragma unroll
              for (int i = 0; i < 4; ++i) { const float snd = hi ? a8[i] : a8[4 + i]; const float rcv = lane_xor2(snd); a4[i] = (hi ? a8[4 + i] : a8[i]) + rcv; } }
            { const bool hi = (c.lane & 4) != 0;
#pragma unroll
              for (int i = 0; i < 2; ++i) { const float snd = hi ? a4[i] : a4[2 + i]; const float rcv = lane_xor4(snd); a2[i] = (hi ? a4[2 + i] : a4[i]) + rcv; } }
            { const bool hi = (c.lane & 8) != 0; const float snd = hi ? a2[0] : a2[1]; const float rcv = lane_xor8(snd); a1 = (hi ? a2[1] : a2[0]) + rcv; }
            a1 = xor16_sum(a1); a1 = xor32_sum(a1);
            float mx = a1;
            mx = fmaxf(mx, lane_xor1(mx)); mx = fmaxf(mx, lane_xor2(mx)); mx = fmaxf(mx, lane_xor4(mx)); mx = fmaxf(mx, lane_xor8(mx));
            const float ex = expf(a1 - mx); float den = ex;
            den = row16_sum(den);
            const int eidx = ((c.lane & 1) << 3) | ((c.lane & 2) << 1) | ((c.lane & 4) >> 1) | ((c.lane & 8) >> 3);
            if (c.lane < 16) WSP(float, WS_AFF)[(size_t)m * 16 + eidx] = ex / den;
        }
#undef POST_LOADROW
    }
    __syncthreads();
}

__device__ __forceinline__ void ph_topk_gather(const Ctx& c, int nlat_tasks, int nctx_lists) {
    LAS unsigned* keys = (LAS unsigned*)c.lds;
    LAS int* hist = (LAS int*)(c.lds + 32768);
    LAS int* cg = (LAS int*)(c.lds + 32768 + 1024);
    LAS int* ce = cg + 512;
    LAS unsigned* ctl = (LAS unsigned*)(ce + 512);
    LAS int* slot_tok = (LAS int*)(c.lds + 40960);
    const float* aff = WSP(float, WS_AFF); int* inv = WSP(int, WS_INV); int* rowtok = WSP(int, WS_ROWTOK);
    for (int task = blockIdx.x; task < nlat_tasks + nctx_lists; task += c.G) {
        int n, cap, tok0, rowbase, e, part, nparts;
        if (task < nlat_tasks) { const int lid = task >> 3; part = task & 7; nparts = 8; const int b = lid >> 4; e = lid & 15; n = SEQ; cap = 1024; tok0 = b * SEQ; rowbase = e * 2048 + b * 1024; }
        else { const int lid = task - nlat_tasks; part = 0; nparts = 1; const int b = lid >> 4; e = lid & 15; n = CTXL; cap = 32; tok0 = NLAT + b * CTXL; rowbase = MOE_LAT + e * 256 + b * 32; }
        const int cpt = n / 512 > 0 ? n / 512 : 1;
        for (int i = c.tid; i < n; i += 512) keys[i] = __builtin_bit_cast(unsigned, aff[(size_t)(tok0 + i) * 16 + e]);
        if (n <= 512) {
            __syncthreads();
            if (c.tid < n) { const unsigned key = keys[c.tid]; int rank = 0;
                for (int j = 0; j < n; ++j) { const unsigned kj = keys[j]; rank += (kj > key || (kj == key && j < c.tid)) ? 1 : 0; }
                const int slot = rank < cap ? rank : -1;
                if (slot >= 0) slot_tok[slot] = tok0 + c.tid;
                inv[(size_t)(tok0 + c.tid) * 16 + e] = slot >= 0 ? rowbase + slot : -1; if (slot >= 0) rowtok[rowbase + slot] = tok0 + c.tid; }
        } else {
        if (c.tid == 0) { ctl[0] = 0u; ctl[1] = (unsigned)cap; }
        __syncthreads();
        for (int pass = 0; pass < 4; ++pass) {
            const int shift = 24 - 8 * pass;
            if (c.tid < 256) hist[c.tid] = 0;
            __syncthreads();
            const unsigned prefix = ctl[0];
            for (int i = c.tid; i < n; i += 512) { const unsigned k = keys[i]; if (pass == 0 || (k >> (shift + 8)) == prefix) __hip_atomic_fetch_add(&hist[(k >> shift) & 255u], 1, __ATOMIC_RELAXED, __HIP_MEMORY_SCOPE_WORKGROUP); }
            __syncthreads();
            if (c.wave == 0) {
                const int kth = (int)ctl[1];
                const int h0 = hist[4 * c.lane], h1 = hist[4 * c.lane + 1], h2 = hist[4 * c.lane + 2], h3 = hist[4 * c.lane + 3];
                const int mine = h0 + h1 + h2 + h3;
                int suf = mine;
#pragma unroll
                for (int o = 1; o < 64; o <<= 1) { const int t = __shfl_down(suf, o); if (c.lane + o < 64) suf += t; }
                const int above = suf - mine;
                if (above < kth && suf >= kth) {
                    int cum = above, sel, rem;
                    if (cum + h3 >= kth) { sel = 3; rem = kth - cum; } else { cum += h3;
                    if (cum + h2 >= kth) { sel = 2; rem = kth - cum; } else { cum += h2;
                    if (cum + h1 >= kth) { sel = 1; rem = kth - cum; } else { cum += h1; sel = 0; rem = kth - cum; } } }
                    ctl[0] = (prefix << 8) | (unsigned)(4 * c.lane + sel); ctl[1] = (unsigned)rem; }
            }
            __syncthreads();
        }
        const unsigned T = ctl[0]; const int need_eq = (int)ctl[1]; const int ngt = cap - need_eq;
        { int g = 0, q = 0;
          for (int j = 0; j < cpt; ++j) { const int i = c.tid * cpt + j; if (i < n) { const unsigned k = keys[i]; g += (k > T); q += (k == T); } }
          cg[c.tid] = g; ce[c.tid] = q; }
        __syncthreads();
        if (c.wave == 0) {
            int g[8], q[8], sg = 0, sq = 0;
#pragma unroll
            for (int j = 0; j < 8; ++j) { g[j] = cg[c.lane * 8 + j]; q[j] = ce[c.lane * 8 + j]; sg += g[j]; sq += q[j]; }
            int ig = sg, iq = sq;
#pragma unroll
            for (int o = 1; o < 64; o <<= 1) { const int tg = __shfl_up(ig, o), tq = __shfl_up(iq, o); if (c.lane >= o) { ig += tg; iq += tq; } }
            int eg = ig - sg, eq = iq - sq;
#pragma unroll
            for (int j = 0; j < 8; ++j) { cg[c.lane * 8 + j] = eg; ce[c.lane * 8 + j] = eq; eg += g[j]; eq += q[j]; }
        }
        __syncthreads();
        { int g = cg[c.tid], q = ce[c.tid];
          for (int j = 0; j < cpt; ++j) { const int i = c.tid * cpt + j; if (i < n) { const unsigned k = keys[i]; int slot = -1;
              if (k > T) { slot = g; ++g; } else if (k == T) { if (q < need_eq) slot = ngt + q; ++q; }
              if (slot >= 0) slot_tok[slot] = tok0 + i;
              if (part == 0) { inv[(size_t)(tok0 + i) * 16 + e] = slot >= 0 ? rowbase + slot : -1; if (slot >= 0) rowtok[rowbase + slot] = tok0 + i; } } } }
        }
        __syncthreads();
        { const int per = cap / nparts, s0 = part * per;
          for (int base = s0 + c.wave; base < s0 + per; base += NWAVES * 8) { v4u vals[8]; int sls[8];
#pragma unroll
              for (int u = 0; u < 8; ++u) { const int sl = base + NWAVES * u; sls[u] = sl; if (sl < s0 + per) { const int tok = slot_tok[sl]; vals[u] = ((const v4u*)(WSP(unsigned char, WS_XN2) + (size_t)tok * 1024))[c.lane]; } }
#pragma unroll
              for (int u = 0; u < 8; ++u) if (sls[u] < s0 + per) ((v4u*)(WSP(unsigned char, WS_XG) + (size_t)(rowbase + sls[u]) * 1024))[c.lane] = vals[u]; } }
        if (task >= nlat_tasks && task < nlat_tasks + 16) {
            for (int i = 64 + c.wave; i < 256; i += NWAVES) { ((v4u*)(WSP(unsigned char, WS_XG) + (size_t)(MOE_LAT + e * 256 + i) * 1024))[c.lane] = (v4u){0u, 0u, 0u, 0u}; if (c.lane == 0) rowtok[MOE_LAT + e * 256 + i] = -1; } }
        __syncthreads();
    }
}

__device__ __forceinline__ void ph_combine(const Ctx& c, int layer, int nrows) {
    const float* ng = c.a->in[I_NORMG] + (size_t)layer * 4 * 1024;
    const int per = (nrows + c.ngw - 1) / c.ngw, m0 = c.gw * per, m1 = min(m0 + per, nrows);
    const unsigned ln = (unsigned)c.lane;
    if (m0 < m1) {
        int scur = -1;
        f32x4 G3[2][2], M5[2][2], GN[2][2], MS[2][2], MH[2][2];
        int inv_n; float aff_n; f32x4 x1n[2][2];
#define CMB_LOADROW(M) do { inv_n = ln < 16u ? WSP(int, WS_INV)[(size_t)(M) * 16 + ln] : -1; aff_n = ln < 16u ? WSP(float, WS_AFF)[(size_t)(M) * 16 + ln] : 0.f; \
            const f32x4* xr_ = (const f32x4*)(WSP(float, WS_X1) + (size_t)(M) * 1024); _Pragma("unroll") for (int j = 0; j < 2; ++j) { x1n[j][0] = xr_[2u * ln + 128u * j]; x1n[j][1] = xr_[2u * ln + 128u * j + 1u]; } } while (0)
        CMB_LOADROW(m0);
        for (int m = m0; m < m1; ++m) {
            const int s = m < NLAT ? m / SEQ : 2;
            if (s != scur) { scur = s; const f32x4* mod4 = (const f32x4*)(WSP(float, WS_MOD) + (size_t)(layer * 3 + s) * 6144); const f32x4* g34 = (const f32x4*)(ng + 3 * 1024);
                const f32x4* gn4 = (const f32x4*)(c.a->in[I_NORMG] + (size_t)4 * 1024); const f32x4* mn4 = (const f32x4*)(WSP(float, WS_MOD) + (size_t)(3 + s) * 6144);
#pragma unroll
                for (int j = 0; j < 2; ++j)
#pragma unroll
                    for (int hh = 0; hh < 2; ++hh) { const unsigned idx = 2u * ln + 128u * j + hh; G3[j][hh] = g34[idx]; M5[j][hh] = (mod4 + 1280)[idx];
                        if (layer == 0) { GN[j][hh] = gn4[idx]; MS[j][hh] = (mn4 + 256)[idx] + 1.0f; MH[j][hh] = mn4[idx]; } } }
            const int myinv = inv_n; const float myaff = aff_n; f32x4 x1c[2][2];
#pragma unroll
            for (int j = 0; j < 2; ++j) { x1c[j][0] = x1n[j][0]; x1c[j][1] = x1n[j][1]; }
            if (m + 1 < m1) CMB_LOADROW(m + 1);
            float f[16];
#pragma unroll
            for (int i = 0; i < 16; ++i) f[i] = 0.f;
            unsigned long long mask = __ballot(myinv >= 0);
            while (mask) {
                int rows[4]; float as[4]; v4u v[4][2];
#pragma unroll
                for (int u = 0; u < 4; ++u) { rows[u] = -1; as[u] = 0.f;
                    if (mask) { const int e = __builtin_ctzll(mask); mask &= mask - 1; rows[u] = __shfl(myinv, e); as[u] = __shfl(myaff, e); } }
#pragma unroll
                for (int u = 0; u < 4; ++u) if (rows[u] >= 0) { const v4u* src = (const v4u*)(WSP(bf16, WS_Y) + (size_t)rows[u] * 1024); v[u][0] = __builtin_nontemporal_load(src + ln); v[u][1] = __builtin_nontemporal_load(src + ln + 64u); }
#pragma unroll
                for (int u = 0; u < 4; ++u) if (rows[u] >= 0) { const float a = as[u];
#pragma unroll
                    for (int j = 0; j < 2; ++j) { const v4u w = v[u][j];
                        f[8 * j + 0] += a * bflo(w.x); f[8 * j + 1] += a * bfhi(w.x); f[8 * j + 2] += a * bflo(w.y); f[8 * j + 3] += a * bfhi(w.y);
                        f[8 * j + 4] += a * bflo(w.z); f[8 * j + 5] += a * bfhi(w.z); f[8 * j + 6] += a * bflo(w.w); f[8 * j + 7] += a * bfhi(w.w); } }
            }
            float ss = 0.f;
#pragma unroll
            for (int i = 0; i < 16; ++i) ss += f[i] * f[i];
            const float rf = 1.0f / sqrtf(wave_sum(ss) * (1.0f / 1024.0f) + EPS);
            f32x4 x[2][2]; float s2 = 0.f;
#pragma unroll
            for (int j = 0; j < 2; ++j)
#pragma unroll
                for (int hh = 0; hh < 2; ++hh) { const f32x4 fv = (f32x4){f[8 * j + 4 * hh], f[8 * j + 4 * hh + 1], f[8 * j + 4 * hh + 2], f[8 * j + 4 * hh + 3]};
                    x[j][hh] = x1c[j][hh] + M5[j][hh] * (fv * rf * G3[j][hh]); s2 += (x[j][hh][0] * x[j][hh][0] + x[j][hh][1] * x[j][hh][1]) + (x[j][hh][2] * x[j][hh][2] + x[j][hh][3] * x[j][hh][3]); }
            if (layer == 0) {
                const float r2 = 1.0f / sqrtf(wave_sum(s2) * (1.0f / 1024.0f) + EPS);
                f32x4* x1r = (f32x4*)(WSP(float, WS_X1) + (size_t)m * 1024); v4u* ho = (v4u*)(WSP(bf16, WS_H) + (size_t)m * 1024);
#pragma unroll
                for (int j = 0; j < 2; ++j) { x1r[2u * ln + 128u * j] = x[j][0]; x1r[2u * ln + 128u * j + 1u] = x[j][1];
                    const f32x4 o0 = x[j][0] * r2 * GN[j][0] * MS[j][0] + MH[j][0], o1 = x[j][1] * r2 * GN[j][1] * MS[j][1] + MH[j][1];
                    v4u pk; pk.x = pk2(o0[0], o0[1]); pk.y = pk2(o0[2], o0[3]); pk.z = pk2(o1[0], o1[1]); pk.w = pk2(o1[2], o1[3]); ho[ln + 64u * j] = pk; }
            } else {
                f32x4* orow = (f32x4*)(c.out + (size_t)m * 1024);
#pragma unroll
                for (int j = 0; j < 2; ++j) { orow[2u * ln + 128u * j] = x[j][0]; orow[2u * ln + 128u * j + 1u] = x[j][1]; }
            }
        }
#undef CMB_LOADROW
    }
}

__device__ __forceinline__ void ph_prep_odd(const Ctx& c) {
    const bf16* P = WSP(bf16, WS_PBUF);
    for (int it = blockIdx.x * 512 + c.tid; it < NLAT * 64; it += c.G * 512) {
        const int m = it >> 6, c8 = (it & 63) * 8, t = m & (SEQ - 1), b0 = m - t;
        const int win = 2 << (c8 >> 7), lo = max(t - win / 2, 0), hi = min(t + win / 2, SEQ);
        float sum[8];
#pragma unroll
        for (int j = 0; j < 8; ++j) sum[j] = 0.f;
        for (int tt = lo; tt < hi; ++tt) { const v4u a = *(const v4u*)(P + (size_t)(b0 + tt) * 2048 + c8);
            sum[0] += bflo(a.x); sum[1] += bfhi(a.x); sum[2] += bflo(a.y); sum[3] += bfhi(a.y); sum[4] += bflo(a.z); sum[5] += bfhi(a.z); sum[6] += bflo(a.w); sum[7] += bfhi(a.w); }
        const v4u a = *(const v4u*)(P + (size_t)m * 2048 + c8); const float inv = 1.0f / (float)(hi - lo);
        v4u o; o.x = pk2(sum[0] * inv - bflo(a.x), sum[1] * inv - bfhi(a.x)); o.y = pk2(sum[2] * inv - bflo(a.y), sum[3] * inv - bfhi(a.y));
        o.z = pk2(sum[4] * inv - bflo(a.z), sum[5] * inv - bfhi(a.z)); o.w = pk2(sum[6] * inv - bflo(a.w), sum[7] * inv - bfhi(a.w));
        *(v4u*)(WSP(bf16, WS_DPOOL) + (size_t)m * 512 + c8) = o;
    }
    const int hd = c.tid & 255, d = hd & 63;
    float gw0[16], gw1[16];
#pragma unroll
    for (int r = 0; r < 16; ++r) { gw0[r] = c.a->in[I_GATEW][r * 256 + hd]; gw1[r] = c.a->in[I_GATEW][(16 + r) * 256 + hd]; }
    const float gb0 = c.a->in[I_GATEB][hd], gb1 = c.a->in[I_GATEB][256 + hd];
    const float* rope = WSP(float, WS_ROPE);
    for (int m = blockIdx.x * 2 + (c.tid >> 8); m < NTOK; m += c.G * 2) {
        const float* lr = WSP(float, WS_LR) + (size_t)m * 32;
        float z0 = gb0, z1 = gb1;
#pragma unroll
        for (int r = 0; r < 16; ++r) { z0 += lr[r] * gw0[r]; z1 += lr[16 + r] * gw1[r]; }
        const float l0 = fminf(z0, 0.f) - log1pf(expf(-fabsf(z0))), l1 = fminf(z1, 0.f) - log1pf(expf(-fabsf(z1)));
        WSP(float, WS_GF)[(size_t)m * 256 + hd] = l0 * (1.0f / 16.0f); WSP(float, WS_GB)[(size_t)m * 256 + hd] = l1 * (1.0f / 16.0f);
        const bf16* pr = P + (size_t)m * 2048;
        if (m < NLAT) {
            const int t = m & (SEQ - 1), pos = (d & 32) ? 128 + (t & 63) : (t >> 6), f = d & 15;
            const float cs = rope[(pos * 16 + f) * 2], sn = rope[(pos * 16 + f) * 2 + 1];
            const int d1 = hd & ~16, d2 = hd | 16;
            const float q1 = bf2f(pr[512 + d1]), q2 = bf2f(pr[512 + d2]), k1 = bf2f(pr[768 + d1]), k2 = bf2f(pr[768 + d2]);
            const bool second = (d & 16) != 0;
            WSP(float, WS_QR)[(size_t)m * 256 + hd] = (second ? q1 * sn + q2 * cs : q1 * cs - q2 * sn) * 0.125f;
            WSP(float, WS_KR)[(size_t)m * 256 + hd] = second ? k1 * sn + k2 * cs : k1 * cs - k2 * sn;
        } else WSP(float, WS_KR)[(size_t)m * 256 + hd] = bf2f(pr[768 + hd]);
    }
}

__device__ __forceinline__ void ph_gla_naive(const Ctx& c) {
    const bf16* P = WSP(bf16, WS_PBUF);
    for (int item = blockIdx.x; item < 256; item += c.G) {
        const int es = item & 15, dir = (item >> 4) & 1, h = (item >> 5) & 3, b = item >> 7;
        const int e = es * 8 + c.wave, d = c.lane;
        const float* G = dir ? WSP(float, WS_GB) : WSP(float, WS_GF);
        float* O = WSP(float, WS_OACC) + (size_t)dir * NLAT * 512;
        float S = 0.f;
        for (int blk = 0; blk < (CTXL + SEQ) / 8; ++blk) {
            float gg[8], kk[8], vv[8], qq[8]; int mm[8];
#pragma unroll
            for (int j = 0; j < 8; ++j) { const int step = blk * 8 + j; int m;
                if (step < CTXL) m = NLAT + b * CTXL + (dir ? CTXL - 1 - step : step); else { const int t = step - CTXL; m = b * SEQ + (dir ? SEQ - 1 - t : t); }
                mm[j] = m; gg[j] = G[(size_t)m * 256 + h * 64 + d]; kk[j] = WSP(float, WS_KR)[(size_t)m * 256 + h * 64 + d]; vv[j] = bf2f(P[(size_t)m * 2048 + 1024 + h * 128 + e]);
                qq[j] = m < NLAT ? WSP(float, WS_QR)[(size_t)m * 256 + h * 64 + d] : 0.f; }
#pragma unroll
            for (int j = 0; j < 8; ++j) { S = expf(gg[j]) * S + kk[j] * vv[j];
                if (blk >= CTXL / 8) { const float o = wave_sum(qq[j] * S); if (c.lane == 0) O[(size_t)mm[j] * 512 + h * 128 + e] = o; } }
        }
    }
}
__device__ __forceinline__ void ph_gla_out(const Ctx& c) {
    for (int m = c.gw; m < NLAT; m += c.ngw) {
        const float* o0 = WSP(float, WS_OACC) + (size_t)m * 512 + 8 * c.lane; const float* o1 = o0 + (size_t)NLAT * 512;
        float o[8]; float ss = 0.f;
#pragma unroll
        for (int j = 0; j < 8; ++j) { o[j] = o0[j] + o1[j]; ss += o[j] * o[j]; }
        ss = row16_sum(ss);
        const float rn = 1.0f / sqrtf(ss * (1.0f / 128.0f) + EPS);
        const v4u rr = *(const v4u*)(WSP(bf16, WS_PBUF) + (size_t)m * 2048 + 1536 + 8 * c.lane);
        const float r[8] = {bflo(rr.x), bfhi(rr.x), bflo(rr.y), bfhi(rr.y), bflo(rr.z), bfhi(rr.z), bflo(rr.w), bfhi(rr.w)};
        float v[8];
#pragma unroll
        for (int j = 0; j < 8; ++j) v[j] = o[j] * rn * c.a->in[I_HEADG][8 * c.lane + j] * silu(r[j]);
        v4u pk; pk.x = pk2(v[0], v[1]); pk.y = pk2(v[2], v[3]); pk.z = pk2(v[4], v[5]); pk.w = pk2(v[6], v[7]);
        *(v4u*)(WSP(bf16, WS_MIX) + (size_t)m * 1024 + 512 + 8 * c.lane) = pk;
    }
}

constexpr int GP = 72, GVP = 136;
typedef short s16x4_t __attribute__((ext_vector_type(4)));
constexpr int GP_unused = 0;
__device__ __forceinline__ bf16x8 mk8(v2u lo, v2u hi) { v4u t; t.x = lo.x; t.y = lo.y; t.z = hi.x; t.w = hi.y; return __builtin_bit_cast(bf16x8, t); }

__device__ __forceinline__ float logsig16(float z) { return (fminf(z, 0.f) - __logf(1.0f + __expf(-fabsf(z)))) * (1.0f / 16.0f); }
__device__ __forceinline__ void ph_gla_g1(const Ctx& c) {
    LAS bf16* keT = (LAS bf16*)c.lds;
    LAS bf16* vL = keT + 2 * 64 * GP;
    LAS float* tot = (LAS float*)(vL + 64 * GVP);
    LAS float* lrL = tot + 2 * 8 * 64;
    LAS bf16* kL = (LAS bf16*)(lrL + 64 * 32);
    LAS bf16* qL = kL + 64 * 64;
    LAS bf16* qkL = qL + 64 * 64;
    const bf16* P = WSP(bf16, WS_PBUF);
    const float* rope = WSP(float, WS_ROPE);
    const int d = c.tid & 63, tg = c.tid >> 6, q = c.lane >> 4, l15 = c.lane & 15;
    const int d1 = d & ~16, d2 = d | 16, fi = d & 15; const bool second = (d & 16) != 0, colhalf = (d & 32) != 0;
    for (int item = blockIdx.x; item < 2 * 4 * 132; item += c.G) {
        const int cidx = item % 132, h = (item / 132) & 3, b = item / (132 * 4);
        const bool lat = cidx >= 4;
        const int m0 = lat ? b * SEQ + 64 * (cidx - 4) : NLAT + b * CTXL + 64 * cidx;
        { const f32x4* src = (const f32x4*)(WSP(float, WS_LR) + (size_t)m0 * 32); ((LAS f32x4*)lrL)[c.tid] = src[c.tid];
          const int row = c.tid >> 3, ch = c.tid & 7; const bf16* pr = P + (size_t)(m0 + row) * 2048 + h * 64 + 8 * ch;
          *(LAS v4u*)(kL + row * 64 + 8 * ch) = *(const v4u*)(pr + 768); if (lat) *(LAS v4u*)(qL + row * 64 + 8 * ch) = *(const v4u*)(pr + 512);
#pragma unroll
          for (int r2 = 0; r2 < 2; ++r2) { const int id = c.tid + 512 * r2, vr = id >> 4, vc = id & 15; *(LAS v4u*)(vL + vr * GVP + 8 * vc) = *(const v4u*)(P + (size_t)(m0 + vr) * 2048 + 1024 + h * 128 + 8 * vc); } }
        float gw0[16], gw1[16];
#pragma unroll
        for (int r = 0; r < 16; ++r) { gw0[r] = c.a->in[I_GATEW][r * 256 + h * 64 + d]; gw1[r] = c.a->in[I_GATEW][(16 + r) * 256 + h * 64 + d]; }
        const float gb0 = c.a->in[I_GATEB][h * 64 + d], gb1 = c.a->in[I_GATEB][256 + h * 64 + d];
        float csr = 1.f, snr = 0.f; if (lat && !colhalf) { csr = rope[((cidx - 4) * 16 + fi) * 2]; snr = rope[((cidx - 4) * 16 + fi) * 2 + 1]; }
        __syncthreads();
        float pf[8], pb[8];
#pragma unroll
        for (int j = 0; j < 8; ++j) { const LAS float* lr = lrL + (8 * tg + j) * 32; float z0 = gb0, z1 = gb1;
#pragma unroll
            for (int r = 0; r < 16; ++r) { z0 += lr[r] * gw0[r]; z1 += lr[16 + r] * gw1[r]; }
            pf[j] = logsig16(z0); pb[j] = logsig16(z1); }
#pragma unroll
        for (int j = 1; j < 8; ++j) pf[j] += pf[j - 1];
#pragma unroll
        for (int j = 6; j >= 0; --j) pb[j] += pb[j + 1];
        tot[(0 * 8 + tg) * 64 + d] = pf[7]; tot[(1 * 8 + tg) * 64 + d] = pb[0];
        __syncthreads();
        float offf = 0.f, offb = 0.f, Bf = 0.f, Bb = 0.f;
#pragma unroll
        for (int g = 0; g < 8; ++g) { const float tf = tot[g * 64 + d], tb = tot[(8 + g) * 64 + d]; Bf += tf; Bb += tb; offf += g < tg ? tf : 0.f; offb += g > tg ? tb : 0.f; }
        float kef[8], keb[8];
#pragma unroll
        for (int j = 0; j < 8; ++j) { const int tj = 8 * tg + j; const float bfj = offf + pf[j], bbj = offb + pb[j];
            float kv, qv = 0.f;
            if (lat) { float cs = csr, sn = snr; if (colhalf) { cs = rope[((128 + tj) * 16 + fi) * 2]; sn = rope[((128 + tj) * 16 + fi) * 2 + 1]; }
                const float k1 = bf2f(kL[tj * 64 + d1]), k2 = bf2f(kL[tj * 64 + d2]), q1 = bf2f(qL[tj * 64 + d1]), q2 = bf2f(qL[tj * 64 + d2]);
                kv = second ? k1 * sn + k2 * cs : k1 * cs - k2 * sn; qv = (second ? q1 * sn + q2 * cs : q1 * cs - q2 * sn) * 0.125f; }
            else kv = bf2f(kL[tj * 64 + d]);
            kef[j] = kv * __expf(Bf - bfj); keb[j] = kv * __expf(Bb - bbj);
            if (lat) { qkL[(0 * 64 + tj) * 64 + d] = (bf16)f2bf(qv * __expf(bfj)); qkL[(1 * 64 + tj) * 64 + d] = (bf16)f2bf(kv * __expf(-bfj));
                qkL[(2 * 64 + tj) * 64 + d] = (bf16)f2bf(qv * __expf(bbj)); qkL[(3 * 64 + tj) * 64 + d] = (bf16)f2bf(kv * __expf(-bbj)); } }
        { v4u w; w.x = pk2(kef[0], kef[1]); w.y = pk2(kef[2], kef[3]); w.z = pk2(kef[4], kef[5]); w.w = pk2(kef[6], kef[7]); *(LAS v4u*)(keT + (size_t)d * GP + 8 * tg) = w;
          w.x = pk2(keb[0], keb[1]); w.y = pk2(keb[2], keb[3]); w.z = pk2(keb[4], keb[5]); w.w = pk2(keb[6], keb[7]); *(LAS v4u*)(keT + (size_t)(64 + d) * GP + 8 * tg) = w; }
        if (tg == 0) { float* DCp = WSP(float, WS_DC);
            DCp[((size_t)(0 * 8 + b * 4 + h) * 132 + cidx) * 64 + d] = __expf(Bf); DCp[((size_t)(1 * 8 + b * 4 + h) * 132 + cidx) * 64 + d] = __expf(Bb); }
        __syncthreads();
        if (lat) {
#pragma unroll
            for (int r2 = 0; r2 < 4; ++r2) { const int id = c.tid + 512 * r2, arr = id >> 9, row = (id >> 3) & 63, ch = id & 7;
                bf16* dst = ((arr & 1) ? WSP(bf16, WS_KD) : WSP(bf16, WS_QE)) + (size_t)(arr >> 1) * NLAT * 256 + (size_t)(m0 + row) * 256 + h * 64 + 8 * ch;
                *(v4u*)dst = *(const LAS v4u*)(qkL + (arr * 64 + row) * 64 + 8 * ch); } }
        { const LAS bf16* vb = vL + (size_t)(8 * q + (l15 >> 2)) * GVP + 16 * c.wave + 4 * (l15 & 3);
          const bf16x8 av0 = mk8(__builtin_bit_cast(v2u, __builtin_amdgcn_ds_read_tr16_b64_v4i16((LAS s16x4_t*)vb)), __builtin_bit_cast(v2u, __builtin_amdgcn_ds_read_tr16_b64_v4i16((LAS s16x4_t*)(vb + 4 * GVP))));
          const bf16x8 av1 = mk8(__builtin_bit_cast(v2u, __builtin_amdgcn_ds_read_tr16_b64_v4i16((LAS s16x4_t*)(vb + 32 * GVP))), __builtin_bit_cast(v2u, __builtin_amdgcn_ds_read_tr16_b64_v4i16((LAS s16x4_t*)(vb + 36 * GVP))));
#pragma unroll
          for (int dir = 0; dir < 2; ++dir)
#pragma unroll
            for (int dt = 0; dt < 4; ++dt) {
                const bf16x8 b0 = *(const LAS bf16x8*)(keT + (size_t)(dir * 64 + 16 * dt + l15) * GP + 8 * q), b1 = *(const LAS bf16x8*)(keT + (size_t)(dir * 64 + 16 * dt + l15) * GP + 32 + 8 * q);
                f32x4 acc = {0.f, 0.f, 0.f, 0.f};
                acc = __builtin_amdgcn_mfma_f32_16x16x32_bf16(av0, b0, acc, 0, 0, 0); acc = __builtin_amdgcn_mfma_f32_16x16x32_bf16(av1, b1, acc, 0, 0, 0);
                float* U = WSP(float, WS_UT) + ((size_t)(dir * 8 + b * 4 + h) * 132 + cidx) * 8192 + (size_t)(16 * c.wave + 4 * q) * 64 + 16 * dt + l15;
#pragma unroll
                for (int r = 0; r < 4; ++r) U[r * 64] = acc[r]; } }
        __syncthreads();
    }
}

constexpr int PP = 520;
__device__ __forceinline__ void ph_pool(const Ctx& c) {
    LAS bf16* uL = (LAS bf16*)c.lds;
    const bf16* P = WSP(bf16, WS_PBUF);
    const int q = c.lane >> 4, l15 = c.lane & 15;
    for (int item = blockIdx.x; item < NLAT / 64; item += c.G) {
        const int mbase = item * 64, tb = mbase & (SEQ - 1);
        for (int i = c.tid; i < 80 * 64; i += 512) { const int r = i >> 6, c8 = (i & 63) * 8, t = tb - 8 + r;
            v4u a = {0u, 0u, 0u, 0u}; if (t >= 0 && t < SEQ) a = *(const v4u*)(P + (size_t)(mbase - 8 + r) * 2048 + c8);
            *(LAS v4u*)(uL + r * PP + c8) = a; }
        __syncthreads();
        v4u dv[8];
#pragma unroll
        for (int i = 0; i < 8; ++i) { const int id = c.tid + 512 * i, tt = id >> 6, c8 = (id & 63) * 8, t = tb + tt;
            const int hw = 1 << (c8 >> 7), lo = max(t - hw, 0), hi = min(t + hw, SEQ);
            float sum[8];
#pragma unroll
            for (int j = 0; j < 8; ++j) sum[j] = 0.f;
            for (int u = -hw; u < hw; ++u) { const v4u a = *(const LAS v4u*)(uL + (tt + 8 + u) * PP + c8);
                sum[0] += bflo(a.x); sum[1] += bfhi(a.x); sum[2] += bflo(a.y); sum[3] += bfhi(a.y); sum[4] += bflo(a.z); sum[5] += bfhi(a.z); sum[6] += bflo(a.w); sum[7] += bfhi(a.w); }
            const v4u a = *(const LAS v4u*)(uL + (tt + 8) * PP + c8); const float inv = 1.0f / (float)(hi - lo);
            dv[i].x = pk2(sum[0] * inv - bflo(a.x), sum[1] * inv - bfhi(a.x)); dv[i].y = pk2(sum[2] * inv - bflo(a.y), sum[3] * inv - bfhi(a.y));
            dv[i].z = pk2(sum[4] * inv - bflo(a.z), sum[5] * inv - bfhi(a.z)); dv[i].w = pk2(sum[6] * inv - bflo(a.w), sum[7] * inv - bfhi(a.w)); }
        __syncthreads();
#pragma unroll
        for (int i = 0; i < 8; ++i) { const int id = c.tid + 512 * i, tt = id >> 6, c8 = (id & 63) * 8; *(LAS v4u*)(uL + (tt + 8) * PP + c8) = dv[i]; }
        __syncthreads();
        for (int i = 0; i < 16; ++i) { const int tl = c.wave + 8 * i, mt = tl >> 5, g = (tl >> 3) & 3, et = tl & 7;
            const LAS bf16* ap = uL + (8 + 16 * mt + l15) * PP + g * 128 + 8 * q; const bf16* bp = WSP(bf16, WS_POOLW) + (size_t)g * 128 * 128 + (size_t)(16 * et + l15) * 128 + 8 * q;
            f32x4 acc = {0.f, 0.f, 0.f, 0.f};
#pragma unroll
            for (int ks = 0; ks < 4; ++ks) acc = __builtin_amdgcn_mfma_f32_16x16x32_bf16(*(const bf16x8*)(bp + 32 * ks), *(const LAS bf16x8*)(ap + 32 * ks), acc, 0, 0, 0);
            const int col = g * 128 + 16 * et + 4 * q; const float* sc = c.a->in[I_POOLS] + col;
            v2u pk; pk.x = pk2(acc[0] * sc[0], acc[1] * sc[1]); pk.y = pk2(acc[2] * sc[2], acc[3] * sc[3]);
            *(v2u*)(WSP(bf16, WS_MIX) + (size_t)(mbase + 16 * mt + l15) * 1024 + col) = pk; }
        __syncthreads();
    }
}

__device__ __forceinline__ void ph_gla_g2(const Ctx& c) {
    for (int el = blockIdx.x * 512 + c.tid; el < 16 * 8192; el += c.G * 512) {
        const int combo = el >> 13, ed = el & 8191, d = ed & 63, dir = combo >> 3;
        const float* U = WSP(float, WS_UT) + (size_t)combo * 132 * 8192 + ed; const float* Dp = WSP(float, WS_DC) + (size_t)combo * 132 * 64 + d;
        bf16* So = WSP(bf16, WS_ST) + (size_t)combo * 128 * 8192 + ed;
        float S = 0.f;
        for (int s4 = 0; s4 < 132; s4 += 4) {
            float u[4], dd[4]; int ci[4];
#pragma unroll
            for (int j = 0; j < 4; ++j) { const int step = s4 + j; ci[j] = dir == 0 ? step : (step < 4 ? 3 - step : 135 - step); u[j] = __builtin_nontemporal_load(U + (size_t)ci[j] * 8192); dd[j] = Dp[ci[j] * 64]; }
#pragma unroll
            for (int j = 0; j < 4; ++j) { if (ci[j] >= 4) So[(size_t)(ci[j] - 4) * 8192] = (bf16)f2bf(S); S = dd[j] * S + u[j]; }
        }
    }
}

__device__ __forceinline__ void ph_gla_g3(const Ctx& c) {
    LAS bf16* qe = (LAS bf16*)c.lds;
    LAS bf16* kd = qe + 2 * 64 * GP;
    LAS bf16* vL = kd + 2 * 64 * GP;
    LAS bf16* STl = vL + 64 * GVP;
    LAS float* ssq = (LAS float*)(STl + 2 * 128 * GP);
    const bf16* P = WSP(bf16, WS_PBUF);
    const int q = c.lane >> 4, l15 = c.lane & 15, it = c.wave & 3, eh = c.wave >> 2;
    for (int item = blockIdx.x; item < 2 * 4 * 128; item += c.G) {
        const int lc = item & 127, h = (item >> 7) & 3, b = item >> 9, m0 = b * SEQ + 64 * lc;
        { const int row = c.tid >> 3, ch = c.tid & 7;
#pragma unroll
          for (int dir = 0; dir < 2; ++dir) { const size_t o = ((size_t)dir * NLAT + m0 + row) * 256 + h * 64 + 8 * ch;
              *(LAS v4u*)(qe + (size_t)(dir * 64 + row) * GP + 8 * ch) = *(const v4u*)(WSP(bf16, WS_QE) + o); *(LAS v4u*)(kd + (size_t)(dir * 64 + row) * GP + 8 * ch) = *(const v4u*)(WSP(bf16, WS_KD) + o); }
#pragma unroll
          for (int dir = 0; dir < 2; ++dir)
#pragma unroll
            for (int r = 0; r < 2; ++r) { const int id = c.tid + 512 * r, e = id >> 3, ch8 = id & 7;
                *(LAS v4u*)(STl + (size_t)(dir * 128 + e) * GP + 8 * ch8) = *(const v4u*)(WSP(bf16, WS_ST) + ((size_t)(dir * 8 + b * 4 + h) * 128 + lc) * 8192 + e * 64 + 8 * ch8); } }
#pragma unroll
        for (int r2 = 0; r2 < 2; ++r2) { const int id = c.tid + 512 * r2, vr = id >> 4, vc = id & 15; *(LAS v4u*)(vL + vr * GVP + 8 * vc) = *(const v4u*)(P + (size_t)(m0 + vr) * 2048 + 1024 + h * 128 + 8 * vc); }
        __syncthreads();
        f32x4 acc[4];
#pragma unroll
        for (int nt = 0; nt < 4; ++nt) acc[nt] = (f32x4){0.f, 0.f, 0.f, 0.f};
        const int iq = 16 * it + l15;
#pragma unroll
        for (int dir = 0; dir < 2; ++dir) {
            const bf16x8 bq0 = *(const LAS bf16x8*)(qe + (size_t)(dir * 64 + iq) * GP + 8 * q), bq1 = *(const LAS bf16x8*)(qe + (size_t)(dir * 64 + iq) * GP + 32 + 8 * q);
            f32x4 s[4];
#pragma unroll
            for (int jt = 0; jt < 4; ++jt) {
                const bf16x8 a0 = *(const LAS bf16x8*)(kd + (size_t)(dir * 64 + 16 * jt + l15) * GP + 8 * q), a1 = *(const LAS bf16x8*)(kd + (size_t)(dir * 64 + 16 * jt + l15) * GP + 32 + 8 * q);
                f32x4 t = {0.f, 0.f, 0.f, 0.f};
                t = __builtin_amdgcn_mfma_f32_16x16x32_bf16(a0, bq0, t, 0, 0, 0); t = __builtin_amdgcn_mfma_f32_16x16x32_bf16(a1, bq1, t, 0, 0, 0);
#pragma unroll
                for (int r = 0; r < 4; ++r) { const int j = 16 * jt + 4 * q + r; const bool keep = dir == 0 ? (j <= iq) : (j >= iq); t[r] = keep ? t[r] : 0.f; }
                s[jt] = t; }
            bf16x8 pbf[2];
#pragma unroll
            for (int ks = 0; ks < 2; ++ks) { v4u w; w.x = pk2(s[2 * ks][0], s[2 * ks][1]); w.y = pk2(s[2 * ks][2], s[2 * ks][3]); w.z = pk2(s[2 * ks + 1][0], s[2 * ks + 1][1]); w.w = pk2(s[2 * ks + 1][2], s[2 * ks + 1][3]);
                pbf[ks] = __builtin_bit_cast(bf16x8, w); }
#pragma unroll
            for (int nt = 0; nt < 4; ++nt) { const int er = 64 * eh + 16 * nt + l15;
                const bf16x8 s0 = *(const LAS bf16x8*)(STl + (size_t)(dir * 128 + er) * GP + 8 * q), s1 = *(const LAS bf16x8*)(STl + (size_t)(dir * 128 + er) * GP + 32 + 8 * q);
                acc[nt] = __builtin_amdgcn_mfma_f32_16x16x32_bf16(s0, bq0, acc[nt], 0, 0, 0); acc[nt] = __builtin_amdgcn_mfma_f32_16x16x32_bf16(s1, bq1, acc[nt], 0, 0, 0);
#pragma unroll
                for (int ks = 0; ks < 2; ++ks) { const LAS bf16* vb = vL + (size_t)(32 * ks + 4 * q + (l15 >> 2)) * GVP + 64 * eh + 16 * nt + 4 * (l15 & 3);
                    const v2u lo = __builtin_bit_cast(v2u, __builtin_amdgcn_ds_read_tr16_b64_v4i16((LAS s16x4_t*)vb)), hi = __builtin_bit_cast(v2u, __builtin_amdgcn_ds_read_tr16_b64_v4i16((LAS s16x4_t*)(vb + 16 * GVP)));
                    acc[nt] = __builtin_amdgcn_mfma_f32_16x16x32_bf16(mk8(lo, hi), pbf[ks], acc[nt], 0, 0, 0); } }
        }
        float ss = 0.f;
#pragma unroll
        for (int nt = 0; nt < 4; ++nt) ss += (acc[nt][0] * acc[nt][0] + acc[nt][1] * acc[nt][1]) + (acc[nt][2] * acc[nt][2] + acc[nt][3] * acc[nt][3]);
        ss = xor16_sum(ss); ss = xor32_sum(ss);
        if (q == 0) ssq[eh * 64 + iq] = ss;
        __syncthreads();
        const float rn = 1.0f / sqrtf((ssq[iq] + ssq[64 + iq]) * (1.0f / 128.0f) + EPS);
#pragma unroll
        for (int nt = 0; nt < 4; ++nt) { const int e = 64 * eh + 16 * nt + 4 * q; const size_t m = (size_t)(m0 + iq);
            const v2u rr = *(const v2u*)(P + m * 2048 + 1536 + h * 128 + e); const float* hg = c.a->in[I_HEADG] + h * 128 + e;
            v2u o; o.x = pk2(acc[nt][0] * rn * hg[0] * silu(bflo(rr.x)), acc[nt][1] * rn * hg[1] * silu(bfhi(rr.x))); o.y = pk2(acc[nt][2] * rn * hg[2] * silu(bflo(rr.y)), acc[nt][3] * rn * hg[3] * silu(bfhi(rr.y)));
            *(v2u*)(WSP(bf16, WS_MIX) + m * 1024 + 512 + h * 128 + e) = o; }
        __syncthreads();
    }
}

constexpr int NP = 72;
constexpr float LOG2E = 1.4426950408889634f;
template <int QG, bool WIN>
__device__ __forceinline__ void na_qgroup(const LAS bf16* Kt, const bf16x8 (&vf)[4][2], const LAS float* bp, const float (&cap)[3][4], const bf16x8 (&qf)[2], f32x4 (&o)[4], float& mrun, float& lrun, int q, int l15) {
    constexpr int KT_LO = WIN ? (QG <= 1 ? 0 : QG - 1) : 0, KT_HI = WIN ? (QG == 0 ? 1 : (QG == 3 ? 3 : QG + 1)) : 3;
    f32x4 s[4];
#pragma unroll
    for (int kt = 0; kt < 4; ++kt) if (kt >= KT_LO && kt <= KT_HI) {
        const bf16x8 a0 = *(const LAS bf16x8*)(Kt + (size_t)(16 * kt + l15) * NP + 8 * q), a1 = *(const LAS bf16x8*)(Kt + (size_t)(16 * kt + l15) * NP + 32 + 8 * q);
        f32x4 t = {0.f, 0.f, 0.f, 0.f};
        t = __builtin_amdgcn_mfma_f32_16x16x32_bf16(a0, qf[0], t, 0, 0, 0); t = __builtin_amdgcn_mfma_f32_16x16x32_bf16(a1, qf[1], t, 0, 0, 0);
        s[kt] = t; }
    float mx = -1e30f;
#pragma unroll
    for (int kt = 0; kt < 4; ++kt) if (kt >= KT_LO && kt <= KT_HI) {
#pragma unroll
        for (int r = 0; r < 4; ++r) { float v;
            if (WIN) v = fminf(__builtin_fmaf(s[kt][r], 0.125f * LOG2E, bp[16 * kt + r]), cap[kt - KT_LO][r]); else v = s[kt][r] * (0.125f * LOG2E);
            s[kt][r] = v; mx = fmaxf(mx, v); } }
    mx = xor16_max(mx); mx = xor32_max(mx);
    const float mnew = fmaxf(mrun, mx), alpha = __builtin_amdgcn_exp2f(mrun - mnew);
    mrun = mnew;
    float psum = 0.f;
#pragma unroll
    for (int kt = 0; kt < 4; ++kt) {
        if (kt >= KT_LO && kt <= KT_HI) {
#pragma unroll
            for (int r = 0; r < 4; ++r) { const float p = __builtin_amdgcn_exp2f(s[kt][r] - mnew); s[kt][r] = p; psum += p; } }
        else s[kt] = (f32x4){0.f, 0.f, 0.f, 0.f}; }
    lrun = lrun * alpha + psum;
#pragma unroll
    for (int nt = 0; nt < 4; ++nt) o[nt] = o[nt] * alpha;
#pragma unroll
    for (int ks = 0; ks < 2; ++ks) if (2 * ks + 1 >= KT_LO && 2 * ks <= KT_HI) {
        v4u w; w.x = pk2(s[2 * ks][0], s[2 * ks][1]); w.y = pk2(s[2 * ks][2], s[2 * ks][3]); w.z = pk2(s[2 * ks + 1][0], s[2 * ks + 1][1]); w.w = pk2(s[2 * ks + 1][2], s[2 * ks + 1][3]);
        const bf16x8 pb = __builtin_bit_cast(bf16x8, w);
#pragma unroll
        for (int nt = 0; nt < 4; ++nt) o[nt] = __builtin_amdgcn_mfma_f32_16x16x32_bf16(vf[nt][ks], pb, o[nt], 0, 0, 0); }
}
__device__ __forceinline__ void na_load_vf(const LAS bf16* Vt, bf16x8 (&vf)[4][2], int q, int l15) {
    const LAS bf16* base = Vt + (size_t)(4 * q + (l15 >> 2)) * NP + 4 * (l15 & 3);
#pragma unroll
    for (int nt = 0; nt < 4; ++nt)
#pragma unroll
        for (int ks = 0; ks < 2; ++ks) {
            const s16x4_t lo = __builtin_amdgcn_ds_read_tr16_b64_v4i16((LAS s16x4_t*)(base + (size_t)(32 * ks) * NP + 16 * nt)), hi = __builtin_amdgcn_ds_read_tr16_b64_v4i16((LAS s16x4_t*)(base + (size_t)(32 * ks + 16) * NP + 16 * nt));
            vf[nt][ks] = mk8(__builtin_bit_cast(v2u, lo), __builtin_bit_cast(v2u, hi)); }
}
__device__ __forceinline__ void ph_na(const Ctx& c) {
    LAS bf16* Kb = (LAS bf16*)c.lds;
    LAS bf16* Vb = Kb + 2 * 64 * NP;
    LAS float* rpbL = (LAS float*)(Vb + 2 * 64 * NP);
    const bf16* P = WSP(bf16, WS_PBUF);
    const int q = c.lane >> 4, l15 = c.lane & 15, hq = c.wave & 1;
    const int lkey = c.tid >> 3, lch = c.tid & 7;
    for (int item = blockIdx.x; item < 512 + 16; item += c.G) {
        const bool lat = item < 512;
        int b, h, r0 = 0, rlo = 0, nwin = 0;
        if (lat) { const int rb = item & 31; h = (item >> 5) & 7; b = item >> 8; r0 = 4 * rb; rlo = min(max(r0 - 4, 0), 120); nwin = min(max(r0 - 1, 0), 120) + 7 - rlo + 1; }
        else { const int ci = item - 512; h = ci & 7; b = ci >> 3; }
        const int nsteps = nwin + 4, r = r0 + (c.wave >> 1), rs = min(max(r - 4, 0), 120);
        for (int i = c.tid; i < 465; i += 512) rpbL[i] = c.a->in[I_RPB][h * 465 + i] * LOG2E;
        bf16x8 qf[2][2];
#pragma unroll
        for (int g = 0; g < 2; ++g) { const int qt = lat ? b * SEQ + r * 64 + 16 * (2 * hq + g) + l15 : NLAT + b * CTXL + 32 * c.wave + 16 * g + l15;
#pragma unroll
            for (int ks = 0; ks < 2; ++ks) qf[g][ks] = *(const bf16x8*)(P + (size_t)qt * 2560 + 1024 + h * 64 + 32 * ks + 8 * q); }
        f32x4 o[2][4];
#pragma unroll
        for (int g = 0; g < 2; ++g)
#pragma unroll
            for (int nt = 0; nt < 4; ++nt) o[g][nt] = (f32x4){0.f, 0.f, 0.f, 0.f};
        float mrun[2] = {-1e30f, -1e30f}, lrun[2] = {0.f, 0.f};
        float cap[2][3][4]; int bidx[2];
#pragma unroll
        for (int g = 0; g < 2; ++g) { const int QGr = 2 * hq + g, qc = 16 * QGr + l15, cs = min(max(qc - 8, 0), 48), ktlo = QGr <= 1 ? 0 : QGr - 1; bidx[g] = 4 * q - qc + 15;
#pragma unroll
            for (int t = 0; t < 3; ++t)
#pragma unroll
                for (int rr = 0; rr < 4; ++rr) { const int kc = 16 * (ktlo + t) + 4 * q + rr; cap[g][t][rr] = (unsigned)(kc - cs) < 16u ? __builtin_inff() : -1e30f; } }
        v4u kreg, vreg;
        { const int tok0 = nwin > 0 ? b * SEQ + rlo * 64 : NLAT + b * CTXL; const bf16* src = P + (size_t)(tok0 + lkey) * 2560 + 1536 + h * 64 + 8 * lch; kreg = *(const v4u*)src; vreg = *(const v4u*)(src + 512); }
        for (int s = 0; s < nsteps; ++s) {
            LAS bf16* Kt = Kb + (s & 1) * 64 * NP; LAS bf16* Vt = Vb + (s & 1) * 64 * NP;
            *(LAS v4u*)(Kt + (size_t)lkey * NP + 8 * lch) = kreg;
            *(LAS v4u*)(Vt + (size_t)lkey * NP + 8 * lch) = vreg;
            __syncthreads();
            if (s + 1 < nsteps) { const int s1 = s + 1; const int tok0 = s1 < nwin ? b * SEQ + (rlo + s1) * 64 : NLAT + b * CTXL + 64 * (s1 - nwin);
                const bf16* src = P + (size_t)(tok0 + lkey) * 2560 + 1536 + h * 64 + 8 * lch; kreg = *(const v4u*)src; vreg = *(const v4u*)(src + 512); }
            if (s < nwin) { const int kr = rlo + s;
                if (kr >= rs && kr < rs + 8) { bf16x8 vf[4][2]; na_load_vf(Vt, vf, q, l15); const LAS float* rpbrow = rpbL + (kr - r + 7) * 31;
                    if (hq == 0) { na_qgroup<0, true>(Kt, vf, rpbrow + bidx[0], cap[0], qf[0], o[0], mrun[0], lrun[0], q, l15); na_qgroup<1, true>(Kt, vf, rpbrow + bidx[1], cap[1], qf[1], o[1], mrun[1], lrun[1], q, l15); }
                    else { na_qgroup<2, true>(Kt, vf, rpbrow + bidx[0], cap[0], qf[0], o[0], mrun[0], lrun[0], q, l15); na_qgroup<3, true>(Kt, vf, rpbrow + bidx[1], cap[1], qf[1], o[1], mrun[1], lrun[1], q, l15); } } }
            else { bf16x8 vf[4][2]; na_load_vf(Vt, vf, q, l15);
                na_qgroup<0, false>(Kt, vf, rpbL, cap[0], qf[0], o[0], mrun[0], lrun[0], q, l15); na_qgroup<0, false>(Kt, vf, rpbL, cap[1], qf[1], o[1], mrun[1], lrun[1], q, l15); }
        }
#pragma unroll
        for (int g = 0; g < 2; ++g) { float l = lrun[g]; l = xor16_sum(l); l = xor32_sum(l); const float il = 1.0f / l;
            const int qt = lat ? b * SEQ + r * 64 + 16 * (2 * hq + g) + l15 : NLAT + b * CTXL + 32 * c.wave + 16 * g + l15;
#pragma unroll
            for (int nt = 0; nt < 4; ++nt) { v2u pk; pk.x = pk2(o[g][nt][0] * il, o[g][nt][1] * il); pk.y = pk2(o[g][nt][2] * il, o[g][nt][3] * il);
                *(v2u*)(WSP(bf16, WS_MIX) + (size_t)qt * 1024 + 512 + h * 64 + 16 * nt + 4 * q) = pk; } }
        __syncthreads();
    }
}


typedef int v8i_c __attribute__((ext_vector_type(8)));
typedef int v4i_c __attribute__((ext_vector_type(4)));
__device__ __forceinline__ v8i_c ld32(const unsigned char* p) { const v4i_c lo = *(const v4i_c*)p, hi = *(const v4i_c*)(p + 16); return __builtin_shufflevector(lo, hi, 0, 1, 2, 3, 4, 5, 6, 7); }
template <int NT, int KS, int APITCH, int MT> __device__ __forceinline__ void ctx_pass(const Ctx& c, const unsigned char* A, int lda, const unsigned char* B0, const unsigned char* B1, int ldb, f32x4 (&acc)[MT][NT], int mt0) {
    const int l15 = c.lane & 15, q = c.lane >> 4;
    LAS unsigned char* aL = c.lds;
    v8i_c b[KS][NT];
    { const unsigned char* bp0 = B0 + (size_t)l15 * ldb + 32 * q; const unsigned char* bp1 = B1 + (size_t)l15 * ldb + 32 * q;
#pragma unroll
      for (int ks = 0; ks < KS; ++ks) { b[ks][0] = ld32(bp0 + 128 * ks); if (NT > 1) b[ks][NT - 1] = ld32(bp1 + 128 * ks); } }
    __syncthreads();
    constexpr int CPR = KS * 8;
    for (int i = c.tid; i < 64 * CPR; i += 512) { const int row = i / CPR, ch = i % CPR; *(LAS v4i_c*)(aL + row * APITCH + 16 * ch) = *(const v4i_c*)(A + (size_t)row * lda + 16 * ch); }
    __syncthreads();
#pragma unroll
    for (int ks = 0; ks < KS; ++ks) {
        v8i_c a[MT];
#pragma unroll
        for (int mt = 0; mt < MT; ++mt) { const LAS unsigned char* p = aL + (16 * (mt0 + mt) + l15) * APITCH + 128 * ks + 32 * q; const v4i_c lo = *(const LAS v4i_c*)p, hi = *(const LAS v4i_c*)(p + 16); a[mt] = __builtin_shufflevector(lo, hi, 0, 1, 2, 3, 4, 5, 6, 7); }
#pragma unroll
        for (int mt = 0; mt < MT; ++mt)
#pragma unroll
            for (int nt = 0; nt < NT; ++nt) asm volatile("v_mfma_f32_16x16x128_f8f6f4 %0, %1, %2, %0" : "+v"(acc[mt][nt]) : "v"(b[ks][nt]), "v"(a[mt]));
    }
}
__device__ __forceinline__ void ph_moe_ctx1(const Ctx& c, int layer) {
    const unsigned char* W1 = WSP(unsigned char, WS_W1) + (size_t)layer * 16 * 5632 * 1024;
    const int l15 = c.lane & 15, q = c.lane >> 4;
    for (int item = blockIdx.x; item < 16 * 22; item += c.G) {
        const int e = item / 22, pn = item % 22;
        const unsigned char* A = WSP(unsigned char, WS_XG) + (size_t)(MOE_LAT + e * 256) * 1024;
        const unsigned char* Bg = W1 + ((size_t)e * 5632 + pn * 256 + 16 * c.wave) * 1024;
        f32x4 acc[4][2];
#pragma unroll
        for (int mt = 0; mt < 4; ++mt) { acc[mt][0] = (f32x4){0.f, 0.f, 0.f, 0.f}; acc[mt][1] = (f32x4){0.f, 0.f, 0.f, 0.f}; }
        ctx_pass<2, 8, 1040, 4>(c, A, 1024, Bg, Bg + (size_t)128 * 1024, 1024, acc, 0);
        asm volatile("s_nop 15\n\ts_nop 15" ::: "memory");
        const float in_inv = 1.0f / (SC_X * SC_W);
#pragma unroll
        for (int mt = 0; mt < 4; ++mt) { const f32x4 g = acc[mt][0] * in_inv, u = acc[mt][1] * (in_inv * SC_H);
            const unsigned w = pg8::pk4_fp8(pg8::clamp448(pg8::silu_f(g[0]) * u[0]), pg8::clamp448(pg8::silu_f(g[1]) * u[1]), pg8::clamp448(pg8::silu_f(g[2]) * u[2]), pg8::clamp448(pg8::silu_f(g[3]) * u[3]));
            *(unsigned*)(WSP(unsigned char, WS_HID) + (size_t)(MOE_LAT + e * 256 + 16 * mt + l15) * FF + pn * 128 + 16 * c.wave + 4 * q) = w; }
    }
    __syncthreads();
}
__device__ __forceinline__ void ph_moe_ctx2(const Ctx& c, int layer) {
    const unsigned char* W2 = WSP(unsigned char, WS_W2) + (size_t)layer * 16 * 1024 * 2816;
    const int l15 = c.lane & 15, q = c.lane >> 4, nt = c.wave & 3, mh = c.wave >> 2;
    for (int item = blockIdx.x; item < 16 * 16; item += c.G) {
        const int e = item >> 4, cb = item & 15;
        const unsigned char* A = WSP(unsigned char, WS_HID) + (size_t)(MOE_LAT + e * 256) * FF;
        const unsigned char* B = W2 + ((size_t)e * 1024 + cb * 64 + 16 * nt) * FF;
        f32x4 acc[2][1];
        acc[0][0] = (f32x4){0.f, 0.f, 0.f, 0.f}; acc[1][0] = (f32x4){0.f, 0.f, 0.f, 0.f};
        ctx_pass<1, 11, 1424, 2>(c, A, FF, B, B, FF, acc, 2 * mh);
        ctx_pass<1, 11, 1424, 2>(c, A + 1408, FF, B + 1408, B + 1408, FF, acc, 2 * mh);
        asm volatile("s_nop 15\n\ts_nop 15" ::: "memory");
        const float sc = 1.0f / (SC_H * SC_W);
#pragma unroll
        for (int mt = 0; mt < 2; ++mt) { const f32x4 v = acc[mt][0] * sc; v2u pk; pk.x = pk2(v[0], v[1]); pk.y = pk2(v[2], v[3]);
            *(v2u*)(WSP(bf16, WS_Y) + (size_t)(MOE_LAT + e * 256 + 16 * (2 * mh + mt) + l15) * 1024 + cb * 64 + 16 * nt + 4 * q) = pk; }
    }
    __syncthreads();
}

#ifndef GLA_NAIVE
#define GLA_NAIVE 0
#endif
#ifndef NA_NAIVE
#define NA_NAIVE 0
#endif
#ifndef MK_ONE_LAUNCH
#define MK_ONE_LAUNCH 1
#endif
constexpr int NPH = 23;
#define MKCTX() Ctx c; c.lds = lds; { unsigned long long a_ = (unsigned long long)a; asm volatile("" : "+s"(a_)); const unsigned lo_ = __builtin_amdgcn_readfirstlane((unsigned)a_), hi_ = __builtin_amdgcn_readfirstlane((unsigned)(a_ >> 32)); c.a = (const CAS Args*)(((unsigned long long)hi_ << 32) | lo_); } c.out = a->out; c.ws = a->ws; { int t_ = threadIdx.x; asm volatile("" : "+v"(t_)); c.tid = t_ & 511; } c.lane = c.tid & 63; c.wave = __builtin_amdgcn_readfirstlane(c.tid >> 6); c.G = gridDim.x; \
    c.gw = blockIdx.x * NWAVES + c.wave; c.ngw = c.G * NWAVES
__device__ __forceinline__ void P_prologue(LAS unsigned char* lds, const CAS Args* a) { MKCTX(); ph_prologue(c); }
__device__ __forceinline__ void P_adaln0(LAS unsigned char* lds, const CAS Args* a) { MKCTX(); ph_adaln0(c); }
__device__ __forceinline__ void P_conv(LAS unsigned char* lds, const CAS Args* a) { MKCTX(); ph_conv(c); }
#if NA_NAIVE
__device__ __forceinline__ void P_na(LAS unsigned char* lds, const CAS Args* a) { MKCTX(); ph_na_naive(c); }
#else
__device__ __forceinline__ void P_na(LAS unsigned char* lds, const CAS Args* a) { MKCTX(); ph_na(c); }
#endif
__device__ __forceinline__ void P_outproj_ctx(LAS unsigned char* lds, const CAS Args* a) { MKCTX(); ph_outproj_ctx_tiles(c, WS_WOUTE); }
__device__ __forceinline__ void P_inproj_odd_tiles(LAS unsigned char* lds, const CAS Args* a) { MKCTX(); ph_inproj_odd_tiles(c); }
__device__ __forceinline__ void P_prep_odd(LAS unsigned char* lds, const CAS Args* a) { MKCTX(); ph_prep_odd(c); }
__device__ __forceinline__ void P_pool(LAS unsigned char* lds, const CAS Args* a) { MKCTX(); ph_pool(c); }
__device__ __forceinline__ void P_gla_naive(LAS unsigned char* lds, const CAS Args* a) { MKCTX(); ph_gla_naive(c); }
__device__ __forceinline__ void P_gla_out(LAS unsigned char* lds, const CAS Args* a) { MKCTX(); ph_gla_out(c); }
__device__ __forceinline__ void P_gla_g1(LAS unsigned char* lds, const CAS Args* a) { MKCTX(); ph_gla_g1(c); }
__device__ __forceinline__ void P_gla_g2(LAS unsigned char* lds, const CAS Args* a) { MKCTX(); ph_gla_g2(c); }
__device__ __forceinline__ void P_gla_g3(LAS unsigned char* lds, const CAS Args* a) { MKCTX(); ph_gla_g3(c); }
__device__ __forceinline__ void P_post(LAS unsigned char* lds, const CAS Args* a, int layer, int ntok) { MKCTX(); ph_post(c, layer, ntok); }
__device__ __forceinline__ void P_topk_gather(LAS unsigned char* lds, const CAS Args* a, int nctx) { MKCTX(); ph_topk_gather(c, 256, nctx); }
__device__ __forceinline__ void P_moe_ctx1(LAS unsigned char* lds, const CAS Args* a, int layer) { MKCTX(); ph_moe_ctx1(c, layer); }
__device__ __forceinline__ void P_moe_ctx2(LAS unsigned char* lds, const CAS Args* a, int layer) { MKCTX(); ph_moe_ctx2(c, layer); }
__device__ __forceinline__ void P_combine(LAS unsigned char* lds, const CAS Args* a, int layer, int ntok) { MKCTX(); ph_combine(c, layer, ntok); }
template <int K, int NN, int LDC> __device__ __forceinline__ void P_gemm_bf16(LAS unsigned char* lds, const bf16* A, const bf16* Bt, bf16* O, int nM) {
    pg8::Gemm g{A, Bt, K}; pg8::Order S; S.init(nM, NN, (int)gridDim.x, (int)blockIdx.x, 0);
    pg8::EpiBf16 E{O, LDC, 1.0f}; pg8::gemm_phase<pg8::EpiBf16, pg8::Order, PG8_ALIGN, PG8_SP2>(lds, g, S, E);
}
template <int KB, int NN, int LDC> __device__ __forceinline__ void P_gemm_f8_bf16(LAS unsigned char* lds, const unsigned char* A, const unsigned char* Bt, bf16* O, int nM) {
    pg8::Gemm g{(const bf16*)A, (const bf16*)Bt, KB / 2}; pg8::Order S; S.init(nM, NN, (int)gridDim.x, (int)blockIdx.x, 1);
    pg8::EpiBf16F8 E{O, LDC, 1.0f / (SC_H * SC_W)}; pg8::gemm_phase<pg8::EpiBf16F8, pg8::Order, PG8_ALIGN, PG8_SP2>(lds, g, S, E);
}
template <int KB, int NN, int LDC> __device__ __forceinline__ void P_gemm_f8_swiglu(LAS unsigned char* lds, const unsigned char* A, const unsigned char* Bt, unsigned char* O, int nM) {
    pg8::Gemm g{(const bf16*)A, (const bf16*)Bt, KB / 2}; pg8::Order S; S.init(nM, NN, (int)gridDim.x, (int)blockIdx.x, 1);
    pg8::EpiSwigluF8 E{O, LDC, 1.0f / (SC_X * SC_W), SC_H}; pg8::gemm_phase<pg8::EpiSwigluF8, pg8::Order, PG8_ALIGN, PG8_SP2>(lds, g, S, E);
}

__global__ void __launch_bounds__(NWAVES * 64, 2) fwd(Args args) {
    extern __shared__ __attribute__((aligned(16))) unsigned char lds_raw[];
    LAS unsigned char* lds = (LAS unsigned char*)lds_raw;
    const CAS Args* a = (const CAS Args*)__builtin_amdgcn_kernarg_segment_ptr();
    unsigned char* ws = args.ws;
    const int tid = threadIdx.x;
    volatile LAS unsigned* MISC = (volatile LAS unsigned*)(lds + MISC_OFF);
    for (int u = tid; u < (LDS_BYTES - LDSCTL_OFF) / 4; u += NWAVES * 64) ((LAS unsigned*)(lds + LDSCTL_OFF))[u] = 0u;
    __syncthreads();
    const int lo = args.ph_lo, hi = args.ph_hi;
    XcdBarrier bar; bar.bar = (unsigned*)(ws + WS_CTL) + CW_BAR; bar.x = 0; bar.st = nullptr;
    if (hi - lo > 1) bar = xcd_barrier_post((unsigned*)(ws + WS_CTL) + CW_BAR, MISC + 8);
#ifndef PROBE_MASK
#define PROBE_MASK 0
#endif
#ifndef PROBE_N
#define PROBE_N 2
#endif
#define REP(k) (((k) != 17 && (k) != 10 && (((PROBE_MASK) >> ((k) < 17 ? (k) : (k) - 12)) & 1)) ? PROBE_N : 1)
#define REPX(b) ((((PROBE_MASK) >> (b)) & 1) ? PROBE_N : 1)
#define RX(b, call) do { for (int rx_ = 0; rx_ < REPX(b); ++rx_) { call; } } while (0)
#define IN(k) (lo <= (k) && (k) < hi)
#define SEAM(k) do { if (IN(k) && IN((k) + 1)) xcd_barrier(bar); } while (0)
#define WP(off) ((bf16*)(ws + (off)))
    if (IN(0)) for (int rep_ = 0; rep_ < REP(0); ++rep_) { P_prologue(lds, a); } SEAM(0);
    if (IN(1)) for (int rep_ = 0; rep_ < REP(1); ++rep_) { P_adaln0(lds, a); } SEAM(1);
    if (IN(2)) for (int rep_ = 0; rep_ < REP(2); ++rep_) { P_gemm_bf16<1024, EVEN_IN / 256, EVEN_IN>(lds, WP(WS_H), WP(WS_WINE), WP(WS_PBUF), NTOK / 256); } SEAM(2);
    if (IN(3)) for (int rep_ = 0; rep_ < REP(3); ++rep_) { RX(17, P_conv(lds, a)); RX(18, P_na(lds, a)); } SEAM(3);
    if (IN(4)) for (int rep_ = 0; rep_ < REP(4); ++rep_) { P_gemm_bf16<1024, 4, 1024>(lds, WP(WS_MIX), WP(WS_WOUTE), WP(WS_YO), NLAT / 256); RX(19, P_outproj_ctx(lds, a)); } SEAM(4);
#define COMMON(layer, p0, ntok, nlists, nrows) \
    if (IN(p0 + 0)) for (int rep_ = 0; rep_ < REP(p0 + 0); ++rep_) { P_post(lds, a, layer, ntok); } SEAM(p0 + 0); \
    if (IN(p0 + 1)) for (int rep_ = 0; rep_ < REP(p0 + 1); ++rep_) { P_topk_gather(lds, a, (nlists) - 32); } do { if (IN(p0 + 1) && IN(p0 + 3)) xcd_barrier(bar); } while (0); \
    if (IN(p0 + 3)) for (int rep_ = 0; rep_ < REP(p0 + 3); ++rep_) { P_gemm_f8_swiglu<1024, 22, FF>(lds, ws + WS_XG, ws + WS_W1 + (size_t)layer * 16 * 5632 * 1024, ws + WS_HID, MOE_LAT / 256); if ((nrows) > MOE_LAT) P_moe_ctx1(lds, a, layer); } SEAM(p0 + 3); \
    if (IN(p0 + 4)) for (int rep_ = 0; rep_ < REP(p0 + 4); ++rep_) { P_gemm_f8_bf16<FF, 4, 1024>(lds, ws + WS_HID, ws + WS_W2 + (size_t)layer * 16 * 1024 * 2816, WP(WS_Y), MOE_LAT / 256); if ((nrows) > MOE_LAT) P_moe_ctx2(lds, a, layer); } SEAM(p0 + 4); \
    if (IN(p0 + 5)) for (int rep_ = 0; rep_ < REP(p0 + 5); ++rep_) { P_combine(lds, a, layer, ntok); }
    COMMON(0, 5, NTOK, 64, MOE_ROWS) SEAM(10);
    if (IN(11)) for (int rep_ = 0; rep_ < REP(11); ++rep_) { P_gemm_bf16<1024, 8, 2048>(lds, WP(WS_H), WP(WS_WINO), WP(WS_PBUF), NLAT / 256); RX(20, P_inproj_odd_tiles(lds, a)); }
    do { if (IN(11) && IN(13)) xcd_barrier(bar); } while (0);
#if GLA_NAIVE
    if (IN(12)) for (int rep_ = 0; rep_ < REP(12); ++rep_) { P_prep_odd(lds, a); } SEAM(12);
    if (IN(13)) for (int rep_ = 0; rep_ < REP(13); ++rep_) { P_pool(lds, a); P_gla_naive(lds, a); } SEAM(13);
    if (IN(14)) for (int rep_ = 0; rep_ < REP(14); ++rep_) { P_gla_out(lds, a); } SEAM(14);
    SEAM(15);
#else
    if (IN(13)) for (int rep_ = 0; rep_ < REP(13); ++rep_) { RX(21, P_pool(lds, a)); RX(22, P_gla_g1(lds, a)); } SEAM(13);
    if (IN(14)) for (int rep_ = 0; rep_ < REP(14); ++rep_) { P_gla_g2(lds, a); } SEAM(14);
    if (IN(15)) for (int rep_ = 0; rep_ < REP(15); ++rep_) { P_gla_g3(lds, a); } SEAM(15);
#endif
    if (IN(16)) for (int rep_ = 0; rep_ < REP(16); ++rep_) { P_gemm_bf16<1024, 4, 1024>(lds, WP(WS_MIX), WP(WS_WOUTO), WP(WS_YO), NLAT / 256); } SEAM(16);
    COMMON(1, 17, NLAT, 32, MOE_LAT)
#undef COMMON
#undef IN
#undef SEAM
#undef WP
}

extern "C" void kernel_launch(void* const* d_in, const int* in_sizes, int n_in, void* d_out, int out_size, void* d_ws, size_t ws_size, hipStream_t stream) {
    static int grid = 0;
    if (grid == 0) {
        if (n_in != N_IN || out_size != NLAT * D || ws_size < WS_END) { fprintf(stderr, "kernel_launch: unexpected shapes (n_in %d, out %d, ws %zu, need %zu)\n", n_in, out_size, ws_size, (size_t)WS_END); grid = -1; return; }
        int dev = 0, cus = 0, per_cu = 0;
        if (hipGetDevice(&dev) != hipSuccess || hipDeviceGetAttribute(&cus, hipDeviceAttributeMultiprocessorCount, dev) != hipSuccess) { grid = -1; return; }
        if (hipFuncSetAttribute((const void*)fwd, hipFuncAttributeMaxDynamicSharedMemorySize, LDS_BYTES) != hipSuccess) { fprintf(stderr, "kernel_launch: hipFuncSetAttribute failed\n"); grid = -1; return; }
        if (hipOccupancyMaxActiveBlocksPerMultiprocessor(&per_cu, (const void*)fwd, NWAVES * 64, LDS_BYTES) != hipSuccess || per_cu < 1) fprintf(stderr, "kernel_launch: occupancy query reports %d\n", per_cu);
        (void)hipGetLastError();
        grid = cus;
    }
    if (grid < 0) return;
    (void)in_sizes;
    if (hipMemsetAsync((char*)d_ws + WS_CTL, 0, CTL_ZERO_BYTES, stream) != hipSuccess) return;
    Args a{};
    for (int i = 0; i < N_IN; ++i) a.in[i] = (const float*)d_in[i];
    a.out = (float*)d_out; a.ws = (unsigned char*)d_ws;
#if MK_ONE_LAUNCH
    a.ph_lo = 0; a.ph_hi = NPH;
    hipLaunchKernelGGL(fwd, dim3(grid), dim3(NWAVES * 64), LDS_BYTES, stream, a);
#else
    for (int li = 0; li < NPH; ++li) { a.ph_lo = li; a.ph_hi = li + 1; hipLaunchKernelGGL(fwd, dim3(grid), dim3(NWAVES * 64), LDS_BYTES, stream, a); }
#endif
}
```

```cpp
#include <hip/hip_runtime.h>
#include <cstdio>
#include <cstdint>
namespace pg8 {
#define PG8_LAS __attribute__((address_space(3)))
typedef unsigned short bf16_t;
typedef short bf16x8 __attribute__((ext_vector_type(8)));
typedef float f32x4 __attribute__((ext_vector_type(4)));
typedef unsigned u32x4 __attribute__((ext_vector_type(4)));
typedef int v4i_t __attribute__((ext_vector_type(4)));
typedef int v8i_t __attribute__((ext_vector_type(8)));
#ifndef PG8_F8_SCALE
#define PG8_F8_SCALE 0
#endif
constexpr int BM = 256, BK = 64, HALF = 128, HTB = HALF * BK * 2  , STAGE_BYTES = 8 * HTB, NXCD = 8, WGM = 8;

__host__ __device__ __forceinline__ int lds_byte(int r, int c) { const int st = (r >> 4) * 2 + (c >> 5), rr = r & 15, cc = c & 31, ob = rr * 64 + cc * 2; return st * 1024 + (ob ^ (((ob >> 9) & 1) << 5)); }
__host__ __device__ __forceinline__ void stage_rc(int b, int& R, int& C) { const int st = b / 1024, sb = b % 1024, swz = sb ^ (((sb >> 9) & 1) << 5); R = (st >> 1) * 16 + swz / 64; C = (st & 1) * 32 + (swz % 64) / 2; }
__host__ __device__ __forceinline__ int perm32(int rho) { const int n = rho >> 4, i = rho & 15; return 8 * (i >> 2) + 4 * n + (i & 3); }

struct Unit { int pm, pn, pb; };
struct Gemm { const bf16_t* A; const bf16_t* Bt; int K; };

struct Order {
    int nM, nN, nwg, G, c, moe;
    __device__ void init(int nM_, int nN_, int G_, int c_, int moe_) { nM = nM_; nN = nN_; nwg = nM * nN; G = G_; c = c_; moe = moe_; }
    __device__ bool next(int i, Unit& u) const {
        const long L = (long)i * G + c; if (L >= nwg) return false;
        int wgid = (int)L; { const int q = nwg / NXCD, r = nwg % NXCD, xcd = wgid % NXCD, off = wgid / NXCD; wgid = (xcd < r ? xcd * (q + 1) : r * (q + 1) + (xcd - r) * q) + off; }
        const int nig = WGM * nN, gid = wgid / nig, fm = gid * WGM, gsz = (nM - fm) < WGM ? (nM - fm) : WGM;
        u.pm = fm + ((wgid % nig) % gsz); u.pn = (wgid % nig) / gsz;
        u.pb = moe ? ((u.pm < 128 ? (u.pm >> 3) : (u.pm - 128)) * nN + u.pn) : u.pn;
        return true;
    }
    __device__ __forceinline__ void a_ready(const Unit&) const {}
    __device__ __forceinline__ void done(const Unit&) const {}
};

__device__ __forceinline__ unsigned cvt_pk_bf16(float lo, float hi) { unsigned r; asm volatile("v_cvt_pk_bf16_f32 %0, %1, %2" : "=v"(r) : "v"(lo), "v"(hi)); return r; }

template <bool F8_> struct EpiBf16T {
    static constexpr bool PERM = true, AFTER_DRAIN = false, F8 = F8_;
    bf16_t* O; int ldc; float scale;
    __device__ __forceinline__ void operator()(const f32x4 (&acc)[2][2][4][2], const Unit& u, int wr, int wc, int fr, int fq) const {
        const int row0 = u.pm * BM + wr * 64 + fr; const int col0 = u.pn * BM + wc * 32 + 8 * fq;
#pragma unroll
        for (int ai = 0; ai < 2; ++ai)
#pragma unroll
            for (int m = 0; m < 4; ++m) { bf16_t* rowp = O + (size_t)(row0 + ai * HALF + m * 16) * ldc + col0;
#pragma unroll
                for (int bj = 0; bj < 2; ++bj) { const f32x4 v0 = acc[ai][bj][m][0] * scale, v1 = acc[ai][bj][m][1] * scale;
                    u32x4 w; w.x = cvt_pk_bf16(v0[0], v0[1]); w.y = cvt_pk_bf16(v0[2], v0[3]); w.z = cvt_pk_bf16(v1[0], v1[1]); w.w = cvt_pk_bf16(v1[2], v1[3]);
                    *(u32x4*)(rowp + bj * HALF) = w; } }
    }
};
__device__ __forceinline__ float silu_f(float x) { return x * __builtin_amdgcn_rcpf(1.0f + __expf(-x)); }
typedef EpiBf16T<false> EpiBf16;
typedef EpiBf16T<true> EpiBf16F8;
__device__ __forceinline__ float clamp448(float x) { return __builtin_fminf(__builtin_fmaxf(x, -448.0f), 448.0f); }
__device__ __forceinline__ unsigned pk4_fp8(float a, float b, float c, float d) { unsigned w = 0u; w = __builtin_amdgcn_cvt_pk_fp8_f32(a, b, w, false); w = __builtin_amdgcn_cvt_pk_fp8_f32(c, d, w, true); return w; }
struct EpiSwigluF8 {
    static constexpr bool PERM = true, AFTER_DRAIN = false, F8 = true;
    unsigned char* O; int ldc; float in_inv, out_scale;
    __device__ __forceinline__ void operator()(const f32x4 (&acc)[2][2][4][2], const Unit& u, int wr, int wc, int fr, int fq) const {
        const int row0 = u.pm * BM + wr * 64 + fr; const int col0 = u.pn * HALF + wc * 32 + 8 * fq;
#pragma unroll
        for (int ai = 0; ai < 2; ++ai)
#pragma unroll
            for (int m = 0; m < 4; ++m) { unsigned char* rowp = O + (size_t)(row0 + ai * HALF + m * 16) * ldc + col0;
                const f32x4 G0 = acc[ai][0][m][0], G1 = acc[ai][0][m][1], U0 = acc[ai][1][m][0], U1 = acc[ai][1][m][1];
                const float ce = -in_inv * 1.4426950408889634f, cm = in_inv * in_inv * out_scale;
                float h0[4], h1[4];
#pragma unroll
                for (int j = 0; j < 4; ++j) { h0[j] = clamp448((G0[j] * U0[j]) * (cm * __builtin_amdgcn_rcpf(1.0f + __builtin_amdgcn_exp2f(G0[j] * ce)))); h1[j] = clamp448((G1[j] * U1[j]) * (cm * __builtin_amdgcn_rcpf(1.0f + __builtin_amdgcn_exp2f(G1[j] * ce)))); }
                typedef unsigned u32x2 __attribute__((ext_vector_type(2)));
                u32x2 w; w.x = pk4_fp8(h0[0], h0[1], h0[2], h0[3]); w.y = pk4_fp8(h1[0], h1[1], h1[2], h1[3]);
                *(u32x2*)rowp = w; }
    }
};
struct EpiSwiglu {
    static constexpr bool PERM = true, AFTER_DRAIN = false, F8 = false;
    bf16_t* O; int ldc;
    __device__ __forceinline__ void operator()(const f32x4 (&acc)[2][2][4][2], const Unit& u, int wr, int wc, int fr, int fq) const {
        const int row0 = u.pm * BM + wr * 64 + fr; const int col0 = u.pn * HALF + wc * 32 + 8 * fq;
#pragma unroll
        for (int ai = 0; ai < 2; ++ai)
#pragma unroll
            for (int m = 0; m < 4; ++m) { bf16_t* rowp = O + (size_t)(row0 + ai * HALF + m * 16) * ldc + col0;
                const f32x4 g0 = acc[ai][0][m][0], g1 = acc[ai][0][m][1], u0 = acc[ai][1][m][0], u1 = acc[ai][1][m][1];
                u32x4 w; w.x = cvt_pk_bf16(silu_f(g0[0]) * u0[0], silu_f(g0[1]) * u0[1]); w.y = cvt_pk_bf16(silu_f(g0[2]) * u0[2], silu_f(g0[3]) * u0[3]);
                w.z = cvt_pk_bf16(silu_f(g1[0]) * u1[0], silu_f(g1[1]) * u1[1]); w.w = cvt_pk_bf16(silu_f(g1[2]) * u1[2], silu_f(g1[3]) * u1[3]);
                *(u32x4*)rowp = w; }
    }
};

template <class Epi, class Sched, bool ALIGN_EPI = false, bool SP2 = false>
__device__ __forceinline__ void gemm_phase(PG8_LAS unsigned char* lds, const Gemm g, const Sched& S, const Epi& E) {
    int tid_ = threadIdx.x; asm volatile("" : "+v"(tid_));
    const int tid = tid_ & 511, wid = __builtin_amdgcn_readfirstlane(tid >> 6), lane = tid & 63, wr = wid >> 2, wc = wid & 3, fr = lane & 15, fq = lane >> 4;
    const int K = g.K, nt = K / BK;
    unsigned voffA[2], voffB[2];
#pragma unroll
    for (int i = 0; i < 2; ++i) { int R, C; stage_rc(tid * 16 + i * 8192, R, C); const int Rb = Epi::PERM ? ((R & ~31) + perm32(R & 31)) : R;
        voffA[i] = (unsigned)(R * K + C) * 2u; voffB[i] = (unsigned)(Rb * K + C) * 2u; }
    const size_t kstep = (size_t)(BK * 2);
    const size_t hstep = (size_t)HALF * K * 2;
    const size_t tstep = 2 * hstep;
    const unsigned ldsw = (unsigned)wid * 1024u;
    const int aoff = lds_byte(wr * 64 + fr, fq * 8), boff = lds_byte(wc * 32 + fr, fq * 8);
#define PG8_SA(b, h) (((b) * 2 + (h)) * HTB)
#define PG8_SB(b, h) ((4 + (b) * 2 + (h)) * HTB)
#define PG8_STAGE(bufoff, gbase, voff) do { _Pragma("unroll") for (int _i = 0; _i < 2; ++_i) \
        __builtin_amdgcn_global_load_lds((const unsigned*)((const char*)(gbase) + (voff)[_i]), (PG8_LAS unsigned*)(lds + (bufoff) + ldsw + _i * 8192), 16, 0, 0); } while (0)
#define PG8_LD16(off) (*(const PG8_LAS v4i_t*)(lds + (off)))
#define PG8_LDA(dst, b, h) do { _Pragma("unroll") for (int m = 0; m < 4; ++m) { if constexpr (Epi::F8) { const v4i_t lo_ = PG8_LD16(PG8_SA(b, h) + aoff + m * 2048), hi_ = PG8_LD16(PG8_SA(b, h) + aoff + m * 2048 + 1024); dst##8[m] = __builtin_shufflevector(lo_, hi_, 0, 1, 2, 3, 4, 5, 6, 7); } \
        else { _Pragma("unroll") for (int k = 0; k < 2; ++k) dst[m][k] = *(const PG8_LAS bf16x8*)(lds + PG8_SA(b, h) + aoff + m * 2048 + k * 1024); } } } while (0)
#define PG8_LDB(dst, b, h) do { _Pragma("unroll") for (int n = 0; n < 2; ++n) { if constexpr (Epi::F8) { const v4i_t lo_ = PG8_LD16(PG8_SB(b, h) + boff + n * 2048), hi_ = PG8_LD16(PG8_SB(b, h) + boff + n * 2048 + 1024); dst##8[n] = __builtin_shufflevector(lo_, hi_, 0, 1, 2, 3, 4, 5, 6, 7); } \
        else { _Pragma("unroll") for (int k = 0; k < 2; ++k) dst[n][k] = *(const PG8_LAS bf16x8*)(lds + PG8_SB(b, h) + boff + n * 2048 + k * 1024); } } } while (0)
#define PG8_MMA(ai, bj, At, Bt) do { __builtin_amdgcn_s_setprio(1); _Pragma("unroll") for (int m = 0; m < 4; ++m) _Pragma("unroll") for (int n = 0; n < 2; ++n) { \
        if constexpr (Epi::F8) { asm volatile("v_mfma_f32_16x16x128_f8f6f4 %0, %1, %2, %0" : "+v"(acc[ai][bj][m][n]) : "v"(Bt##8[n]), "v"(At##8[m])); } \
        else { _Pragma("unroll") for (int k = 0; k < 2; ++k) acc[ai][bj][m][n] = __builtin_amdgcn_mfma_f32_16x16x32_bf16(Bt[n][k], At[m][k], acc[ai][bj][m][n], 0, 0, 0); } } \
        __builtin_amdgcn_s_setprio(0); } while (0)
#define PG8_WAIT_V(n) asm volatile("s_waitcnt vmcnt(" #n ")" ::: "memory")
#define PG8_WAIT_L(n) asm volatile("s_waitcnt lgkmcnt(" #n ")" ::: "memory")
#define PG8_BAR __builtin_amdgcn_s_barrier()
#define PG8_SCHED __builtin_amdgcn_sched_barrier(0)
    Unit cur, nxt; int ui = 0;
    if (!S.next(0, cur)) return;
    f32x4 acc[2][2][4][2];
#pragma unroll
    for (int a = 0; a < 2; ++a)
#pragma unroll
        for (int b = 0; b < 2; ++b)
#pragma unroll
            for (int m = 0; m < 4; ++m)
#pragma unroll
                for (int n = 0; n < 2; ++n) acc[a][b][m][n] = (f32x4){0.f, 0.f, 0.f, 0.f};
    bf16x8 At[4][2], B0[2][2], B1[2][2]; v8i_t At8[4], B08[2], B18[2];
    const char* cA = (const char*)g.A + (size_t)cur.pm * tstep; const char* cB = (const char*)g.Bt + (size_t)cur.pb * tstep;
    S.a_ready(cur);
    if constexpr (SP2) {
        PG8_STAGE(PG8_SB(0, 0), cB, voffB); PG8_STAGE(PG8_SB(0, 1), cB + hstep, voffB); PG8_STAGE(PG8_SA(0, 0), cA, voffA); PG8_STAGE(PG8_SA(0, 1), cA + hstep, voffA);
        if (wr == 1) PG8_BAR;
        PG8_WAIT_V(2); PG8_BAR;
        PG8_STAGE(PG8_SB(1, 0), cB + kstep, voffB); PG8_STAGE(PG8_SA(1, 0), cA + kstep, voffA); PG8_STAGE(PG8_SB(1, 1), cB + hstep + kstep, voffB);
        PG8_WAIT_V(6); PG8_BAR;
    } else {
        PG8_STAGE(PG8_SB(0, 0), cB, voffB); PG8_STAGE(PG8_SA(0, 0), cA, voffA); PG8_STAGE(PG8_SB(0, 1), cB + hstep, voffB); PG8_STAGE(PG8_SA(0, 1), cA + hstep, voffA);
        if (wr == 1) PG8_BAR;
        PG8_WAIT_V(4); PG8_BAR;
        PG8_STAGE(PG8_SB(1, 0), cB + kstep, voffB); PG8_STAGE(PG8_SA(1, 0), cA + kstep, voffA); PG8_STAGE(PG8_SB(1, 1), cB + hstep + kstep, voffB);
        PG8_WAIT_V(6); PG8_BAR;
    }
    for (;;) {
        const bool has_next = S.next(ui + 1, nxt);
        const char* nA = has_next ? (const char*)g.A + (size_t)nxt.pm * tstep : cA; const char* nB = has_next ? (const char*)g.Bt + (size_t)nxt.pb * tstep : cB;
        for (int t = 0; t < nt; t += 2) {
            const bool last = (t == nt - 2);
            const char* a1 = cA + (size_t)(t + 1) * kstep;
            const char* a2 = last ? nA : cA + (size_t)(t + 2) * kstep; const char* b2 = last ? nB : cB + (size_t)(t + 2) * kstep;
            const char* a3 = a2 + kstep; const char* b3 = b2 + kstep;
            if (last && has_next) S.a_ready(nxt);
            if constexpr (SP2) {
            PG8_LDB(B0, 0, 0); PG8_LDB(B1, 0, 1); PG8_SCHED; PG8_LDA(At, 0, 0); PG8_STAGE(PG8_SA(1, 1), a1 + hstep, voffA);
            PG8_WAIT_V(8); PG8_WAIT_L(0); PG8_BAR; PG8_MMA(0, 0, At, B0); PG8_MMA(0, 1, At, B1); PG8_BAR; PG8_SCHED;
            PG8_LDA(At, 0, 1); PG8_STAGE(PG8_SB(0, 0), b2, voffB); PG8_STAGE(PG8_SB(0, 1), b2 + hstep, voffB); PG8_STAGE(PG8_SA(0, 0), a2, voffA);
            PG8_WAIT_V(8); PG8_WAIT_L(0); PG8_BAR; PG8_MMA(1, 0, At, B0); PG8_MMA(1, 1, At, B1); PG8_BAR; PG8_SCHED;
            PG8_LDB(B0, 1, 0); PG8_LDB(B1, 1, 1); PG8_SCHED; PG8_LDA(At, 1, 0); PG8_STAGE(PG8_SA(0, 1), a2 + hstep, voffA);
            PG8_WAIT_V(8); PG8_WAIT_L(0); PG8_BAR; PG8_MMA(0, 0, At, B0); PG8_MMA(0, 1, At, B1); PG8_BAR; PG8_SCHED;
            PG8_LDA(At, 1, 1); PG8_STAGE(PG8_SB(1, 0), b3, voffB); PG8_STAGE(PG8_SB(1, 1), b3 + hstep, voffB); PG8_STAGE(PG8_SA(1, 0), a3, voffA);
            PG8_WAIT_V(8); PG8_WAIT_L(0); PG8_BAR; PG8_MMA(1, 0, At, B0); PG8_MMA(1, 1, At, B1); PG8_BAR; PG8_SCHED;
            } else {
            PG8_LDB(B0, 0, 0); PG8_SCHED; PG8_LDA(At, 0, 0); PG8_STAGE(PG8_SA(1, 1), a1 + hstep, voffA);
            PG8_WAIT_L(8); PG8_BAR; PG8_WAIT_L(0); PG8_MMA(0, 0, At, B0); PG8_BAR; PG8_SCHED;
            PG8_LDB(B1, 0, 1); PG8_STAGE(PG8_SB(0, 0), b2, voffB);
            PG8_BAR; PG8_WAIT_L(0); PG8_MMA(0, 1, At, B1); PG8_BAR;
            PG8_LDA(At, 0, 1); PG8_STAGE(PG8_SA(0, 0), a2, voffA);
            PG8_BAR; PG8_WAIT_L(0); PG8_MMA(1, 0, At, B0); PG8_BAR; PG8_SCHED;
            PG8_STAGE(PG8_SB(0, 1), b2 + hstep, voffB);
            PG8_WAIT_V(6); PG8_BAR; PG8_MMA(1, 1, At, B1); PG8_BAR;
            PG8_LDB(B0, 1, 0); PG8_SCHED; PG8_LDA(At, 1, 0); PG8_STAGE(PG8_SA(0, 1), a2 + hstep, voffA);
            PG8_WAIT_L(8); PG8_BAR; PG8_WAIT_L(0); PG8_MMA(0, 0, At, B0); PG8_BAR; PG8_SCHED;
            PG8_LDB(B1, 1, 1); PG8_STAGE(PG8_SB(1, 0), b3, voffB);
            PG8_BAR; PG8_WAIT_L(0); PG8_MMA(0, 1, At, B1); PG8_BAR;
            PG8_LDA(At, 1, 1); PG8_STAGE(PG8_SA(1, 0), a3, voffA);
            PG8_BAR; PG8_WAIT_L(0); PG8_MMA(1, 0, At, B0); PG8_BAR; PG8_SCHED;
            PG8_STAGE(PG8_SB(1, 1), b3 + hstep, voffB);
            PG8_WAIT_V(6); PG8_BAR; PG8_MMA(1, 1, At, B1); PG8_BAR;
            }
        }
        if constexpr (Epi::F8) { asm volatile("s_nop 15\n\ts_nop 15" ::: "memory"); }
        if constexpr (ALIGN_EPI) { if (wr == 0) PG8_BAR; }
        if constexpr (!Epi::AFTER_DRAIN) { E(acc, cur, wr, wc, fr, fq); S.done(cur); }
        if (!has_next) break;
#pragma unroll
        for (int a = 0; a < 2; ++a)
#pragma unroll
            for (int b = 0; b < 2; ++b)
#pragma unroll
                for (int m = 0; m < 4; ++m)
#pragma unroll
                    for (int n = 0; n < 2; ++n) acc[a][b][m][n] = (f32x4){0.f, 0.f, 0.f, 0.f};
        cur = nxt; cA = nA; cB = nB; ++ui;
        if constexpr (ALIGN_EPI) { if (wr == 1) PG8_BAR; }
    }
    PG8_WAIT_V(0);
    if constexpr (!ALIGN_EPI) { if (wr == 0) PG8_BAR; }
    PG8_BAR;
    if constexpr (Epi::AFTER_DRAIN) { E.fused(acc, cur, wr, wc, fr, fq, lds, wid, lane); S.done(cur); }
#undef PG8_SA
#undef PG8_SB
#undef PG8_STAGE
#undef PG8_LDA
#undef PG8_LDB
#undef PG8_MMA
#undef PG8_LD16
#undef PG8_WAIT_V
#undef PG8_WAIT_L
#undef PG8_BAR
#undef PG8_SCHED
}
}

#ifndef PG8_SP2
#define PG8_SP2 true
#endif
#ifndef PG8_ALIGN
#define PG8_ALIGN true
#endif
constexpr int D = 1024, SEQ = 8192, NLAT = 16384, CTXL = 256, NCTX = 512, NTOK = NLAT + NCTX;
constexpr int NE = 16, FF = 2816, EVEN_IN = 2560, ODD_IN = 2080;
constexpr int MOE_LAT = 32768, MOE_ROWS = 36864;
constexpr float EPS = 1e-6f;
constexpr int NWAVES = 8;
enum { I_X = 0, I_C, I_CTX, I_CCTX, I_WMOD, I_BMOD, I_NORMG, I_WINE, I_WOUTE, I_CONVW, I_CONVB, I_CLNG, I_CLNB, I_RPB, I_WINO, I_WOUTO, I_POOLW, I_POOLS, I_GATEW, I_GATEB, I_HEADG, I_ROUTER, I_WG, I_WU, I_WD, N_IN };

constexpr size_t MiB = 1u << 20;
constexpr size_t alup(size_t x) { return (x + MiB - 1) / MiB * MiB; }
constexpr size_t WS_CTL = 0, CTL_ZERO_BYTES = MiB;
constexpr size_t WS_MOD = WS_CTL + MiB;
constexpr size_t WS_ROPE = WS_MOD + alup((size_t)2 * 3 * 6144 * 4);
constexpr size_t WS_AFF = WS_ROPE + MiB;
constexpr size_t WS_INV = WS_AFF + alup((size_t)NTOK * 16 * 4);
constexpr size_t WS_ROWTOK = WS_INV + alup((size_t)NTOK * 16 * 4);
constexpr size_t WS_LR = WS_ROWTOK + alup((size_t)MOE_ROWS * 4);
constexpr size_t WS_WINE = WS_LR + alup((size_t)NTOK * 32 * 4);
constexpr size_t WS_WOUTE = WS_WINE + alup((size_t)2560 * 1024 * 2);
constexpr size_t WS_WINO = WS_WOUTE + alup((size_t)1024 * 1024 * 2);
constexpr size_t WS_WOUTO = WS_WINO + alup((size_t)2080 * 1024 * 2);
constexpr size_t WS_POOLW = WS_WOUTO + alup((size_t)1024 * 1024 * 2);
constexpr size_t WS_W1 = WS_POOLW + MiB;
constexpr size_t WS_W2 = WS_W1 + alup((size_t)2 * 16 * 5632 * 1024 * 2);
constexpr size_t WS_H = WS_W2 + alup((size_t)2 * 16 * 1024 * 2816 * 2);
constexpr size_t WS_X1 = WS_H + alup((size_t)NTOK * 1024 * 2);
constexpr size_t WS_XN2 = WS_X1 + alup((size_t)NTOK * 1024 * 4);
constexpr size_t WS_PBUF = WS_XN2 + alup((size_t)NTOK * 1024 * 2);
constexpr size_t WS_MIX = WS_PBUF + alup((size_t)NTOK * 2560 * 2);
constexpr size_t WS_YO = WS_MIX + alup((size_t)NTOK * 1024 * 2);
constexpr size_t WS_MOE = WS_YO + alup((size_t)NTOK * 1024 * 2);
constexpr size_t WS_XG = WS_MOE;
constexpr size_t WS_HID = WS_XG + alup((size_t)MOE_ROWS * 1024 * 2);
constexpr size_t WS_Y = WS_HID + alup((size_t)MOE_ROWS * 2816 * 2);
constexpr size_t WS_END = WS_Y + alup((size_t)MOE_ROWS * 1024 * 2);
constexpr size_t WS_DPOOL = WS_MOE;
constexpr size_t WS_QR = WS_DPOOL + alup((size_t)NLAT * 512 * 2);
constexpr size_t WS_KR = WS_QR + alup((size_t)NLAT * 256 * 4);
constexpr size_t WS_GF = WS_KR + alup((size_t)NTOK * 256 * 4);
constexpr size_t WS_GB = WS_GF + alup((size_t)NTOK * 256 * 4);
constexpr size_t WS_QE = WS_GB + alup((size_t)NTOK * 256 * 4);
constexpr size_t WS_KD = WS_QE + alup((size_t)2 * NLAT * 256 * 2);
constexpr size_t WS_UT = WS_KD + alup((size_t)2 * NLAT * 256 * 2);
constexpr size_t WS_DC = WS_UT + alup((size_t)16 * 132 * 8192 * 4);
constexpr size_t WS_ST = WS_DC + MiB;
constexpr size_t WS_OACC = WS_ST + alup((size_t)16 * 128 * 8192 * 2);
constexpr size_t WS_GLA_END = WS_OACC + alup((size_t)2 * NLAT * 512 * 4);
static_assert(WS_GLA_END <= WS_END, "overlay fits");
constexpr int CW_TMO = 0, CW_BAR = 4096;

constexpr int RING_OFF = 0, RING_BYTES = 131072;
constexpr int LDSCTL_OFF = RING_BYTES, MISC_OFF = LDSCTL_OFF + 320;
constexpr int LDS_BYTES = 147456;

#define GAS __attribute__((address_space(1)))
#define LAS __attribute__((address_space(3)))
typedef unsigned short bf16;
typedef unsigned v4u __attribute__((ext_vector_type(4)));
typedef unsigned v2u __attribute__((ext_vector_type(2)));
typedef float f32x4 __attribute__((ext_vector_type(4)));
typedef short bf16x8 __attribute__((ext_vector_type(8)));
typedef GAS unsigned gu32;
#define RLX_AGENT __ATOMIC_RELAXED, __HIP_MEMORY_SCOPE_AGENT
#define LDS_WAIT() asm volatile("s_waitcnt lgkmcnt(0)" ::: "memory")
#define VM_WAIT() asm volatile("s_waitcnt vmcnt(0)" ::: "memory")
__device__ __forceinline__ unsigned f2bf(float f) { unsigned u = __builtin_bit_cast(unsigned, f); return (u + 0x7fffu + ((u >> 16) & 1u)) >> 16; }
typedef float f32x2_c __attribute__((ext_vector_type(2)));
typedef __bf16 bf16x2_c __attribute__((ext_vector_type(2)));
__device__ __forceinline__ unsigned pk2(float lo, float hi) { f32x2_c v; v.x = lo; v.y = hi; const bf16x2_c r = __builtin_convertvector(v, bf16x2_c); return __builtin_bit_cast(unsigned, r); }
__device__ __forceinline__ float bflo(unsigned w) { return __builtin_bit_cast(float, w << 16); }
__device__ __forceinline__ float bfhi(unsigned w) { return __builtin_bit_cast(float, w & 0xffff0000u); }
__device__ __forceinline__ float bf2f(bf16 b) { return __builtin_bit_cast(float, ((unsigned)b) << 16); }
template <int CTRL> __device__ __forceinline__ float dpp_mov(float v) { return __builtin_bit_cast(float, __builtin_amdgcn_update_dpp(0, __builtin_bit_cast(int, v), CTRL, 0xF, 0xF, true)); }
__device__ __forceinline__ float lane_xor1(float v) { return dpp_mov<0xB1>(v); }
__device__ __forceinline__ float lane_xor2(float v) { return dpp_mov<0x4E>(v); }
__device__ __forceinline__ float lane_xor4(float v) { return dpp_mov<0x1B>(dpp_mov<0x141>(v)); }
__device__ __forceinline__ float lane_xor8(float v) { return dpp_mov<0x141>(dpp_mov<0x140>(v)); }
__device__ __forceinline__ float row16_sum(float v) { v += lane_xor1(v); v += lane_xor2(v); v += dpp_mov<0x141>(v); v += dpp_mov<0x140>(v); return v; }
__device__ __forceinline__ float wave_sum(float v) {
    v = row16_sum(v); const int b = __builtin_bit_cast(int, v);
    const float r0 = __builtin_bit_cast(float, __builtin_amdgcn_readlane(b, 0)), r1 = __builtin_bit_cast(float, __builtin_amdgcn_readlane(b, 16)), r2 = __builtin_bit_cast(float, __builtin_amdgcn_readlane(b, 32)), r3 = __builtin_bit_cast(float, __builtin_amdgcn_readlane(b, 48));
    return (r0 + r1) + (r2 + r3);
}
typedef unsigned u32x2_t __attribute__((ext_vector_type(2)));
__device__ __forceinline__ void swap16(float v, float& own, float& other) { const u32x2_t r = __builtin_amdgcn_permlane16_swap(__builtin_bit_cast(unsigned, v), __builtin_bit_cast(unsigned, v), false, false); const unsigned r0 = r.x, r1 = r.y; own = __builtin_bit_cast(float, r0); other = __builtin_bit_cast(float, r1); }
__device__ __forceinline__ void swap32(float v, float& own, float& other) { const u32x2_t r = __builtin_amdgcn_permlane32_swap(__builtin_bit_cast(unsigned, v), __builtin_bit_cast(unsigned, v), false, false); const unsigned r0 = r.x, r1 = r.y; own = __builtin_bit_cast(float, r0); other = __builtin_bit_cast(float, r1); }
__device__ __forceinline__ float xor16_max(float v) { float a, b; swap16(v, a, b); return fmaxf(a, b); }
__device__ __forceinline__ float xor32_max(float v) { float a, b; swap32(v, a, b); return fmaxf(a, b); }
__device__ __forceinline__ float xor16_sum(float v) { float a, b; swap16(v, a, b); return a + b; }
__device__ __forceinline__ float xor32_sum(float v) { float a, b; swap32(v, a, b); return a + b; }
__device__ __forceinline__ float silu(float x) { return x / (1.0f + __expf(-x)); }
__device__ __forceinline__ float sigmoidf(float x) { return 1.0f / (1.0f + __expf(-x)); }
#define XB_TMO      128
#define XB_XCNT(j)  (256  + 64 * (j))
#define XB_XSUB(j)  (1280 + 64 * (j))
#define XB_XGEN(j)  (2304 + 64 * (j))
#define XB_TOP      3328
#define XB_TOPGEN   3392
#define XCD_BAR_WORDS 3456
#define XB_SPIN_CAP (1u << 18)

__device__ __forceinline__ unsigned xb_ld(unsigned* p)              { return __hip_atomic_load(p, __ATOMIC_RELAXED, __HIP_MEMORY_SCOPE_AGENT); }
__device__ __forceinline__ unsigned xb_add(unsigned* p, unsigned v) { return __hip_atomic_fetch_add(p, v, __ATOMIC_RELAXED, __HIP_MEMORY_SCOPE_AGENT); }
__device__ __forceinline__ unsigned xb_xcc_id() { return (unsigned)__builtin_amdgcn_s_getreg((3 << 11) | 20) & 0xFu; }
#define XB_SPIN(cond, bar) do { unsigned _sp = 0; while (cond) { __builtin_amdgcn_s_sleep(1); \
    if ((++_sp & 255u) == 0u) { if (xb_ld(&(bar)[XB_TMO])) break; if (_sp > XB_SPIN_CAP) { atomicAdd(&(bar)[XB_TMO], 1u); break; } } } } while (0)

struct XcdBarrier {
    unsigned* bar; unsigned x;
    volatile LAS unsigned* st;
};

__device__ __forceinline__ XcdBarrier xcd_barrier_post(unsigned* bar, volatile LAS unsigned* st) {
    XcdBarrier b; b.bar = bar; b.x = xb_xcc_id(); b.st = st;
    if (threadIdx.x == 0) (void)xb_add(&bar[XB_XCNT(b.x)], 1u);
    return b;
}
__device__ __forceinline__ void xcd_barrier_complete(unsigned* bar, unsigned x, unsigned& nloc, unsigned& nx) {
    const unsigned G = gridDim.x * gridDim.y * gridDim.z;
    unsigned sum, cnt, mine, sp = 0u;
    for (;;) {
        sum = 0u; cnt = 0u; mine = 0u;
#pragma unroll
        for (unsigned j = 0; j < 16; ++j) { const unsigned c = xb_ld(&bar[XB_XCNT(j)]); sum += c; cnt += (c > 0u) ? 1u : 0u; mine = (j == x) ? c : mine; }
        if (sum == G) break;
        __builtin_amdgcn_s_sleep(1);
        if ((++sp & 255u) == 0u) { if (xb_ld(&bar[XB_TMO])) break; if (sp > XB_SPIN_CAP) { atomicAdd(&bar[XB_TMO], 1u); break; } }
    }
    nloc = mine > 0u ? mine : 1u; nx = cnt > 0u ? cnt : 1u;
}

__device__ __forceinline__ void xcd_barrier(const XcdBarrier& b) {
    asm volatile("s_waitcnt vmcnt(0)" ::: "memory");
    __syncthreads();
    if (threadIdx.x == 0) {
        unsigned* bar = b.bar;
        __builtin_amdgcn_s_waitcnt(0);
        unsigned nloc = b.st[0], nx = b.st[1];
        if (nloc == 0u) { xcd_barrier_complete(bar, b.x, nloc, nx); b.st[0] = nloc; b.st[1] = nx; }
        const unsigned old = xb_add(&bar[XB_XSUB(b.x)], 1u);
        const unsigned gen = old / nloc;
        if (old + 1u == (gen + 1u) * nloc) {
            __builtin_amdgcn_fence(__ATOMIC_RELEASE, "agent");
            asm volatile("s_waitcnt vmcnt(0)" ::: "memory");
            const unsigned og = xb_add(&bar[XB_TOP], 1u);
            const unsigned tg = og / nx;
            if (og + 1u == (tg + 1u) * nx) xb_add(&bar[XB_TOPGEN], 1u);
            else XB_SPIN(xb_ld(&bar[XB_TOPGEN]) == tg, bar);
            __builtin_amdgcn_fence(__ATOMIC_ACQUIRE, "agent");
            xb_add(&bar[XB_XGEN(b.x)], 1u);
            asm volatile("s_waitcnt vmcnt(0)" ::: "memory");
        } else {
            XB_SPIN(xb_ld(&bar[XB_XGEN(b.x)]) == gen, bar);
            __builtin_amdgcn_fence(__ATOMIC_ACQUIRE, "agent");
            asm volatile("s_waitcnt vmcnt(0)" ::: "memory");
        }
    }
    __syncthreads();
}

#define CAS __attribute__((address_space(4)))
struct Args { const float* in[N_IN]; float* out; unsigned char* ws; int ph_lo, ph_hi; };
struct Ctx {
    LAS unsigned char* lds;
    const CAS Args* a; float* out; unsigned char* ws;
    int tid, lane, wave, G, gw, ngw;
};
#define WSP(T, off) ((T*)(c.ws + (off)))

__device__ __forceinline__ f32x4 wave_tile16(const bf16* A, int lda, const bf16* Bt, int ldb, int K, int lane) {
    const bf16* ap = A + (size_t)(lane & 15) * lda + 8 * (lane >> 4);
    const bf16* bp = Bt + (size_t)(lane & 15) * ldb + 8 * (lane >> 4);
    f32x4 acc = {0.f, 0.f, 0.f, 0.f};
#pragma unroll 8
    for (int k = 0; k < K; k += 32) {
        const bf16x8 a = *(const bf16x8*)(ap + k), b = *(const bf16x8*)(bp + k);
        acc = __builtin_amdgcn_mfma_f32_16x16x32_bf16(b, a, acc, 0, 0, 0);
    }
    return acc;
}

__device__ __forceinline__ void transpose_tile(const float* W, int N, int k0, int n0, bf16* dst, int ldd, LAS float* scr, int lane) {
#pragma unroll 8
    for (int i = 0; i < 32; ++i) { const int kk = 2 * i + (lane >> 5); scr[kk * 33 + (lane & 31)] = W[(size_t)(k0 + kk) * N + n0 + (lane & 31)]; }
    LDS_WAIT(); asm volatile("" ::: "memory");
    const int cc = lane & 7;
#pragma unroll
    for (int j = 0; j < 4; ++j) { const int n = (lane >> 3) + 8 * j; const LAS float* s = scr + (8 * cc) * 33 + n;
        v4u o; o.x = pk2(s[0 * 33], s[1 * 33]); o.y = pk2(s[2 * 33], s[3 * 33]); o.z = pk2(s[4 * 33], s[5 * 33]); o.w = pk2(s[6 * 33], s[7 * 33]);
        *(v4u*)(dst + (size_t)n * ldd + 8 * cc) = o; }
    LDS_WAIT(); asm volatile("" ::: "memory");
}

constexpr float SC_W = 64.0f, SC_X = 16.0f, SC_H = 8.0f;
__device__ __forceinline__ void transpose64_f8(const float* W, int N, int k0, int n0, unsigned char* dst, int ldd, LAS float* scr, int lane) {
    const int cq = lane & 15, rq = lane >> 4;
    f32x4 v[16];
#pragma unroll
    for (int i = 0; i < 16; ++i) v[i] = *(const f32x4*)(W + (size_t)(k0 + rq + 4 * i) * N + n0 + 4 * cq);
#pragma unroll
    for (int i = 0; i < 16; ++i) *(LAS f32x4*)(scr + (rq + 4 * i) * 64 + 4 * cq) = v[i];
    LDS_WAIT(); asm volatile("" ::: "memory");
    unsigned o[16];
#pragma unroll
    for (int j = 0; j < 16; ++j) o[j] = pg8::pk4_fp8(scr[(4 * j) * 64 + lane] * SC_W, scr[(4 * j + 1) * 64 + lane] * SC_W, scr[(4 * j + 2) * 64 + lane] * SC_W, scr[(4 * j + 3) * 64 + lane] * SC_W);
#pragma unroll
    for (int t = 0; t < 4; ++t) { v4u w; w.x = o[4 * t]; w.y = o[4 * t + 1]; w.z = o[4 * t + 2]; w.w = o[4 * t + 3]; *(v4u*)(dst + (size_t)lane * ldd + 16 * t) = w; }
    LDS_WAIT(); asm volatile("" ::: "memory");
}

constexpr int TI_WINE = (1024 / 64) * (2560 / 32), TI_WOUT = (1024 / 64) * (1024 / 32), TI_WINO = (1024 / 64) * (2080 / 32), TI_POOL = 4 * 2 * 4;
constexpr int TI_SMALL = TI_WINE + 2 * TI_WOUT + TI_WINO + TI_POOL;
constexpr int TI_GU = (1024 / 64) * (2816 / 64), TI_DN = (2816 / 64) * (1024 / 64);
constexpr int TI_PER_LE = 2 * TI_GU + TI_DN;
constexpr int TI_TOTAL = TI_SMALL + 32 * TI_PER_LE;

__device__ __forceinline__ void ph_prologue(const Ctx& c) {
    if (blockIdx.x < 192) {
        LAS float* sl = (LAS float*)c.lds;
        LAS float* red = sl + 3 * 1024;
        for (int i = c.tid; i < 3072; i += 512) { const int s = i >> 10, k = i & 1023; const float v = s < 2 ? c.a->in[I_C][s * 1024 + k] : c.a->in[I_CCTX][k]; sl[i] = silu(v); }
        __syncthreads();
        const int item = blockIdx.x, l = item / 96, j = 64 * (item % 96) + c.lane;
        const float* W = c.a->in[I_WMOD] + (size_t)l * 1024 * 6144 + j;
        float a0 = 0.f, a1 = 0.f, a2 = 0.f;
#pragma unroll 8
        for (int kk = 0; kk < 128; ++kk) { const int k = c.wave * 128 + kk; const float w = W[(size_t)k * 6144]; a0 += sl[k] * w; a1 += sl[1024 + k] * w; a2 += sl[2048 + k] * w; }
        red[(c.wave * 3 + 0) * 64 + c.lane] = a0; red[(c.wave * 3 + 1) * 64 + c.lane] = a1; red[(c.wave * 3 + 2) * 64 + c.lane] = a2;
        __syncthreads();
        if (c.wave < 3) { float s = 0.f;
#pragma unroll
            for (int w = 0; w < 8; ++w) s += red[(w * 3 + c.wave) * 64 + c.lane];
            WSP(float, WS_MOD)[(l * 3 + c.wave) * 6144 + j] = s + c.a->in[I_BMOD][l * 6144 + j]; }
        __syncthreads();
    }
    { const int g = blockIdx.x * 512 + c.tid;
      if (g < 192 * 16) { const int pos = g >> 4, f = g & 15; const float inv = powf(10000.0f, -(float)f / 16.0f); const float ang = (float)(pos < 128 ? pos : pos - 128) * inv;
          float sn, cs; sincosf(ang, &sn, &cs); float* T = WSP(float, WS_ROPE); T[g * 2] = cs; T[g * 2 + 1] = sn; } }
    LAS float* scr = (LAS float*)(c.lds + c.wave * 16384);
    for (int it = c.gw; it < TI_SMALL; it += c.ngw) {
        int r = it;
        {
            if (r < TI_WINE) { const int nb = 2560 / 32, kb = r / nb, n0 = 32 * (r % nb); transpose_tile(c.a->in[I_WINE], 2560, 64 * kb, n0, WSP(bf16, WS_WINE) + (size_t)n0 * 1024 + 64 * kb, 1024, scr, c.lane); continue; } r -= TI_WINE;
            if (r < TI_WOUT) { const int nb = 32, kb = r / nb, n0 = 32 * (r % nb); transpose_tile(c.a->in[I_WOUTE], 1024, 64 * kb, n0, WSP(bf16, WS_WOUTE) + (size_t)n0 * 1024 + 64 * kb, 1024, scr, c.lane); continue; } r -= TI_WOUT;
            if (r < TI_WOUT) { const int nb = 32, kb = r / nb, n0 = 32 * (r % nb); transpose_tile(c.a->in[I_WOUTO], 1024, 64 * kb, n0, WSP(bf16, WS_WOUTO) + (size_t)n0 * 1024 + 64 * kb, 1024, scr, c.lane); continue; } r -= TI_WOUT;
            if (r < TI_WINO) { const int nb = 2080 / 32, kb = r / nb, n0 = 32 * (r % nb); transpose_tile(c.a->in[I_WINO], 2080, 64 * kb, n0, WSP(bf16, WS_WINO) + (size_t)n0 * 1024 + 64 * kb, 1024, scr, c.lane); continue; } r -= TI_WINO;
            { const int g = r / 8, kb = (r % 8) / 4, n0 = 32 * (r % 4);
              transpose_tile(c.a->in[I_POOLW] + (size_t)g * 128 * 128, 128, 64 * kb, n0, WSP(bf16, WS_POOLW) + (size_t)g * 128 * 128 + (size_t)n0 * 128 + 64 * kb, 128, scr, c.lane); continue; }
        }
    }
    __syncthreads();
    {
        constexpr int NIT = 32 * 528;
        f32x4 v[8];
        unsigned* qctr = (unsigned*)(c.ws + WS_CTL) + 2048;
        volatile LAS unsigned* qslot = (volatile LAS unsigned*)(c.lds + MISC_OFF) + 16;
        int it = blockIdx.x, buf = 0, par = 0;
        const float* src = nullptr; int N = 0, k0 = 0, n0 = 0, le = 0, which = 0;
#define PRO_DECODE(IT) do { le = (IT) / 528; const int q_ = (IT) % 528; which = q_ / 176; const int r_ = q_ % 176; \
            if (which < 2) { n0 = 256 * (r_ / 16); k0 = 64 * (r_ % 16); N = 2816; src = c.a->in[which ? I_WU : I_WG] + (size_t)le * 1024 * 2816; } \
            else { n0 = 256 * (r_ / 44); k0 = 64 * (r_ % 44); N = 1024; src = c.a->in[I_WD] + (size_t)le * 2816 * 1024; } } while (0)
#define PRO_LOAD() do { _Pragma("unroll") for (int i = 0; i < 8; ++i) v[i] = __builtin_nontemporal_load((const f32x4*)(src + (size_t)(k0 + 8 * c.wave + i) * N + n0 + 4 * c.lane)); } while (0)
        if (it < NIT) { PRO_DECODE(it); PRO_LOAD(); }
        while (it < NIT) {
            unsigned nx = 0u; if (c.tid == 0) nx = c.G + __hip_atomic_fetch_add(qctr, 1u, __ATOMIC_RELAXED, __HIP_MEMORY_SCOPE_AGENT);
            LAS float* img = (LAS float*)(c.lds + buf * 65536);
#pragma unroll
            for (int i = 0; i < 8; ++i) *(LAS f32x4*)(img + (8 * c.wave + i) * 256 + 4 * c.lane) = v[i];
            const int n = n0 + (c.tid & 255), kh = c.tid >> 8;
            unsigned char* dst = which < 2 ? WSP(unsigned char, WS_W1) + ((size_t)le * 5632 + (n / 128) * 256 + (n % 128) + which * 128) * 1024 + k0 + 32 * kh
                                           : WSP(unsigned char, WS_W2) + ((size_t)le * 1024 + n) * 2816 + k0 + 32 * kh;
            if (c.tid == 0) qslot[par] = nx;
            __syncthreads();
            const int nxt = (int)qslot[par];
            if (nxt < NIT) { PRO_DECODE(nxt); PRO_LOAD(); }
            const LAS float* s = img + (32 * kh) * 256 + (c.tid & 255);
#pragma unroll
            for (int t = 0; t < 2; ++t) { v4u w;
                w.x = pg8::pk4_fp8(s[(16 * t + 0) * 256] * SC_W, s[(16 * t + 1) * 256] * SC_W, s[(16 * t + 2) * 256] * SC_W, s[(16 * t + 3) * 256] * SC_W);
                w.y = pg8::pk4_fp8(s[(16 * t + 4) * 256] * SC_W, s[(16 * t + 5) * 256] * SC_W, s[(16 * t + 6) * 256] * SC_W, s[(16 * t + 7) * 256] * SC_W);
                w.z = pg8::pk4_fp8(s[(16 * t + 8) * 256] * SC_W, s[(16 * t + 9) * 256] * SC_W, s[(16 * t + 10) * 256] * SC_W, s[(16 * t + 11) * 256] * SC_W);
                w.w = pg8::pk4_fp8(s[(16 * t + 12) * 256] * SC_W, s[(16 * t + 13) * 256] * SC_W, s[(16 * t + 14) * 256] * SC_W, s[(16 * t + 15) * 256] * SC_W);
                *(v4u*)(dst + 16 * t) = w; }
            it = nxt; buf ^= 1; par ^= 1;
        }
        __syncthreads();
#undef PRO_DECODE
#undef PRO_LOAD
    }
}

__device__ __forceinline__ void ph_adaln0(const Ctx& c) {
    const f32x4* g4 = (const f32x4*)c.a->in[I_NORMG];
    for (int m = c.gw; m < NTOK; m += c.ngw) {
        const f32x4* xr = (const f32x4*)(m < NLAT ? c.a->in[I_X] + (size_t)m * 1024 : c.a->in[I_CTX] + (size_t)(m - NLAT) * 1024);
        const int s = m < NLAT ? m / SEQ : 2;
        const f32x4* mod4 = (const f32x4*)(WSP(float, WS_MOD) + (size_t)s * 6144);
        f32x4 x[4]; float ss = 0.f;
#pragma unroll
        for (int j = 0; j < 4; ++j) { x[j] = xr[c.lane + 64 * j]; ss += (x[j][0] * x[j][0] + x[j][1] * x[j][1]) + (x[j][2] * x[j][2] + x[j][3] * x[j][3]); }
        const float rs = 1.0f / sqrtf(wave_sum(ss) * (1.0f / 1024.0f) + EPS);
        v2u* ho = (v2u*)(WSP(bf16, WS_H) + (size_t)m * 1024);
#pragma unroll
        for (int j = 0; j < 4; ++j) { const int idx = c.lane + 64 * j; const f32x4 o = x[j] * rs * g4[idx] * (mod4[256 + idx] + 1.0f) + mod4[idx];
            v2u pk; pk.x = pk2(o[0], o[1]); pk.y = pk2(o[2], o[3]); ho[idx] = pk; }
    }
}

__device__ __forceinline__ void ph_conv(const Ctx& c) {
    LAS bf16* glu = (LAS bf16*)c.lds;
    LAS float* yb = (LAS float*)(c.lds + 65536);
    const bf16* P = WSP(bf16, WS_PBUF);
    const int ch = c.tid;
    float w[31];
#pragma unroll
    for (int i = 0; i < 31; ++i) w[i] = c.a->in[I_CONVW][i * 512 + ch];
    const float cb = c.a->in[I_CONVB][ch];
    const bool g256 = (c.G == 256); const int nrnd = g256 ? 3 : (NTOK / 32 + (int)c.G - 1) / (int)c.G;
    for (int rnd = 0; rnd < nrnd; ++rnd) {
        const int item = (g256 && rnd == 2) ? 512 + (int)blockIdx.x - 16 : (int)blockIdx.x + rnd * (int)c.G;
        if (item >= NTOK / 32 || item < 0 || (g256 && rnd == 2 && (int)blockIdx.x < 16)) continue;
        const int t0 = item * 32;
        int lo, hi; if (t0 < NLAT) { lo = (t0 / SEQ) * SEQ; hi = lo + SEQ; } else { lo = NLAT + ((t0 - NLAT) / CTXL) * CTXL; hi = lo + CTXL; }
        for (int i = c.tid; i < 62 * 64; i += 512) { const int rr = i >> 6, c8 = (i & 63) * 8, row = t0 - 15 + rr;
            v4u o = {0u, 0u, 0u, 0u};
            if (row >= lo && row < hi) { const v4u a = *(const v4u*)(P + (size_t)row * 2560 + c8), b = *(const v4u*)(P + (size_t)row * 2560 + 512 + c8);
                o.x = pk2(bflo(a.x) * sigmoidf(bflo(b.x)), bfhi(a.x) * sigmoidf(bfhi(b.x))); o.y = pk2(bflo(a.y) * sigmoidf(bflo(b.y)), bfhi(a.y) * sigmoidf(bfhi(b.y)));
                o.z = pk2(bflo(a.z) * sigmoidf(bflo(b.z)), bfhi(a.z) * sigmoidf(bfhi(b.z))); o.w = pk2(bflo(a.w) * sigmoidf(bflo(b.w)), bfhi(a.w) * sigmoidf(bfhi(b.w))); }
            *(LAS v4u*)(glu + rr * 512 + c8) = o; }
        __syncthreads();
        float acc[32];
#pragma unroll
        for (int t = 0; t < 32; ++t) acc[t] = cb;
#pragma unroll
        for (int rr = 0; rr < 62; ++rr) { const float gv = bf2f(glu[rr * 512 + ch]);
#pragma unroll
            for (int t = 0; t < 32; ++t) if (rr - t >= 0 && rr - t <= 30) acc[t] += gv * w[rr - t]; }
#pragma unroll
        for (int t = 0; t < 32; ++t) yb[t * 512 + ch] = acc[t];
        __syncthreads();
#pragma unroll
        for (int tt = 0; tt < 4; ++tt) { const int t = c.wave * 4 + tt;
            const f32x4 v0 = *(const LAS f32x4*)(yb + t * 512 + 8 * c.lane), v1 = *(const LAS f32x4*)(yb + t * 512 + 8 * c.lane + 4);
            const float mu = wave_sum((v0[0] + v0[1]) + (v0[2] + v0[3]) + (v1[0] + v1[1]) + (v1[2] + v1[3])) * (1.0f / 512.0f);
            float q = 0.f; float d[8];
#pragma unroll
            for (int j = 0; j < 4; ++j) { d[j] = v0[j] - mu; d[4 + j] = v1[j] - mu; }
#pragma unroll
            for (int j = 0; j < 8; ++j) q += d[j] * d[j];
            const float rstd = 1.0f / sqrtf(wave_sum(q) * (1.0f / 512.0f) + EPS);
            float o[8];
#pragma unroll
            for (int j = 0; j < 8; ++j) { const int k = 8 * c.lane + j; o[j] = silu(d[j] * rstd * c.a->in[I_CLNG][k] + c.a->in[I_CLNB][k]); }
            v4u pk; pk.x = pk2(o[0], o[1]); pk.y = pk2(o[2], o[3]); pk.z = pk2(o[4], o[5]); pk.w = pk2(o[6], o[7]);
            *(v4u*)(WSP(bf16, WS_MIX) + (size_t)(t0 + t) * 1024 + 8 * c.lane) = pk; }
        __syncthreads();
    }
}

__device__ __forceinline__ void ph_na_naive(const Ctx& c) {
    const bf16* P = WSP(bf16, WS_PBUF);
    const int qc = c.tid & 63, h = c.tid >> 6;
    for (int item = blockIdx.x; item < 256 + 8; item += c.G) {
        int b, r = 0, m; const bool lat = item < 256;
        if (lat) { b = item >> 7; r = item & 127; m = b * SEQ + r * 64 + qc; } else { const int ci = item - 256; b = ci >> 2; m = NLAT + b * CTXL + (ci & 3) * 64 + qc; }
        float q[64], o[64];
        { const bf16* qp = P + (size_t)m * 2560 + 1024 + h * 64;
#pragma unroll
          for (int d = 0; d < 64; d += 8) { const v4u a = *(const v4u*)(qp + d); q[d] = bflo(a.x) * 0.125f; q[d + 1] = bfhi(a.x) * 0.125f; q[d + 2] = bflo(a.y) * 0.125f; q[d + 3] = bfhi(a.y) * 0.125f;
              q[d + 4] = bflo(a.z) * 0.125f; q[d + 5] = bfhi(a.z) * 0.125f; q[d + 6] = bflo(a.w) * 0.125f; q[d + 7] = bfhi(a.w) * 0.125f; } }
#pragma unroll
        for (int d = 0; d < 64; ++d) o[d] = 0.f;
        float mx = -1e30f, l = 0.f;
        const int rs = lat ? min(max(r - 4, 0), 120) : 0, cs = min(max(qc - 8, 0), 48);
        const int nwin = lat ? 128 : 0;
        for (int kk = 0; kk < nwin + 256; ++kk) {
            int tok; float bias = 0.f;
            if (kk < nwin) { const int i = kk >> 4, j = kk & 15; tok = b * SEQ + (rs + i) * 64 + cs + j; bias = c.a->in[I_RPB][(h * 15 + (rs + i - r + 7)) * 31 + (cs + j - qc + 15)]; }
            else tok = NLAT + b * CTXL + (kk - nwin);
            const bf16* kp = P + (size_t)tok * 2560 + 1536 + h * 64; const bf16* vp = kp + 512;
            float s = 0.f;
#pragma unroll
            for (int d = 0; d < 64; d += 8) { const v4u a = *(const v4u*)(kp + d);
                s += q[d] * bflo(a.x) + q[d + 1] * bfhi(a.x) + q[d + 2] * bflo(a.y) + q[d + 3] * bfhi(a.y) + q[d + 4] * bflo(a.z) + q[d + 5] * bfhi(a.z) + q[d + 6] * bflo(a.w) + q[d + 7] * bfhi(a.w); }
            s += bias;
            const float mn = fmaxf(mx, s), al = __expf(mx - mn), p = __expf(s - mn);
            l = l * al + p; mx = mn;
#pragma unroll
            for (int d = 0; d < 64; d += 8) { const v4u a = *(const v4u*)(vp + d);
                o[d] = o[d] * al + p * bflo(a.x); o[d + 1] = o[d + 1] * al + p * bfhi(a.x); o[d + 2] = o[d + 2] * al + p * bflo(a.y); o[d + 3] = o[d + 3] * al + p * bfhi(a.y);
                o[d + 4] = o[d + 4] * al + p * bflo(a.z); o[d + 5] = o[d + 5] * al + p * bfhi(a.z); o[d + 6] = o[d + 6] * al + p * bflo(a.w); o[d + 7] = o[d + 7] * al + p * bfhi(a.w); }
        }
        const float il = 1.0f / l;
        bf16* op = WSP(bf16, WS_MIX) + (size_t)m * 1024 + 512 + h * 64;
#pragma unroll
        for (int d = 0; d < 64; d += 8) { v4u pk; pk.x = pk2(o[d] * il, o[d + 1] * il); pk.y = pk2(o[d + 2] * il, o[d + 3] * il); pk.z = pk2(o[d + 4] * il, o[d + 5] * il); pk.w = pk2(o[d + 6] * il, o[d + 7] * il);
            *(v4u*)(op + d) = pk; }
    }
}

__device__ __forceinline__ void ph_outproj_ctx_tiles(const Ctx& c, size_t ws_wout) {
    for (int t = c.gw; t < 32 * 64; t += c.ngw) { const int mt = t >> 6, nt = t & 63;
        const f32x4 a = wave_tile16(WSP(bf16, WS_MIX) + (size_t)(NLAT + 16 * mt) * 1024, 1024, WSP(bf16, ws_wout) + (size_t)(16 * nt) * 1024, 1024, 1024, c.lane);
        v2u pk; pk.x = pk2(a[0], a[1]); pk.y = pk2(a[2], a[3]);
        *(v2u*)(WSP(bf16, WS_YO) + (size_t)(NLAT + 16 * mt + (c.lane & 15)) * 1024 + 16 * nt + 4 * (c.lane >> 4)) = pk; }
}
__device__ __forceinline__ void ph_inproj_odd_tiles(const Ctx& c) {
    const bf16* H = WSP(bf16, WS_H); const bf16* W = WSP(bf16, WS_WINO);
    for (int t = c.gw; t < 2048 + 32 * 48 + 64; t += c.ngw) {
        if (t < 2048) { const int mt = t >> 1, nt = t & 1;
            const f32x4 a = wave_tile16(H + (size_t)(16 * mt) * 1024, 1024, W + (size_t)(2048 + 16 * nt) * 1024, 1024, 1024, c.lane);
            *(f32x4*)(WSP(float, WS_LR) + (size_t)(16 * mt + (c.lane & 15)) * 32 + 16 * nt + 4 * (c.lane >> 4)) = a; }
        else if (t < 2048 + 32 * 48) { const int u = t - 2048, mt = u / 48, nt = u % 48;
            const f32x4 a = wave_tile16(H + (size_t)(NLAT + 16 * mt) * 1024, 1024, W + (size_t)(768 + 16 * nt) * 1024, 1024, 1024, c.lane);
            v2u pk; pk.x = pk2(a[0], a[1]); pk.y = pk2(a[2], a[3]);
            *(v2u*)(WSP(bf16, WS_PBUF) + (size_t)(NLAT + 16 * mt + (c.lane & 15)) * 2048 + 768 + 16 * nt + 4 * (c.lane >> 4)) = pk; }
        else { const int u = t - 2048 - 32 * 48, mt = u >> 1, nt = u & 1;
            const f32x4 a = wave_tile16(H + (size_t)(NLAT + 16 * mt) * 1024, 1024, W + (size_t)(2048 + 16 * nt) * 1024, 1024, 1024, c.lane);
            *(f32x4*)(WSP(float, WS_LR) + (size_t)(NLAT + 16 * mt + (c.lane & 15)) * 32 + 16 * nt + 4 * (c.lane >> 4)) = a; }
    }
}
__device__ __forceinline__ void ph_pool_tiles(const Ctx& c) {
    for (int t = c.gw; t < 1024 * 32; t += c.ngw) { const int mt = t >> 5, g = (t >> 3) & 3, et = t & 7;
        const f32x4 a = wave_tile16(WSP(bf16, WS_DPOOL) + (size_t)(16 * mt) * 512 + g * 128, 512, WSP(bf16, WS_POOLW) + (size_t)g * 128 * 128 + (size_t)(16 * et) * 128, 128, 128, c.lane);
        const int col = g * 128 + 16 * et + 4 * (c.lane >> 4); const float* sc = c.a->in[I_POOLS] + col;
        v2u pk; pk.x = pk2(a[0] * sc[0], a[1] * sc[1]); pk.y = pk2(a[2] * sc[2], a[3] * sc[3]);
        *(v2u*)(WSP(bf16, WS_MIX) + (size_t)(16 * mt + (c.lane & 15)) * 1024 + col) = pk; }
}

__device__ __forceinline__ void ph_post(const Ctx& c, int layer, int nrows) {
    LAS float* rw = (LAS float*)c.lds;
    { const float* R = c.a->in[I_ROUTER] + (size_t)layer * 1024 * 16;
      for (int i = c.tid; i < 1024 * 16; i += 512) { const int k = i >> 4, e = i & 15, rho = (k & 3) * 256 + ((k >> 8) & 3) * 64 + ((k >> 2) & 63); rw[rho * 16 + 4 * ((e >> 2) ^ ((rho >> 2) & 3)) + (e & 3)] = R[i]; } }
    __syncthreads();
    const f32x4* ng4 = (const f32x4*)(c.a->in[I_NORMG] + (size_t)layer * 4 * 1024);
    const int per = (nrows + c.ngw - 1) / c.ngw, m0 = c.gw * per, m1 = min(m0 + per, nrows);
    const unsigned ln = (unsigned)c.lane;
    if (m0 < m1) {
        int scur = -1;
        f32x4 G1[4], G2[4], M2[4], M3[4], M4[4], xin[4]; v2u yy[4];
#define POST_LOADROW(M) do { const f32x4* xr_ = (const f32x4*)(layer == 0 ? ((M) < NLAT ? c.a->in[I_X] + (size_t)(M) * 1024 : c.a->in[I_CTX] + (size_t)((M) - NLAT) * 1024) : WSP(float, WS_X1) + (size_t)(M) * 1024); \
            const v2u* yr_ = (const v2u*)(WSP(bf16, WS_YO) + (size_t)(M) * 1024); _Pragma("unroll") for (int j = 0; j < 4; ++j) { xin[j] = __builtin_nontemporal_load(xr_ + ln + 64u * j); yy[j] = __builtin_nontemporal_load(yr_ + ln + 64u * j); } } while (0)
        POST_LOADROW(m0);
        for (int m = m0; m < m1; ++m) {
            const int s = m < NLAT ? m / SEQ : 2;
            if (s != scur) { scur = s; const f32x4* mod4 = (const f32x4*)(WSP(float, WS_MOD) + (size_t)(layer * 3 + s) * 6144);
                const f32x4* m2p = mod4 + 512; const f32x4* m3p = mod4 + 768; const f32x4* m4p = mod4 + 1024; const f32x4* g1p = ng4 + 256; const f32x4* g2p = ng4 + 512;
#pragma unroll
                for (int j = 0; j < 4; ++j) { const unsigned idx = ln + 64u * j; G1[j] = g1p[idx]; G2[j] = g2p[idx]; M2[j] = m2p[idx]; M3[j] = m3p[idx]; M4[j] = m4p[idx] + 1.0f; } }
            f32x4 x[4], xi[4]; float ss = 0.f;
#pragma unroll
            for (int j = 0; j < 4; ++j) { x[j] = (f32x4){bflo(yy[j].x), bfhi(yy[j].x), bflo(yy[j].y), bfhi(yy[j].y)}; xi[j] = xin[j]; ss += (x[j][0] * x[j][0] + x[j][1] * x[j][1]) + (x[j][2] * x[j][2] + x[j][3] * x[j][3]); }
            if (m + 1 < m1) POST_LOADROW(m + 1);
            const float ry = 1.0f / sqrtf(wave_sum(ss) * (1.0f / 1024.0f) + EPS);
            float s1 = 0.f;
            f32x4* x1r = (f32x4*)(WSP(float, WS_X1) + (size_t)m * 1024);
#pragma unroll
            for (int j = 0; j < 4; ++j) { x[j] = xi[j] + M2[j] * (x[j] * ry * G1[j]); s1 += (x[j][0] * x[j][0] + x[j][1] * x[j][1]) + (x[j][2] * x[j][2] + x[j][3] * x[j][3]); x1r[ln + 64u * j] = x[j]; }
            const float r1 = 1.0f / sqrtf(wave_sum(s1) * (1.0f / 1024.0f) + EPS);
            unsigned* xo = (unsigned*)(WSP(unsigned char, WS_XN2) + (size_t)m * 1024);
#pragma unroll
            for (int j = 0; j < 4; ++j) { x[j] = x[j] * r1 * G2[j] * M4[j] + M3[j];
                xo[ln + 64u * j] = pg8::pk4_fp8(pg8::clamp448(x[j][0] * SC_X), pg8::clamp448(x[j][1] * SC_X), pg8::clamp448(x[j][2] * SC_X), pg8::clamp448(x[j][3] * SC_X)); }
            float lg[16];
#pragma unroll
            for (int e = 0; e < 16; ++e) lg[e] = 0.f;
#pragma unroll
            for (int j = 0; j < 4; ++j)
#pragma unroll
                for (int t = 0; t < 4; ++t) { const float xn = x[j][t];
                    const LAS float* wr = rw + (t * 256 + 64 * j) * 16 + c.lane * 16; const int sw = (c.lane >> 2) & 3;
                    const f32x4 w0 = *(const LAS f32x4*)(wr + 4 * (0 ^ sw)), w1 = *(const LAS f32x4*)(wr + 4 * (1 ^ sw)), w2 = *(const LAS f32x4*)(wr + 4 * (2 ^ sw)), w3 = *(const LAS f32x4*)(wr + 4 * (3 ^ sw));
#pragma unroll
                    for (int u = 0; u < 4; ++u) { lg[u] += xn * w0[u]; lg[4 + u] += xn * w1[u]; lg[8 + u] += xn * w2[u]; lg[12 + u] += xn * w3[u]; }
                    asm volatile("" ::: "memory"); }
            float a8[8], a4[4], a2[2], a1;
            { const bool hi = (c.lane & 1) != 0;
#pragma unroll
              for (int i = 0; i < 8; ++i) { const float snd = hi ? lg[i] : lg[8 + i]; const float rcv = lane_xor1(snd); a8[i] = (hi ? lg[8 + i] : lg[i]) + rcv; } }
            { const bool hi = (c.lane & 2) != 0;
#pragma unroll
              for (int i = 0; i < 4; ++i) { const float snd = hi ? a8[i] : a8[4 + i]; const float rcv = lane_xor2(snd); a4[i] = (hi ? a8[4 + i] : a8[i]) + rcv; } }
            { const bool hi = (c.lane & 4) != 0;
#pragma unroll
              for (int i = 0; i < 2; ++i) { const float snd = hi ? a4[i] : a4[2 + i]; const float rcv = lane_xor4(snd); a2[i] = (hi ? a4[2 + i] : a4[i]) + rcv; } }
            { const bool hi = (c.lane & 8) != 0; const float snd = hi ? a2[0] : a2[1]; const float rcv = lane_xor8(snd); a1 = (hi ? a2[1] : a2[0]) + rcv; }
            a1 = xor16_sum(a1); a1 = xor32_sum(a1);
            float mx = a1;
            mx = fmaxf(mx, lane_xor1(mx)); mx = fmaxf(mx, lane_xor2(mx)); mx = fmaxf(mx, lane_xor4(mx)); mx = fmaxf(mx, lane_xor8(mx));
            const float ex = expf(a1 - mx); float den = ex;
            den = row16_sum(den);
            const int eidx = ((c.lane & 1) << 3) | ((c.lane & 2) << 1) | ((c.lane & 4) >> 1) | ((c.lane & 8) >> 3);
            if (c.lane < 16) WSP(float, WS_AFF)[(size_t)m * 16 + eidx] = ex / den;
        }
#undef POST_LOADROW
    }
    __syncthreads();
}

__device__ __forceinline__ void ph_topk_gather(const Ctx& c, int nlat_tasks, int nctx_lists) {
    LAS unsigned* keys = (LAS unsigned*)c.lds;
    LAS int* hist = (LAS int*)(c.lds + 32768);
    LAS int* cg = (LAS int*)(c.lds + 32768 + 1024);
    LAS int* ce = cg + 512;
    LAS unsigned* ctl = (LAS unsigned*)(ce + 512);
    LAS int* slot_tok = (LAS int*)(c.lds + 40960);
    const float* aff = WSP(float, WS_AFF); int* inv = WSP(int, WS_INV); int* rowtok = WSP(int, WS_ROWTOK);
    for (int task = blockIdx.x; task < nlat_tasks + nctx_lists; task += c.G) {
        int n, cap, tok0, rowbase, e, part, nparts;
        if (task < nlat_tasks) { const int lid = task >> 3; part = task & 7; nparts = 8; const int b = lid >> 4; e = lid & 15; n = SEQ; cap = 1024; tok0 = b * SEQ; rowbase = e * 2048 + b * 1024; }
        else { const int lid = task - nlat_tasks; part = 0; nparts = 1; const int b = lid >> 4; e = lid & 15; n = CTXL; cap = 32; tok0 = NLAT + b * CTXL; rowbase = MOE_LAT + e * 256 + b * 32; }
        const int cpt = n / 512 > 0 ? n / 512 : 1;
        for (int i = c.tid; i < n; i += 512) keys[i] = __builtin_bit_cast(unsigned, aff[(size_t)(tok0 + i) * 16 + e]);
        if (n <= 512) {
            __syncthreads();
            if (c.tid < n) { const unsigned key = keys[c.tid]; int rank = 0;
                for (int j = 0; j < n; ++j) { const unsigned kj = keys[j]; rank += (kj > key || (kj == key && j < c.tid)) ? 1 : 0; }
                const int slot = rank < cap ? rank : -1;
                if (slot >= 0) slot_tok[slot] = tok0 + c.tid;
                inv[(size_t)(tok0 + c.tid) * 16 + e] = slot >= 0 ? rowbase + slot : -1; if (slot >= 0) rowtok[rowbase + slot] = tok0 + c.tid; }
        } else {
        if (c.tid == 0) { ctl[0] = 0u; ctl[1] = (unsigned)cap; }
        __syncthreads();
        for (int pass = 0; pass < 4; ++pass) {
            const int shift = 24 - 8 * pass;
            if (c.tid < 256) hist[c.tid] = 0;
            __syncthreads();
            const unsigned prefix = ctl[0];
            for (int i = c.tid; i < n; i += 512) { const unsigned k = keys[i]; if (pass == 0 || (k >> (shift + 8)) == prefix) __hip_atomic_fetch_add(&hist[(k >> shift) & 255u], 1, __ATOMIC_RELAXED, __HIP_MEMORY_SCOPE_WORKGROUP); }
            __syncthreads();
            if (c.wave == 0) {
                const int kth = (int)ctl[1];
                const int h0 = hist[4 * c.lane], h1 = hist[4 * c.lane + 1], h2 = hist[4 * c.lane + 2], h3 = hist[4 * c.lane + 3];
                const int mine = h0 + h1 + h2 + h3;
                int suf = mine;
#pragma unroll
                for (int o = 1; o < 64; o <<= 1) { const int t = __shfl_down(suf, o); if (c.lane + o < 64) suf += t; }
                const int above = suf - mine;
                if (above < kth && suf >= kth) {
                    int cum = above, sel, rem;
                    if (cum + h3 >= kth) { sel = 3; rem = kth - cum; } else { cum += h3;
                    if (cum + h2 >= kth) { sel = 2; rem = kth - cum; } else { cum += h2;
                    if (cum + h1 >= kth) { sel = 1; rem = kth - cum; } else { cum += h1; sel = 0; rem = kth - cum; } } }
                    ctl[0] = (prefix << 8) | (unsigned)(4 * c.lane + sel); ctl[1] = (unsigned)rem; }
            }
            __syncthreads();
        }
        const unsigned T = ctl[0]; const int need_eq = (int)ctl[1]; const int ngt = cap - need_eq;
        { int g = 0, q = 0;
          for (int j = 0; j < cpt; ++j) { const int i = c.tid * cpt + j; if (i < n) { const unsigned k = keys[i]; g += (k > T); q += (k == T); } }
          cg[c.tid] = g; ce[c.tid] = q; }
        __syncthreads();
        if (c.wave == 0) {
            int g[8], q[8], sg = 0, sq = 0;
#pragma unroll
            for (int j = 0; j < 8; ++j) { g[j] = cg[c.lane * 8 + j]; q[j] = ce[c.lane * 8 + j]; sg += g[j]; sq += q[j]; }
            int ig = sg, iq = sq;
#pragma unroll
            for (int o = 1; o < 64; o <<= 1) { const int tg = __shfl_up(ig, o), tq = __shfl_up(iq, o); if (c.lane >= o) { ig += tg; iq += tq; } }
            int eg = ig - sg, eq = iq - sq;
#pragma unroll
            for (int j = 0; j < 8; ++j) { cg[c.lane * 8 + j] = eg; ce[c.lane * 8 + j] = eq; eg += g[j]; eq += q[j]; }
        }
        __syncthreads();
        { int g = cg[c.tid], q = ce[c.tid];
          for (int j = 0; j < cpt; ++j) { const int i = c.tid * cpt + j; if (i < n) { const unsigned k = keys[i]; int slot = -1;
              if (k > T) { slot = g; ++g; } else if (k == T) { if (q < need_eq) slot = ngt + q; ++q; }
              if (slot >= 0) slot_tok[slot] = tok0 + i;
              if ((i * nparts) / n == part) { inv[(size_t)(tok0 + i) * 16 + e] = slot >= 0 ? rowbase + slot : -1; if (slot >= 0) rowtok[rowbase + slot] = tok0 + i; } } } }
        }
        __syncthreads();
        { const int per = cap / nparts, s0 = part * per;
          for (int base = s0 + c.wave; base < s0 + per; base += NWAVES * 8) { v4u vals[8]; int sls[8];
#pragma unroll
              for (int u = 0; u < 8; ++u) { const int sl = base + NWAVES * u; sls[u] = sl; if (sl < s0 + per) { const int tok = slot_tok[sl]; vals[u] = ((const v4u*)(WSP(unsigned char, WS_XN2) + (size_t)tok * 1024))[c.lane]; } }
#pragma unroll
              for (int u = 0; u < 8; ++u) if (sls[u] < s0 + per) ((v4u*)(WSP(unsigned char, WS_XG) + (size_t)(rowbase + sls[u]) * 1024))[c.lane] = vals[u]; } }
        if (task >= nlat_tasks && task < nlat_tasks + 16) {
            for (int i = 64 + c.wave; i < 256; i += NWAVES) { ((v4u*)(WSP(unsigned char, WS_XG) + (size_t)(MOE_LAT + e * 256 + i) * 1024))[c.lane] = (v4u){0u, 0u, 0u, 0u}; if (c.lane == 0) rowtok[MOE_LAT + e * 256 + i] = -1; } }
        __syncthreads();
    }
}

__device__ __forceinline__ void ph_combine(const Ctx& c, int layer, int nrows) {
    const float* ng = c.a->in[I_NORMG] + (size_t)layer * 4 * 1024;
    const int per = (nrows + c.ngw - 1) / c.ngw, m0 = c.gw * per, m1 = min(m0 + per, nrows);
    const unsigned ln = (unsigned)c.lane;
    if (m0 < m1) {
        int scur = -1;
        f32x4 G3[2][2], M5[2][2], GN[2][2], MS[2][2], MH[2][2];
        int inv_n; float aff_n; f32x4 x1n[2][2];
#define CMB_LOADROW(M) do { inv_n = ln < 16u ? WSP(int, WS_INV)[(size_t)(M) * 16 + ln] : -1; aff_n = ln < 16u ? WSP(float, WS_AFF)[(size_t)(M) * 16 + ln] : 0.f; \
            const f32x4* xr_ = (const f32x4*)(WSP(float, WS_X1) + (size_t)(M) * 1024); _Pragma("unroll") for (int j = 0; j < 2; ++j) { x1n[j][0] = xr_[2u * ln + 128u * j]; x1n[j][1] = xr_[2u * ln + 128u * j + 1u]; } } while (0)
        CMB_LOADROW(m0);
        for (int m = m0; m < m1; ++m) {
            const int s = m < NLAT ? m / SEQ : 2;
            if (s != scur) { scur = s; const f32x4* mod4 = (const f32x4*)(WSP(float, WS_MOD) + (size_t)(layer * 3 + s) * 6144); const f32x4* g34 = (const f32x4*)(ng + 3 * 1024);
                const f32x4* gn4 = (const f32x4*)(c.a->in[I_NORMG] + (size_t)4 * 1024); const f32x4* mn4 = (const f32x4*)(WSP(float, WS_MOD) + (size_t)(3 + s) * 6144);
#pragma unroll
                for (int j = 0; j < 2; ++j)
#pragma unroll
                    for (int hh = 0; hh < 2; ++hh) { const unsigned idx = 2u * ln + 128u * j + hh; G3[j][hh] = g34[idx]; M5[j][hh] = (mod4 + 1280)[idx];
                        if (layer == 0) { GN[j][hh] = gn4[idx]; MS[j][hh] = (mn4 + 256)[idx] + 1.0f; MH[j][hh] = mn4[idx]; } } }
            const int myinv = inv_n; const float myaff = aff_n; f32x4 x1c[2][2];
#pragma unroll
            for (int j = 0; j < 2; ++j) { x1c[j][0] = x1n[j][0]; x1c[j][1] = x1n[j][1]; }
            if (m + 1 < m1) CMB_LOADROW(m + 1);
            float f[16];
#pragma unroll
            for (int i = 0; i < 16; ++i) f[i] = 0.f;
            unsigned long long mask = __ballot(myinv >= 0);
            while (mask) {
                int rows[4]; float as[4]; v4u v[4][2];
#pragma unroll
                for (int u = 0; u < 4; ++u) { rows[u] = -1; as[u] = 0.f;
                    if (mask) { const int e = __builtin_ctzll(mask); mask &= mask - 1; rows[u] = __shfl(myinv, e); as[u] = __shfl(myaff, e); } }
#pragma unroll
                for (int u = 0; u < 4; ++u) if (rows[u] >= 0) { const v4u* src = (const v4u*)(WSP(bf16, WS_Y) + (size_t)rows[u] * 1024); v[u][0] = __builtin_nontemporal_load(src + ln); v[u][1] = __builtin_nontemporal_load(src + ln + 64u); }
#pragma unroll
                for (int u = 0; u < 4; ++u) if (rows[u] >= 0) { const float a = as[u];
#pragma unroll
                    for (int j = 0; j < 2; ++j) { const v4u w = v[u][j];
                        f[8 * j + 0] += a * bflo(w.x); f[8 * j + 1] += a * bfhi(w.x); f[8 * j + 2] += a * bflo(w.y); f[8 * j + 3] += a * bfhi(w.y);
                        f[8 * j + 4] += a * bflo(w.z); f[8 * j + 5] += a * bfhi(w.z); f[8 * j + 6] += a * bflo(w.w); f[8 * j + 7] += a * bfhi(w.w); } }
            }
            float ss = 0.f;
#pragma unroll
            for (int i = 0; i < 16; ++i) ss += f[i] * f[i];
            const float rf = 1.0f / sqrtf(wave_sum(ss) * (1.0f / 1024.0f) + EPS);
            f32x4 x[2][2]; float s2 = 0.f;
#pragma unroll
            for (int j = 0; j < 2; ++j)
#pragma unroll
                for (int hh = 0; hh < 2; ++hh) { const f32x4 fv = (f32x4){f[8 * j + 4 * hh], f[8 * j + 4 * hh + 1], f[8 * j + 4 * hh + 2], f[8 * j + 4 * hh + 3]};
                    x[j][hh] = x1c[j][hh] + M5[j][hh] * (fv * rf * G3[j][hh]); s2 += (x[j][hh][0] * x[j][hh][0] + x[j][hh][1] * x[j][hh][1]) + (x[j][hh][2] * x[j][hh][2] + x[j][hh][3] * x[j][hh][3]); }
            if (layer == 0) {
                const float r2 = 1.0f / sqrtf(wave_sum(s2) * (1.0f / 1024.0f) + EPS);
                f32x4* x1r = (f32x4*)(WSP(float, WS_X1) + (size_t)m * 1024); v4u* ho = (v4u*)(WSP(bf16, WS_H) + (size_t)m * 1024);
#pragma unroll
                for (int j = 0; j < 2; ++j) { x1r[2u * ln + 128u * j] = x[j][0]; x1r[2u * ln + 128u * j + 1u] = x[j][1];
                    const f32x4 o0 = x[j][0] * r2 * GN[j][0] * MS[j][0] + MH[j][0], o1 = x[j][1] * r2 * GN[j][1] * MS[j][1] + MH[j][1];
                    v4u pk; pk.x = pk2(o0[0], o0[1]); pk.y = pk2(o0[2], o0[3]); pk.z = pk2(o1[0], o1[1]); pk.w = pk2(o1[2], o1[3]); ho[ln + 64u * j] = pk; }
            } else {
                f32x4* orow = (f32x4*)(c.out + (size_t)m * 1024);
#pragma unroll
                for (int j = 0; j < 2; ++j) { orow[2u * ln + 128u * j] = x[j][0]; orow[2u * ln + 128u * j + 1u] = x[j][1]; }
            }
        }
#undef CMB_LOADROW
    }
}

__device__ __forceinline__ void ph_prep_odd(const Ctx& c) {
    const bf16* P = WSP(bf16, WS_PBUF);
    for (int it = blockIdx.x * 512 + c.tid; it < NLAT * 64; it += c.G * 512) {
        const int m = it >> 6, c8 = (it & 63) * 8, t = m & (SEQ - 1), b0 = m - t;
        const int win = 2 << (c8 >> 7), lo = max(t - win / 2, 0), hi = min(t + win / 2, SEQ);
        float sum[8];
#pragma unroll
        for (int j = 0; j < 8; ++j) sum[j] = 0.f;
        for (int tt = lo; tt < hi; ++tt) { const v4u a = *(const v4u*)(P + (size_t)(b0 + tt) * 2048 + c8);
            sum[0] += bflo(a.x); sum[1] += bfhi(a.x); sum[2] += bflo(a.y); sum[3] += bfhi(a.y); sum[4] += bflo(a.z); sum[5] += bfhi(a.z); sum[6] += bflo(a.w); sum[7] += bfhi(a.w); }
        const v4u a = *(const v4u*)(P + (size_t)m * 2048 + c8); const float inv = 1.0f / (float)(hi - lo);
        v4u o; o.x = pk2(sum[0] * inv - bflo(a.x), sum[1] * inv - bfhi(a.x)); o.y = pk2(sum[2] * inv - bflo(a.y), sum[3] * inv - bfhi(a.y));
        o.z = pk2(sum[4] * inv - bflo(a.z), sum[5] * inv - bfhi(a.z)); o.w = pk2(sum[6] * inv - bflo(a.w), sum[7] * inv - bfhi(a.w));
        *(v4u*)(WSP(bf16, WS_DPOOL) + (size_t)m * 512 + c8) = o;
    }
    const int hd = c.tid & 255, d = hd & 63;
    float gw0[16], gw1[16];
#pragma unroll
    for (int r = 0; r < 16; ++r) { gw0[r] = c.a->in[I_GATEW][r * 256 + hd]; gw1[r] = c.a->in[I_GATEW][(16 + r) * 256 + hd]; }
    const float gb0 = c.a->in[I_GATEB][hd], gb1 = c.a->in[I_GATEB][256 + hd];
    const float* rope = WSP(float, WS_ROPE);
    for (int m = blockIdx.x * 2 + (c.tid >> 8); m < NTOK; m += c.G * 2) {
        const float* lr = WSP(float, WS_LR) + (size_t)m * 32;
        float z0 = gb0, z1 = gb1;
#pragma unroll
        for (int r = 0; r < 16; ++r) { z0 += lr[r] * gw0[r]; z1 += lr[16 + r] * gw1[r]; }
        const float l0 = fminf(z0, 0.f) - log1pf(expf(-fabsf(z0))), l1 = fminf(z1, 0.f) - log1pf(expf(-fabsf(z1)));
        WSP(float, WS_GF)[(size_t)m * 256 + hd] = l0 * (1.0f / 16.0f); WSP(float, WS_GB)[(size_t)m * 256 + hd] = l1 * (1.0f / 16.0f);
        const bf16* pr = P + (size_t)m * 2048;
        if (m < NLAT) {
            const int t = m & (SEQ - 1), pos = (d & 32) ? 128 + (t & 63) : (t >> 6), f = d & 15;
            const float cs = rope[(pos * 16 + f) * 2], sn = rope[(pos * 16 + f) * 2 + 1];
            const int d1 = hd & ~16, d2 = hd | 16;
            const float q1 = bf2f(pr[512 + d1]), q2 = bf2f(pr[512 + d2]), k1 = bf2f(pr[768 + d1]), k2 = bf2f(pr[768 + d2]);
            const bool second = (d & 16) != 0;
            WSP(float, WS_QR)[(size_t)m * 256 + hd] = (second ? q1 * sn + q2 * cs : q1 * cs - q2 * sn) * 0.125f;
            WSP(float, WS_KR)[(size_t)m * 256 + hd] = second ? k1 * sn + k2 * cs : k1 * cs - k2 * sn;
        } else WSP(float, WS_KR)[(size_t)m * 256 + hd] = bf2f(pr[768 + hd]);
    }
}

__device__ __forceinline__ void ph_gla_naive(const Ctx& c) {
    const bf16* P = WSP(bf16, WS_PBUF);
    for (int item = blockIdx.x; item < 256; item += c.G) {
        const int es = item & 15, dir = (item >> 4) & 1, h = (item >> 5) & 3, b = item >> 7;
        const int e = es * 8 + c.wave, d = c.lane;
        const float* G = dir ? WSP(float, WS_GB) : WSP(float, WS_GF);
        float* O = WSP(float, WS_OACC) + (size_t)dir * NLAT * 512;
        float S = 0.f;
        for (int blk = 0; blk < (CTXL + SEQ) / 8; ++blk) {
            float gg[8], kk[8], vv[8], qq[8]; int mm[8];
#pragma unroll
            for (int j = 0; j < 8; ++j) { const int step = blk * 8 + j; int m;
                if (step < CTXL) m = NLAT + b * CTXL + (dir ? CTXL - 1 - step : step); else { const int t = step - CTXL; m = b * SEQ + (dir ? SEQ - 1 - t : t); }
                mm[j] = m; gg[j] = G[(size_t)m * 256 + h * 64 + d]; kk[j] = WSP(float, WS_KR)[(size_t)m * 256 + h * 64 + d]; vv[j] = bf2f(P[(size_t)m * 2048 + 1024 + h * 128 + e]);
                qq[j] = m < NLAT ? WSP(float, WS_QR)[(size_t)m * 256 + h * 64 + d] : 0.f; }
#pragma unroll
            for (int j = 0; j < 8; ++j) { S = expf(gg[j]) * S + kk[j] * vv[j];
                if (blk >= CTXL / 8) { const float o = wave_sum(qq[j] * S); if (c.lane == 0) O[(size_t)mm[j] * 512 + h * 128 + e] = o; } }
        }
    }
}
__device__ __forceinline__ void ph_gla_out(const Ctx& c) {
    for (int m = c.gw; m < NLAT; m += c.ngw) {
        const float* o0 = WSP(float, WS_OACC) + (size_t)m * 512 + 8 * c.lane; const float* o1 = o0 + (size_t)NLAT * 512;
        float o[8]; float ss = 0.f;
#pragma unroll
        for (int j = 0; j < 8; ++j) { o[j] = o0[j] + o1[j]; ss += o[j] * o[j]; }
        ss = row16_sum(ss);
        const float rn = 1.0f / sqrtf(ss * (1.0f / 128.0f) + EPS);
        const v4u rr = *(const v4u*)(WSP(bf16, WS_PBUF) + (size_t)m * 2048 + 1536 + 8 * c.lane);
        const float r[8] = {bflo(rr.x), bfhi(rr.x), bflo(rr.y), bfhi(rr.y), bflo(rr.z), bfhi(rr.z), bflo(rr.w), bfhi(rr.w)};
        float v[8];
#pragma unroll
        for (int j = 0; j < 8; ++j) v[j] = o[j] * rn * c.a->in[I_HEADG][8 * c.lane + j] * silu(r[j]);
        v4u pk; pk.x = pk2(v[0], v[1]); pk.y = pk2(v[2], v[3]); pk.z = pk2(v[4], v[5]); pk.w = pk2(v[6], v[7]);
        *(v4u*)(WSP(bf16, WS_MIX) + (size_t)m * 1024 + 512 + 8 * c.lane) = pk;
    }
}

constexpr int GP = 72, GVP = 136;
typedef short s16x4_t __attribute__((ext_vector_type(4)));
constexpr int GP_unused = 0;
__device__ __forceinline__ bf16x8 mk8(v2u lo, v2u hi) { v4u t; t.x = lo.x; t.y = lo.y; t.z = hi.x; t.w = hi.y; return __builtin_bit_cast(bf16x8, t); }

__device__ __forceinline__ float logsig16(float z) { return (fminf(z, 0.f) - __logf(1.0f + __expf(-fabsf(z)))) * (1.0f / 16.0f); }
__device__ __forceinline__ void ph_gla_g1(const Ctx& c) {
    LAS bf16* keT = (LAS bf16*)c.lds;
    LAS bf16* vL = keT + 2 * 64 * GP;
    LAS float* tot = (LAS float*)(vL + 64 * GVP);
    LAS float* lrL = tot + 2 * 8 * 64;
    LAS bf16* kL = (LAS bf16*)(lrL + 64 * 32);
    LAS bf16* qL = kL + 64 * 64;
    LAS bf16* qkL = qL + 64 * 64;
    const bf16* P = WSP(bf16, WS_PBUF);
    const float* rope = WSP(float, WS_ROPE);
    const int d = c.tid & 63, tg = c.tid >> 6, q = c.lane >> 4, l15 = c.lane & 15;
    const int d1 = d & ~16, d2 = d | 16, fi = d & 15; const bool second = (d & 16) != 0, colhalf = (d & 32) != 0;
    for (int item = blockIdx.x; item < 2 * 4 * 132; item += c.G) {
        const int cidx = item % 132, h = (item / 132) & 3, b = item / (132 * 4);
        const bool lat = cidx >= 4;
        const int m0 = lat ? b * SEQ + 64 * (cidx - 4) : NLAT + b * CTXL + 64 * cidx;
        { const f32x4* src = (const f32x4*)(WSP(float, WS_LR) + (size_t)m0 * 32); ((LAS f32x4*)lrL)[c.tid] = src[c.tid];
          const int row = c.tid >> 3, ch = c.tid & 7; const bf16* pr = P + (size_t)(m0 + row) * 2048 + h * 64 + 8 * ch;
          *(LAS v4u*)(kL + row * 64 + 8 * ch) = *(const v4u*)(pr + 768); if (lat) *(LAS v4u*)(qL + row * 64 + 8 * ch) = *(const v4u*)(pr + 512);
#pragma unroll
          for (int r2 = 0; r2 < 2; ++r2) { const int id = c.tid + 512 * r2, vr = id >> 4, vc = id & 15; *(LAS v4u*)(vL + vr * GVP + 8 * vc) = *(const v4u*)(P + (size_t)(m0 + vr) * 2048 + 1024 + h * 128 + 8 * vc); } }
        float gw0[16], gw1[16];
#pragma unroll
        for (int r = 0; r < 16; ++r) { gw0[r] = c.a->in[I_GATEW][r * 256 + h * 64 + d]; gw1[r] = c.a->in[I_GATEW][(16 + r) * 256 + h * 64 + d]; }
        const float gb0 = c.a->in[I_GATEB][h * 64 + d], gb1 = c.a->in[I_GATEB][256 + h * 64 + d];
        float csr = 1.f, snr = 0.f; if (lat && !colhalf) { csr = rope[((cidx - 4) * 16 + fi) * 2]; snr = rope[((cidx - 4) * 16 + fi) * 2 + 1]; }
        __syncthreads();
        float pf[8], pb[8];
#pragma unroll
        for (int j = 0; j < 8; ++j) { const LAS float* lr = lrL + (8 * tg + j) * 32; float z0 = gb0, z1 = gb1;
#pragma unroll
            for (int r = 0; r < 16; ++r) { z0 += lr[r] * gw0[r]; z1 += lr[16 + r] * gw1[r]; }
            pf[j] = logsig16(z0); pb[j] = logsig16(z1); }
#pragma unroll
        for (int j = 1; j < 8; ++j) pf[j] += pf[j - 1];
#pragma unroll
        for (int j = 6; j >= 0; --j) pb[j] += pb[j + 1];
        tot[(0 * 8 + tg) * 64 + d] = pf[7]; tot[(1 * 8 + tg) * 64 + d] = pb[0];
        __syncthreads();
        float offf = 0.f, offb = 0.f, Bf = 0.f, Bb = 0.f;
#pragma unroll
        for (int g = 0; g < 8; ++g) { const float tf = tot[g * 64 + d], tb = tot[(8 + g) * 64 + d]; Bf += tf; Bb += tb; offf += g < tg ? tf : 0.f; offb += g > tg ? tb : 0.f; }
        float kef[8], keb[8];
#pragma unroll
        for (int j = 0; j < 8; ++j) { const int tj = 8 * tg + j; const float bfj = offf + pf[j], bbj = offb + pb[j];
            float kv, qv = 0.f;
            if (lat) { float cs = csr, sn = snr; if (colhalf) { cs = rope[((128 + tj) * 16 + fi) * 2]; sn = rope[((128 + tj) * 16 + fi) * 2 + 1]; }
                const float k1 = bf2f(kL[tj * 64 + d1]), k2 = bf2f(kL[tj * 64 + d2]), q1 = bf2f(qL[tj * 64 + d1]), q2 = bf2f(qL[tj * 64 + d2]);
                kv = second ? k1 * sn + k2 * cs : k1 * cs - k2 * sn; qv = (second ? q1 * sn + q2 * cs : q1 * cs - q2 * sn) * 0.125f; }
            else kv = bf2f(kL[tj * 64 + d]);
            kef[j] = kv * __expf(Bf - bfj); keb[j] = kv * __expf(Bb - bbj);
            if (lat) { qkL[(0 * 64 + tj) * 64 + d] = (bf16)f2bf(qv * __expf(bfj)); qkL[(1 * 64 + tj) * 64 + d] = (bf16)f2bf(kv * __expf(-bfj));
                qkL[(2 * 64 + tj) * 64 + d] = (bf16)f2bf(qv * __expf(bbj)); qkL[(3 * 64 + tj) * 64 + d] = (bf16)f2bf(kv * __expf(-bbj)); } }
        { v4u w; w.x = pk2(kef[0], kef[1]); w.y = pk2(kef[2], kef[3]); w.z = pk2(kef[4], kef[5]); w.w = pk2(kef[6], kef[7]); *(LAS v4u*)(keT + (size_t)d * GP + 8 * tg) = w;
          w.x = pk2(keb[0], keb[1]); w.y = pk2(keb[2], keb[3]); w.z = pk2(keb[4], keb[5]); w.w = pk2(keb[6], keb[7]); *(LAS v4u*)(keT + (size_t)(64 + d) * GP + 8 * tg) = w; }
        if (tg == 0) { float* DCp = WSP(float, WS_DC);
            DCp[((size_t)(0 * 8 + b * 4 + h) * 132 + cidx) * 64 + d] = __expf(Bf); DCp[((size_t)(1 * 8 + b * 4 + h) * 132 + cidx) * 64 + d] = __expf(Bb); }
        __syncthreads();
        if (lat) {
#pragma unroll
            for (int r2 = 0; r2 < 4; ++r2) { const int id = c.tid + 512 * r2, arr = id >> 9, row = (id >> 3) & 63, ch = id & 7;
                bf16* dst = ((arr & 1) ? WSP(bf16, WS_KD) : WSP(bf16, WS_QE)) + (size_t)(arr >> 1) * NLAT * 256 + (size_t)(m0 + row) * 256 + h * 64 + 8 * ch;
                *(v4u*)dst = *(const LAS v4u*)(qkL + (arr * 64 + row) * 64 + 8 * ch); } }
        { const LAS bf16* vb = vL + (size_t)(8 * q + (l15 >> 2)) * GVP + 16 * c.wave + 4 * (l15 & 3);
          const bf16x8 av0 = mk8(__builtin_bit_cast(v2u, __builtin_amdgcn_ds_read_tr16_b64_v4i16((LAS s16x4_t*)vb)), __builtin_bit_cast(v2u, __builtin_amdgcn_ds_read_tr16_b64_v4i16((LAS s16x4_t*)(vb + 4 * GVP))));
          const bf16x8 av1 = mk8(__builtin_bit_cast(v2u, __builtin_amdgcn_ds_read_tr16_b64_v4i16((LAS s16x4_t*)(vb + 32 * GVP))), __builtin_bit_cast(v2u, __builtin_amdgcn_ds_read_tr16_b64_v4i16((LAS s16x4_t*)(vb + 36 * GVP))));
#pragma unroll
          for (int dir = 0; dir < 2; ++dir)
#pragma unroll
            for (int dt = 0; dt < 4; ++dt) {
                const bf16x8 b0 = *(const LAS bf16x8*)(keT + (size_t)(dir * 64 + 16 * dt + l15) * GP + 8 * q), b1 = *(const LAS bf16x8*)(keT + (size_t)(dir * 64 + 16 * dt + l15) * GP + 32 + 8 * q);
                f32x4 acc = {0.f, 0.f, 0.f, 0.f};
                acc = __builtin_amdgcn_mfma_f32_16x16x32_bf16(av0, b0, acc, 0, 0, 0); acc = __builtin_amdgcn_mfma_f32_16x16x32_bf16(av1, b1, acc, 0, 0, 0);
                float* U = WSP(float, WS_UT) + ((size_t)(dir * 8 + b * 4 + h) * 132 + cidx) * 8192 + (size_t)(16 * c.wave + 4 * q) * 64 + 16 * dt + l15;
#pragma unroll
                for (int r = 0; r < 4; ++r) U[r * 64] = acc[r]; } }
        __syncthreads();
    }
}

constexpr int PP = 520;
__device__ __forceinline__ void ph_pool(const Ctx& c) {
    LAS bf16* uL = (LAS bf16*)c.lds;
    const bf16* P = WSP(bf16, WS_PBUF);
    const int q = c.lane >> 4, l15 = c.lane & 15;
    for (int item = blockIdx.x; item < NLAT / 64; item += c.G) {
        const int mbase = item * 64, tb = mbase & (SEQ - 1);
        for (int i = c.tid; i < 80 * 64; i += 512) { const int r = i >> 6, c8 = (i & 63) * 8, t = tb - 8 + r;
            v4u a = {0u, 0u, 0u, 0u}; if (t >= 0 && t < SEQ) a = *(const v4u*)(P + (size_t)(mbase - 8 + r) * 2048 + c8);
            *(LAS v4u*)(uL + r * PP + c8) = a; }
        __syncthreads();
        v4u dv[8];
#pragma unroll
        for (int i = 0; i < 8; ++i) { const int id = c.tid + 512 * i, tt = id >> 6, c8 = (id & 63) * 8, t = tb + tt;
            const int hw = 1 << (c8 >> 7), lo = max(t - hw, 0), hi = min(t + hw, SEQ);
            float sum[8];
#pragma unroll
            for (int j = 0; j < 8; ++j) sum[j] = 0.f;
            for (int u = -hw; u < hw; ++u) { const v4u a = *(const LAS v4u*)(uL + (tt + 8 + u) * PP + c8);
                sum[0] += bflo(a.x); sum[1] += bfhi(a.x); sum[2] += bflo(a.y); sum[3] += bfhi(a.y); sum[4] += bflo(a.z); sum[5] += bfhi(a.z); sum[6] += bflo(a.w); sum[7] += bfhi(a.w); }
            const v4u a = *(const LAS v4u*)(uL + (tt + 8) * PP + c8); const float inv = 1.0f / (float)(hi - lo);
            dv[i].x = pk2(sum[0] * inv - bflo(a.x), sum[1] * inv - bfhi(a.x)); dv[i].y = pk2(sum[2] * inv - bflo(a.y), sum[3] * inv - bfhi(a.y));
            dv[i].z = pk2(sum[4] * inv - bflo(a.z), sum[5] * inv - bfhi(a.z)); dv[i].w = pk2(sum[6] * inv - bflo(a.w), sum[7] * inv - bfhi(a.w)); }
        __syncthreads();
#pragma unroll
        for (int i = 0; i < 8; ++i) { const int id = c.tid + 512 * i, tt = id >> 6, c8 = (id & 63) * 8; *(LAS v4u*)(uL + (tt + 8) * PP + c8) = dv[i]; }
        __syncthreads();
        for (int i = 0; i < 16; ++i) { const int tl = c.wave + 8 * i, mt = tl >> 5, g = (tl >> 3) & 3, et = tl & 7;
            const LAS bf16* ap = uL + (8 + 16 * mt + l15) * PP + g * 128 + 8 * q; const bf16* bp = WSP(bf16, WS_POOLW) + (size_t)g * 128 * 128 + (size_t)(16 * et + l15) * 128 + 8 * q;
            f32x4 acc = {0.f, 0.f, 0.f, 0.f};
#pragma unroll
            for (int ks = 0; ks < 4; ++ks) acc = __builtin_amdgcn_mfma_f32_16x16x32_bf16(*(const bf16x8*)(bp + 32 * ks), *(const LAS bf16x8*)(ap + 32 * ks), acc, 0, 0, 0);
            const int col = g * 128 + 16 * et + 4 * q; const float* sc = c.a->in[I_POOLS] + col;
            v2u pk; pk.x = pk2(acc[0] * sc[0], acc[1] * sc[1]); pk.y = pk2(acc[2] * sc[2], acc[3] * sc[3]);
            *(v2u*)(WSP(bf16, WS_MIX) + (size_t)(mbase + 16 * mt + l15) * 1024 + col) = pk; }
        __syncthreads();
    }
}

__device__ __forceinline__ void ph_gla_g2(const Ctx& c) {
    for (int el = blockIdx.x * 512 + c.tid; el < 16 * 8192; el += c.G * 512) {
        const int combo = el >> 13, ed = el & 8191, d = ed & 63, dir = combo >> 3;
        const float* U = WSP(float, WS_UT) + (size_t)combo * 132 * 8192 + ed; const float* Dp = WSP(float, WS_DC) + (size_t)combo * 132 * 64 + d;
        bf16* So = WSP(bf16, WS_ST) + (size_t)combo * 128 * 8192 + ed;
        float S = 0.f;
        for (int s4 = 0; s4 < 132; s4 += 4) {
            float u[4], dd[4]; int ci[4];
#pragma unroll
            for (int j = 0; j < 4; ++j) { const int step = s4 + j; ci[j] = dir == 0 ? step : (step < 4 ? 3 - step : 135 - step); u[j] = __builtin_nontemporal_load(U + (size_t)ci[j] * 8192); dd[j] = Dp[ci[j] * 64]; }
#pragma unroll
            for (int j = 0; j < 4; ++j) { if (ci[j] >= 4) So[(size_t)(ci[j] - 4) * 8192] = (bf16)f2bf(S); S = dd[j] * S + u[j]; }
        }
    }
}

__device__ __forceinline__ void ph_gla_g3(const Ctx& c) {
    LAS bf16* qe = (LAS bf16*)c.lds;
    LAS bf16* kd = qe + 2 * 64 * GP;
    LAS bf16* vL = kd + 2 * 64 * GP;
    LAS bf16* STl = vL + 64 * GVP;
    LAS float* ssq = (LAS float*)(STl + 2 * 128 * GP);
    const bf16* P = WSP(bf16, WS_PBUF);
    const int q = c.lane >> 4, l15 = c.lane & 15, it = c.wave & 3, eh = c.wave >> 2;
    for (int item = blockIdx.x; item < 2 * 4 * 128; item += c.G) {
        const int lc = item & 127, h = (item >> 7) & 3, b = item >> 9, m0 = b * SEQ + 64 * lc;
        { const int row = c.tid >> 3, ch = c.tid & 7;
#pragma unroll
          for (int dir = 0; dir < 2; ++dir) { const size_t o = ((size_t)dir * NLAT + m0 + row) * 256 + h * 64 + 8 * ch;
              *(LAS v4u*)(qe + (size_t)(dir * 64 + row) * GP + 8 * ch) = *(const v4u*)(WSP(bf16, WS_QE) + o); *(LAS v4u*)(kd + (size_t)(dir * 64 + row) * GP + 8 * ch) = *(const v4u*)(WSP(bf16, WS_KD) + o); }
#pragma unroll
          for (int dir = 0; dir < 2; ++dir)
#pragma unroll
            for (int r = 0; r < 2; ++r) { const int id = c.tid + 512 * r, e = id >> 3, ch8 = id & 7;
                *(LAS v4u*)(STl + (size_t)(dir * 128 + e) * GP + 8 * ch8) = *(const v4u*)(WSP(bf16, WS_ST) + ((size_t)(dir * 8 + b * 4 + h) * 128 + lc) * 8192 + e * 64 + 8 * ch8); } }
#pragma unroll
        for (int r2 = 0; r2 < 2; ++r2) { const int id = c.tid + 512 * r2, vr = id >> 4, vc = id & 15; *(LAS v4u*)(vL + vr * GVP + 8 * vc) = *(const v4u*)(P + (size_t)(m0 + vr) * 2048 + 1024 + h * 128 + 8 * vc); }
        __syncthreads();
        f32x4 acc[4];
#pragma unroll
        for (int nt = 0; nt < 4; ++nt) acc[nt] = (f32x4){0.f, 0.f, 0.f, 0.f};
        const int iq = 16 * it + l15;
#pragma unroll
        for (int dir = 0; dir < 2; ++dir) {
            const bf16x8 bq0 = *(const LAS bf16x8*)(qe + (size_t)(dir * 64 + iq) * GP + 8 * q), bq1 = *(const LAS bf16x8*)(qe + (size_t)(dir * 64 + iq) * GP + 32 + 8 * q);
            f32x4 s[4];
#pragma unroll
            for (int jt = 0; jt < 4; ++jt) {
                const bf16x8 a0 = *(const LAS bf16x8*)(kd + (size_t)(dir * 64 + 16 * jt + l15) * GP + 8 * q), a1 = *(const LAS bf16x8*)(kd + (size_t)(dir * 64 + 16 * jt + l15) * GP + 32 + 8 * q);
                f32x4 t = {0.f, 0.f, 0.f, 0.f};
                t = __builtin_amdgcn_mfma_f32_16x16x32_bf16(a0, bq0, t, 0, 0, 0); t = __builtin_amdgcn_mfma_f32_16x16x32_bf16(a1, bq1, t, 0, 0, 0);
#pragma unroll
                for (int r = 0; r < 4; ++r) { const int j = 16 * jt + 4 * q + r; const bool keep = dir == 0 ? (j <= iq) : (j >= iq); t[r] = keep ? t[r] : 0.f; }
                s[jt] = t; }
            bf16x8 pbf[2];
#pragma unroll
            for (int ks = 0; ks < 2; ++ks) { v4u w; w.x = pk2(s[2 * ks][0], s[2 * ks][1]); w.y = pk2(s[2 * ks][2], s[2 * ks][3]); w.z = pk2(s[2 * ks + 1][0], s[2 * ks + 1][1]); w.w = pk2(s[2 * ks + 1][2], s[2 * ks + 1][3]);
                pbf[ks] = __builtin_bit_cast(bf16x8, w); }
#pragma unroll
            for (int nt = 0; nt < 4; ++nt) { const int er = 64 * eh + 16 * nt + l15;
                const bf16x8 s0 = *(const LAS bf16x8*)(STl + (size_t)(dir * 128 + er) * GP + 8 * q), s1 = *(const LAS bf16x8*)(STl + (size_t)(dir * 128 + er) * GP + 32 + 8 * q);
                acc[nt] = __builtin_amdgcn_mfma_f32_16x16x32_bf16(s0, bq0, acc[nt], 0, 0, 0); acc[nt] = __builtin_amdgcn_mfma_f32_16x16x32_bf16(s1, bq1, acc[nt], 0, 0, 0);
#pragma unroll
                for (int ks = 0; ks < 2; ++ks) { const LAS bf16* vb = vL + (size_t)(32 * ks + 4 * q + (l15 >> 2)) * GVP + 64 * eh + 16 * nt + 4 * (l15 & 3);
                    const v2u lo = __builtin_bit_cast(v2u, __builtin_amdgcn_ds_read_tr16_b64_v4i16((LAS s16x4_t*)vb)), hi = __builtin_bit_cast(v2u, __builtin_amdgcn_ds_read_tr16_b64_v4i16((LAS s16x4_t*)(vb + 16 * GVP)));
                    acc[nt] = __builtin_amdgcn_mfma_f32_16x16x32_bf16(mk8(lo, hi), pbf[ks], acc[nt], 0, 0, 0); } }
        }
        float ss = 0.f;
#pragma unroll
        for (int nt = 0; nt < 4; ++nt) ss += (acc[nt][0] * acc[nt][0] + acc[nt][1] * acc[nt][1]) + (acc[nt][2] * acc[nt][2] + acc[nt][3] * acc[nt][3]);
        ss = xor16_sum(ss); ss = xor32_sum(ss);
        if (q == 0) ssq[eh * 64 + iq] = ss;
        __syncthreads();
        const float rn = 1.0f / sqrtf((ssq[iq] + ssq[64 + iq]) * (1.0f / 128.0f) + EPS);
#pragma unroll
        for (int nt = 0; nt < 4; ++nt) { const int e = 64 * eh + 16 * nt + 4 * q; const size_t m = (size_t)(m0 + iq);
            const v2u rr = *(const v2u*)(P + m * 2048 + 1536 + h * 128 + e); const float* hg = c.a->in[I_HEADG] + h * 128 + e;
            v2u o; o.x = pk2(acc[nt][0] * rn * hg[0] * silu(bflo(rr.x)), acc[nt][1] * rn * hg[1] * silu(bfhi(rr.x))); o.y = pk2(acc[nt][2] * rn * hg[2] * silu(bflo(rr.y)), acc[nt][3] * rn * hg[3] * silu(bfhi(rr.y)));
            *(v2u*)(WSP(bf16, WS_MIX) + m * 1024 + 512 + h * 128 + e) = o; }
        __syncthreads();
    }
}

constexpr int NP = 72;
constexpr float LOG2E = 1.4426950408889634f;
template <int QG, bool WIN>
__device__ __forceinline__ void na_qgroup(const LAS bf16* Kt, const bf16x8 (&vf)[4][2], const LAS float* bp, const float (&cap)[3][4], const bf16x8 (&qf)[2], f32x4 (&o)[4], float& mrun, float& lrun, int q, int l15) {
    constexpr int KT_LO = WIN ? (QG <= 1 ? 0 : QG - 1) : 0, KT_HI = WIN ? (QG == 0 ? 1 : (QG == 3 ? 3 : QG + 1)) : 3;
    f32x4 s[4];
#pragma unroll
    for (int kt = 0; kt < 4; ++kt) if (kt >= KT_LO && kt <= KT_HI) {
        const bf16x8 a0 = *(const LAS bf16x8*)(Kt + (size_t)(16 * kt + l15) * NP + 8 * q), a1 = *(const LAS bf16x8*)(Kt + (size_t)(16 * kt + l15) * NP + 32 + 8 * q);
        f32x4 t = {0.f, 0.f, 0.f, 0.f};
        t = __builtin_amdgcn_mfma_f32_16x16x32_bf16(a0, qf[0], t, 0, 0, 0); t = __builtin_amdgcn_mfma_f32_16x16x32_bf16(a1, qf[1], t, 0, 0, 0);
        s[kt] = t; }
    float mx = -1e30f;
#pragma unroll
    for (int kt = 0; kt < 4; ++kt) if (kt >= KT_LO && kt <= KT_HI) {
#pragma unroll
        for (int r = 0; r < 4; ++r) { float v;
            if (WIN) v = fminf(__builtin_fmaf(s[kt][r], 0.125f * LOG2E, bp[16 * kt + r]), cap[kt - KT_LO][r]); else v = s[kt][r] * (0.125f * LOG2E);
            s[kt][r] = v; mx = fmaxf(mx, v); } }
    mx = xor16_max(mx); mx = xor32_max(mx);
    const float mnew = fmaxf(mrun, mx), alpha = __builtin_amdgcn_exp2f(mrun - mnew);
    mrun = mnew;
    float psum = 0.f;
#pragma unroll
    for (int kt = 0; kt < 4; ++kt) {
        if (kt >= KT_LO && kt <= KT_HI) {
#pragma unroll
            for (int r = 0; r < 4; ++r) { const float p = __builtin_amdgcn_exp2f(s[kt][r] - mnew); s[kt][r] = p; psum += p; } }
        else s[kt] = (f32x4){0.f, 0.f, 0.f, 0.f}; }
    lrun = lrun * alpha + psum;
#pragma unroll
    for (int nt = 0; nt < 4; ++nt) o[nt] = o[nt] * alpha;
#pragma unroll
    for (int ks = 0; ks < 2; ++ks) if (2 * ks + 1 >= KT_LO && 2 * ks <= KT_HI) {
        v4u w; w.x = pk2(s[2 * ks][0], s[2 * ks][1]); w.y = pk2(s[2 * ks][2], s[2 * ks][3]); w.z = pk2(s[2 * ks + 1][0], s[2 * ks + 1][1]); w.w = pk2(s[2 * ks + 1][2], s[2 * ks + 1][3]);
        const bf16x8 pb = __builtin_bit_cast(bf16x8, w);
#pragma unroll
        for (int nt = 0; nt < 4; ++nt) o[nt] = __builtin_amdgcn_mfma_f32_16x16x32_bf16(vf[nt][ks], pb, o[nt], 0, 0, 0); }
}
__device__ __forceinline__ void na_load_vf(const LAS bf16* Vt, bf16x8 (&vf)[4][2], int q, int l15) {
    const LAS bf16* base = Vt + (size_t)(4 * q + (l15 >> 2)) * NP + 4 * (l15 & 3);
#pragma unroll
    for (int nt = 0; nt < 4; ++nt)
#pragma unroll
        for (int ks = 0; ks < 2; ++ks) {
            const s16x4_t lo = __builtin_amdgcn_ds_read_tr16_b64_v4i16((LAS s16x4_t*)(base + (size_t)(32 * ks) * NP + 16 * nt)), hi = __builtin_amdgcn_ds_read_tr16_b64_v4i16((LAS s16x4_t*)(base + (size_t)(32 * ks + 16) * NP + 16 * nt));
            vf[nt][ks] = mk8(__builtin_bit_cast(v2u, lo), __builtin_bit_cast(v2u, hi)); }
}
__device__ __forceinline__ void ph_na(const Ctx& c) {
    LAS bf16* Kb = (LAS bf16*)c.lds;
    LAS bf16* Vb = Kb + 2 * 64 * NP;
    LAS float* rpbL = (LAS float*)(Vb + 2 * 64 * NP);
    const bf16* P = WSP(bf16, WS_PBUF);
    const int q = c.lane >> 4, l15 = c.lane & 15, hq = c.wave & 1;
    const int lkey = c.tid >> 3, lch = c.tid & 7;
    for (int item = blockIdx.x; item < 512 + 16; item += c.G) {
        const bool lat = item < 512;
        int b, h, r0 = 0, rlo = 0, nwin = 0;
        if (lat) { const int rb = item & 31; h = (item >> 5) & 7; b = item >> 8; r0 = 4 * rb; rlo = min(max(r0 - 4, 0), 120); nwin = min(max(r0 - 1, 0), 120) + 7 - rlo + 1; }
        else { const int ci = item - 512; h = ci & 7; b = ci >> 3; }
        const int nsteps = nwin + 4, r = r0 + (c.wave >> 1), rs = min(max(r - 4, 0), 120);
        for (int i = c.tid; i < 465; i += 512) rpbL[i] = c.a->in[I_RPB][h * 465 + i] * LOG2E;
        bf16x8 qf[2][2];
#pragma unroll
        for (int g = 0; g < 2; ++g) { const int qt = lat ? b * SEQ + r * 64 + 16 * (2 * hq + g) + l15 : NLAT + b * CTXL + 32 * c.wave + 16 * g + l15;
#pragma unroll
            for (int ks = 0; ks < 2; ++ks) qf[g][ks] = *(const bf16x8*)(P + (size_t)qt * 2560 + 1024 + h * 64 + 32 * ks + 8 * q); }
        f32x4 o[2][4];
#pragma unroll
        for (int g = 0; g < 2; ++g)
#pragma unroll
            for (int nt = 0; nt < 4; ++nt) o[g][nt] = (f32x4){0.f, 0.f, 0.f, 0.f};
        float mrun[2] = {-1e30f, -1e30f}, lrun[2] = {0.f, 0.f};
        float cap[2][3][4]; int bidx[2];
#pragma unroll
        for (int g = 0; g < 2; ++g) { const int QGr = 2 * hq + g, qc = 16 * QGr + l15, cs = min(max(qc - 8, 0), 48), ktlo = QGr <= 1 ? 0 : QGr - 1; bidx[g] = 4 * q - qc + 15;
#pragma unroll
            for (int t = 0; t < 3; ++t)
#pragma unroll
                for (int rr = 0; rr < 4; ++rr) { const int kc = 16 * (ktlo + t) + 4 * q + rr; cap[g][t][rr] = (unsigned)(kc - cs) < 16u ? __builtin_inff() : -1e30f; } }
        v4u kreg, vreg;
        { const int tok0 = nwin > 0 ? b * SEQ + rlo * 64 : NLAT + b * CTXL; const bf16* src = P + (size_t)(tok0 + lkey) * 2560 + 1536 + h * 64 + 8 * lch; kreg = *(const v4u*)src; vreg = *(const v4u*)(src + 512); }
        for (int s = 0; s < nsteps; ++s) {
            LAS bf16* Kt = Kb + (s & 1) * 64 * NP; LAS bf16* Vt = Vb + (s & 1) * 64 * NP;
            *(LAS v4u*)(Kt + (size_t)lkey * NP + 8 * lch) = kreg;
            *(LAS v4u*)(Vt + (size_t)lkey * NP + 8 * lch) = vreg;
            __syncthreads();
            if (s + 1 < nsteps) { const int s1 = s + 1; const int tok0 = s1 < nwin ? b * SEQ + (rlo + s1) * 64 : NLAT + b * CTXL + 64 * (s1 - nwin);
                const bf16* src = P + (size_t)(tok0 + lkey) * 2560 + 1536 + h * 64 + 8 * lch; kreg = *(const v4u*)src; vreg = *(const v4u*)(src + 512); }
            if (s < nwin) { const int kr = rlo + s;
                if (kr >= rs && kr < rs + 8) { bf16x8 vf[4][2]; na_load_vf(Vt, vf, q, l15); const LAS float* rpbrow = rpbL + (kr - r + 7) * 31;
                    if (hq == 0) { na_qgroup<0, true>(Kt, vf, rpbrow + bidx[0], cap[0], qf[0], o[0], mrun[0], lrun[0], q, l15); na_qgroup<1, true>(Kt, vf, rpbrow + bidx[1], cap[1], qf[1], o[1], mrun[1], lrun[1], q, l15); }
                    else { na_qgroup<2, true>(Kt, vf, rpbrow + bidx[0], cap[0], qf[0], o[0], mrun[0], lrun[0], q, l15); na_qgroup<3, true>(Kt, vf, rpbrow + bidx[1], cap[1], qf[1], o[1], mrun[1], lrun[1], q, l15); } } }
            else { bf16x8 vf[4][2]; na_load_vf(Vt, vf, q, l15);
                na_qgroup<0, false>(Kt, vf, rpbL, cap[0], qf[0], o[0], mrun[0], lrun[0], q, l15); na_qgroup<0, false>(Kt, vf, rpbL, cap[1], qf[1], o[1], mrun[1], lrun[1], q, l15); }
        }
#pragma unroll
        for (int g = 0; g < 2; ++g) { float l = lrun[g]; l = xor16_sum(l); l = xor32_sum(l); const float il = 1.0f / l;
            const int qt = lat ? b * SEQ + r * 64 + 16 * (2 * hq + g) + l15 : NLAT + b * CTXL + 32 * c.wave + 16 * g + l15;
#pragma unroll
            for (int nt = 0; nt < 4; ++nt) { v2u pk; pk.x = pk2(o[g][nt][0] * il, o[g][nt][1] * il); pk.y = pk2(o[g][nt][2] * il, o[g][nt][3] * il);
                *(v2u*)(WSP(bf16, WS_MIX) + (size_t)qt * 1024 + 512 + h * 64 + 16 * nt + 4 * q) = pk; } }
        __syncthreads();
    }
}


typedef int v8i_c __attribute__((ext_vector_type(8)));
typedef int v4i_c __attribute__((ext_vector_type(4)));
__device__ __forceinline__ v8i_c ld32(const unsigned char* p) { const v4i_c lo = *(const v4i_c*)p, hi = *(const v4i_c*)(p + 16); return __builtin_shufflevector(lo, hi, 0, 1, 2, 3, 4, 5, 6, 7); }
template <int NT, int KS, int APITCH, int MT> __device__ __forceinline__ void ctx_pass(const Ctx& c, const unsigned char* A, int lda, const unsigned char* B0, const unsigned char* B1, int ldb, f32x4 (&acc)[MT][NT], int mt0) {
    const int l15 = c.lane & 15, q = c.lane >> 4;
    LAS unsigned char* aL = c.lds;
    v8i_c b[KS][NT];
    { const unsigned char* bp0 = B0 + (size_t)l15 * ldb + 32 * q; const unsigned char* bp1 = B1 + (size_t)l15 * ldb + 32 * q;
#pragma unroll
      for (int ks = 0; ks < KS; ++ks) { b[ks][0] = ld32(bp0 + 128 * ks); if (NT > 1) b[ks][NT - 1] = ld32(bp1 + 128 * ks); } }
    __syncthreads();
    constexpr int CPR = KS * 8;
    for (int i = c.tid; i < 64 * CPR; i += 512) { const int row = i / CPR, ch = i % CPR; *(LAS v4i_c*)(aL + row * APITCH + 16 * ch) = *(const v4i_c*)(A + (size_t)row * lda + 16 * ch); }
    __syncthreads();
#pragma unroll
    for (int ks = 0; ks < KS; ++ks) {
        v8i_c a[MT];
#pragma unroll
        for (int mt = 0; mt < MT; ++mt) { const LAS unsigned char* p = aL + (16 * (mt0 + mt) + l15) * APITCH + 128 * ks + 32 * q; const v4i_c lo = *(const LAS v4i_c*)p, hi = *(const LAS v4i_c*)(p + 16); a[mt] = __builtin_shufflevector(lo, hi, 0, 1, 2, 3, 4, 5, 6, 7); }
#pragma unroll
        for (int mt = 0; mt < MT; ++mt)
#pragma unroll
            for (int nt = 0; nt < NT; ++nt) asm volatile("v_mfma_f32_16x16x128_f8f6f4 %0, %1, %2, %0" : "+v"(acc[mt][nt]) : "v"(b[ks][nt]), "v"(a[mt]));
    }
}
__device__ __forceinline__ void ph_moe_ctx1(const Ctx& c, int layer) {
    const unsigned char* W1 = WSP(unsigned char, WS_W1) + (size_t)layer * 16 * 5632 * 1024;
    const int l15 = c.lane & 15, q = c.lane >> 4;
    for (int item = blockIdx.x; item < 16 * 22; item += c.G) {
        const int e = item / 22, pn = item % 22;
        const unsigned char* A = WSP(unsigned char, WS_XG) + (size_t)(MOE_LAT + e * 256) * 1024;
        const unsigned char* Bg = W1 + ((size_t)e * 5632 + pn * 256 + 16 * c.wave) * 1024;
        f32x4 acc[4][2];
#pragma unroll
        for (int mt = 0; mt < 4; ++mt) { acc[mt][0] = (f32x4){0.f, 0.f, 0.f, 0.f}; acc[mt][1] = (f32x4){0.f, 0.f, 0.f, 0.f}; }
        ctx_pass<2, 8, 1040, 4>(c, A, 1024, Bg, Bg + (size_t)128 * 1024, 1024, acc, 0);
        asm volatile("s_nop 15\n\ts_nop 15" ::: "memory");
        const float in_inv = 1.0f / (SC_X * SC_W);
#pragma unroll
        for (int mt = 0; mt < 4; ++mt) { const f32x4 g = acc[mt][0] * in_inv, u = acc[mt][1] * (in_inv * SC_H);
            const unsigned w = pg8::pk4_fp8(pg8::clamp448(pg8::silu_f(g[0]) * u[0]), pg8::clamp448(pg8::silu_f(g[1]) * u[1]), pg8::clamp448(pg8::silu_f(g[2]) * u[2]), pg8::clamp448(pg8::silu_f(g[3]) * u[3]));
            *(unsigned*)(WSP(unsigned char, WS_HID) + (size_t)(MOE_LAT + e * 256 + 16 * mt + l15) * FF + pn * 128 + 16 * c.wave + 4 * q) = w; }
    }
    __syncthreads();
}
__device__ __forceinline__ void ph_moe_ctx2(const Ctx& c, int layer) {
    const unsigned char* W2 = WSP(unsigned char, WS_W2) + (size_t)layer * 16 * 1024 * 2816;
    const int l15 = c.lane & 15, q = c.lane >> 4, nt = c.wave & 3, mh = c.wave >> 2;
    for (int item = blockIdx.x; item < 16 * 16; item += c.G) {
        const int e = item >> 4, cb = item & 15;
        const unsigned char* A = WSP(unsigned char, WS_HID) + (size_t)(MOE_LAT + e * 256) * FF;
        const unsigned char* B = W2 + ((size_t)e * 1024 + cb * 64 + 16 * nt) * FF;
        f32x4 acc[2][1];
        acc[0][0] = (f32x4){0.f, 0.f, 0.f, 0.f}; acc[1][0] = (f32x4){0.f, 0.f, 0.f, 0.f};
        ctx_pass<1, 11, 1424, 2>(c, A, FF, B, B, FF, acc, 2 * mh);
        ctx_pass<1, 11, 1424, 2>(c, A + 1408, FF, B + 1408, B + 1408, FF, acc, 2 * mh);
        asm volatile("s_nop 15\n\ts_nop 15" ::: "memory");
        const float sc = 1.0f / (SC_H * SC_W);
#pragma unroll
        for (int mt = 0; mt < 2; ++mt) { const f32x4 v = acc[mt][0] * sc; v2u pk; pk.x = pk2(v[0], v[1]); pk.y = pk2(v[2], v[3]);
            *(v2u*)(WSP(bf16, WS_Y) + (size_t)(MOE_LAT + e * 256 + 16 * (2 * mh + mt) + l15) * 1024 + cb * 64 + 16 * nt + 4 * q) = pk; }
    }
    __syncthreads();
}

#ifndef GLA_NAIVE
#define GLA_NAIVE 0
#endif
#ifndef NA_NAIVE
#define NA_NAIVE 0
#endif
#ifndef MK_ONE_LAUNCH
#define MK_ONE_LAUNCH 1
#endif
constexpr int NPH = 23;
#define MKCTX() Ctx c; c.lds = lds; { unsigned long long a_ = (unsigned long long)a; asm volatile("" : "+s"(a_)); const unsigned lo_ = __builtin_amdgcn_readfirstlane((unsigned)a_), hi_ = __builtin_amdgcn_readfirstlane((unsigned)(a_ >> 32)); c.a = (const CAS Args*)(((unsigned long long)hi_ << 32) | lo_); } c.out = a->out; c.ws = a->ws; { int t_ = threadIdx.x; asm volatile("" : "+v"(t_)); c.tid = t_ & 511; } c.lane = c.tid & 63; c.wave = __builtin_amdgcn_readfirstlane(c.tid >> 6); c.G = gridDim.x; \
    c.gw = blockIdx.x * NWAVES + c.wave; c.ngw = c.G * NWAVES
__device__ __forceinline__ void P_prologue(LAS unsigned char* lds, const CAS Args* a) { MKCTX(); ph_prologue(c); }
__device__ __forceinline__ void P_adaln0(LAS unsigned char* lds, const CAS Args* a) { MKCTX(); ph_adaln0(c); }
__device__ __forceinline__ void P_conv(LAS unsigned char* lds, const CAS Args* a) { MKCTX(); ph_conv(c); }
#if NA_NAIVE
__device__ __forceinline__ void P_na(LAS unsigned char* lds, const CAS Args* a) { MKCTX(); ph_na_naive(c); }
#else
__device__ __forceinline__ void P_na(LAS unsigned char* lds, const CAS Args* a) { MKCTX(); ph_na(c); }
#endif
__device__ __forceinline__ void P_outproj_ctx(LAS unsigned char* lds, const CAS Args* a) { MKCTX(); ph_outproj_ctx_tiles(c, WS_WOUTE); }
__device__ __forceinline__ void P_inproj_odd_tiles(LAS unsigned char* lds, const CAS Args* a) { MKCTX(); ph_inproj_odd_tiles(c); }
__device__ __forceinline__ void P_prep_odd(LAS unsigned char* lds, const CAS Args* a) { MKCTX(); ph_prep_odd(c); }
__device__ __forceinline__ void P_pool(LAS unsigned char* lds, const CAS Args* a) { MKCTX(); ph_pool(c); }
__device__ __forceinline__ void P_gla_naive(LAS unsigned char* lds, const CAS Args* a) { MKCTX(); ph_gla_naive(c); }
__device__ __forceinline__ void P_gla_out(LAS unsigned char* lds, const CAS Args* a) { MKCTX(); ph_gla_out(c); }
__device__ __forceinline__ void P_gla_g1(LAS unsigned char* lds, const CAS Args* a) { MKCTX(); ph_gla_g1(c); }
__device__ __forceinline__ void P_gla_g2(LAS unsigned char* lds, const CAS Args* a) { MKCTX(); ph_gla_g2(c); }
__device__ __forceinline__ void P_gla_g3(LAS unsigned char* lds, const CAS Args* a) { MKCTX(); ph_gla_g3(c); }
__device__ __forceinline__ void P_post(LAS unsigned char* lds, const CAS Args* a, int layer, int ntok) { MKCTX(); ph_post(c, layer, ntok); }
__device__ __forceinline__ void P_topk_gather(LAS unsigned char* lds, const CAS Args* a, int nctx) { MKCTX(); ph_topk_gather(c, 256, nctx); }
__device__ __forceinline__ void P_moe_ctx1(LAS unsigned char* lds, const CAS Args* a, int layer) { MKCTX(); ph_moe_ctx1(c, layer); }
__device__ __forceinline__ void P_moe_ctx2(LAS unsigned char* lds, const CAS Args* a, int layer) { MKCTX(); ph_moe_ctx2(c, layer); }
__device__ __forceinline__ void P_combine(LAS unsigned char* lds, const CAS Args* a, int layer, int ntok) { MKCTX(); ph_combine(c, layer, ntok); }
template <int K, int NN, int LDC> __device__ __forceinline__ void P_gemm_bf16(LAS unsigned char* lds, const bf16* A, const bf16* Bt, bf16* O, int nM) {
    pg8::Gemm g{A, Bt, K}; pg8::Order S; S.init(nM, NN, (int)gridDim.x, (int)blockIdx.x, 0);
    pg8::EpiBf16 E{O, LDC, 1.0f}; pg8::gemm_phase<pg8::EpiBf16, pg8::Order, PG8_ALIGN, PG8_SP2>(lds, g, S, E);
}
template <int KB, int NN, int LDC> __device__ __forceinline__ void P_gemm_f8_bf16(LAS unsigned char* lds, const unsigned char* A, const unsigned char* Bt, bf16* O, int nM) {
    pg8::Gemm g{(const bf16*)A, (const bf16*)Bt, KB / 2}; pg8::Order S; S.init(nM, NN, (int)gridDim.x, (int)blockIdx.x, 1);
    pg8::EpiBf16F8 E{O, LDC, 1.0f / (SC_H * SC_W)}; pg8::gemm_phase<pg8::EpiBf16F8, pg8::Order, PG8_ALIGN, PG8_SP2>(lds, g, S, E);
}
template <int KB, int NN, int LDC> __device__ __forceinline__ void P_gemm_f8_swiglu(LAS unsigned char* lds, const unsigned char* A, const unsigned char* Bt, unsigned char* O, int nM) {
    pg8::Gemm g{(const bf16*)A, (const bf16*)Bt, KB / 2}; pg8::Order S; S.init(nM, NN, (int)gridDim.x, (int)blockIdx.x, 1);
    pg8::EpiSwigluF8 E{O, LDC, 1.0f / (SC_X * SC_W), SC_H}; pg8::gemm_phase<pg8::EpiSwigluF8, pg8::Order, PG8_ALIGN, PG8_SP2>(lds, g, S, E);
}

__global__ void __launch_bounds__(NWAVES * 64, 2) fwd(Args args) {
    extern __shared__ __attribute__((aligned(16))) unsigned char lds_raw[];
    LAS unsigned char* lds = (LAS unsigned char*)lds_raw;
    const CAS Args* a = (const CAS Args*)__builtin_amdgcn_kernarg_segment_ptr();
    unsigned char* ws = args.ws;
    const int tid = threadIdx.x;
    volatile LAS unsigned* MISC = (volatile LAS unsigned*)(lds + MISC_OFF);
    for (int u = tid; u < (LDS_BYTES - LDSCTL_OFF) / 4; u += NWAVES * 64) ((LAS unsigned*)(lds + LDSCTL_OFF))[u] = 0u;
    __syncthreads();
    const int lo = args.ph_lo, hi = args.ph_hi;
    XcdBarrier bar; bar.bar = (unsigned*)(ws + WS_CTL) + CW_BAR; bar.x = 0; bar.st = nullptr;
    if (hi - lo > 1) bar = xcd_barrier_post((unsigned*)(ws + WS_CTL) + CW_BAR, MISC + 8);
#ifndef PROBE_MASK
#define PROBE_MASK 0
#endif
#ifndef PROBE_N
#define PROBE_N 2
#endif
#define REP(k) (((k) != 17 && (k) != 10 && (((PROBE_MASK) >> ((k) < 17 ? (k) : (k) - 12)) & 1)) ? PROBE_N : 1)
#define REPX(b) ((((PROBE_MASK) >> (b)) & 1) ? PROBE_N : 1)
#define RX(b, call) do { for (int rx_ = 0; rx_ < REPX(b); ++rx_) { call; } } while (0)
#define IN(k) (lo <= (k) && (k) < hi)
#define SEAM(k) do { if (IN(k) && IN((k) + 1)) xcd_barrier(bar); } while (0)
#define WP(off) ((bf16*)(ws + (off)))
    if (IN(0)) for (int rep_ = 0; rep_ < REP(0); ++rep_) { P_prologue(lds, a); } SEAM(0);
    if (IN(1)) for (int rep_ = 0; rep_ < REP(1); ++rep_) { P_adaln0(lds, a); } SEAM(1);
    if (IN(2)) for (int rep_ = 0; rep_ < REP(2); ++rep_) { P_gemm_bf16<1024, EVEN_IN / 256, EVEN_IN>(lds, WP(WS_H), WP(WS_WINE), WP(WS_PBUF), NTOK / 256); } SEAM(2);
    if (IN(3)) for (int rep_ = 0; rep_ < REP(3); ++rep_) { RX(17, P_conv(lds, a)); RX(18, P_na(lds, a)); } SEAM(3);
    if (IN(4)) for (int rep_ = 0; rep_ < REP(4); ++rep_) { P_gemm_bf16<1024, 4, 1024>(lds, WP(WS_MIX), WP(WS_WOUTE), WP(WS_YO), NLAT / 256); RX(19, P_outproj_ctx(lds, a)); } SEAM(4);
#define COMMON(layer, p0, ntok, nlists, nrows) \
    if (IN(p0 + 0)) for (int rep_ = 0; rep_ < REP(p0 + 0); ++rep_) { P_post(lds, a, layer, ntok); } SEAM(p0 + 0); \
    if (IN(p0 + 1)) for (int rep_ = 0; rep_ < REP(p0 + 1); ++rep_) { P_topk_gather(lds, a, (nlists) - 32); } do { if (IN(p0 + 1) && IN(p0 + 3)) xcd_barrier(bar); } while (0); \
    if (IN(p0 + 3)) for (int rep_ = 0; rep_ < REP(p0 + 3); ++rep_) { P_gemm_f8_swiglu<1024, 22, FF>(lds, ws + WS_XG, ws + WS_W1 + (size_t)layer * 16 * 5632 * 1024, ws + WS_HID, MOE_LAT / 256); if ((nrows) > MOE_LAT) P_moe_ctx1(lds, a, layer); } SEAM(p0 + 3); \
    if (IN(p0 + 4)) for (int rep_ = 0; rep_ < REP(p0 + 4); ++rep_) { P_gemm_f8_bf16<FF, 4, 1024>(lds, ws + WS_HID, ws + WS_W2 + (size_t)layer * 16 * 1024 * 2816, WP(WS_Y), MOE_LAT / 256); if ((nrows) > MOE_LAT) P_moe_ctx2(lds, a, layer); } SEAM(p0 + 4); \
    if (IN(p0 + 5)) for (int rep_ = 0; rep_ < REP(p0 + 5); ++rep_) { P_combine(lds, a, layer, ntok); }
    COMMON(0, 5, NTOK, 64, MOE_ROWS) SEAM(10);
    if (IN(11)) for (int rep_ = 0; rep_ < REP(11); ++rep_) { P_gemm_bf16<1024, 8, 2048>(lds, WP(WS_H), WP(WS_WINO), WP(WS_PBUF), NLAT / 256); RX(20, P_inproj_odd_tiles(lds, a)); }
    do { if (IN(11) && IN(13)) xcd_barrier(bar); } while (0);
#if GLA_NAIVE
    if (IN(12)) for (int rep_ = 0; rep_ < REP(12); ++rep_) { P_prep_odd(lds, a); } SEAM(12);
    if (IN(13)) for (int rep_ = 0; rep_ < REP(13); ++rep_) { P_pool(lds, a); P_gla_naive(lds, a); } SEAM(13);
    if (IN(14)) for (int rep_ = 0; rep_ < REP(14); ++rep_) { P_gla_out(lds, a); } SEAM(14);
    SEAM(15);
#else
    if (IN(13)) for (int rep_ = 0; rep_ < REP(13); ++rep_) { RX(21, P_pool(lds, a)); RX(22, P_gla_g1(lds, a)); } SEAM(13);
    if (IN(14)) for (int rep_ = 0; rep_ < REP(14); ++rep_) { P_gla_g2(lds, a); } SEAM(14);
    if (IN(15)) for (int rep_ = 0; rep_ < REP(15); ++rep_) { P_gla_g3(lds, a); } SEAM(15);
#endif
    if (IN(16)) for (int rep_ = 0; rep_ < REP(16); ++rep_) { P_gemm_bf16<1024, 4, 1024>(lds, WP(WS_MIX), WP(WS_WOUTO), WP(WS_YO), NLAT / 256); } SEAM(16);
    COMMON(1, 17, NLAT, 32, MOE_LAT)
#undef COMMON
#undef IN
#undef SEAM
#undef WP
}

extern "C" void kernel_launch(void* const* d_in, const int* in_sizes, int n_in, void* d_out, int out_size, void* d_ws, size_t ws_size, hipStream_t stream) {
    static int grid = 0;
    if (grid == 0) {
        if (n_in != N_IN || out_size != NLAT * D || ws_size < WS_END) { fprintf(stderr, "kernel_launch: unexpected shapes (n_in %d, out %d, ws %zu, need %zu)\n", n_in, out_size, ws_size, (size_t)WS_END); grid = -1; return; }
        int dev = 0, cus = 0, per_cu = 0;
        if (hipGetDevice(&dev) != hipSuccess || hipDeviceGetAttribute(&cus, hipDeviceAttributeMultiprocessorCount, dev) != hipSuccess) { grid = -1; return; }
        if (hipFuncSetAttribute((const void*)fwd, hipFuncAttributeMaxDynamicSharedMemorySize, LDS_BYTES) != hipSuccess) { fprintf(stderr, "kernel_launch: hipFuncSetAttribute failed\n"); grid = -1; return; }
        if (hipOccupancyMaxActiveBlocksPerMultiprocessor(&per_cu, (const void*)fwd, NWAVES * 64, LDS_BYTES) != hipSuccess || per_cu < 1) fprintf(stderr, "kernel_launch: occupancy query reports %d\n", per_cu);
        (void)hipGetLastError();
        grid = cus;
    }
    if (grid < 0) return;
    (void)in_sizes;
    if (hipMemsetAsync((char*)d_ws + WS_CTL, 0, CTL_ZERO_BYTES, stream) != hipSuccess) return;
    Args a{};
    for (int i = 0; i < N_IN; ++i) a.in[i] = (const float*)d_in[i];
    a.out = (float*)d_out; a.ws = (unsigned char*)d_ws;
#if MK_ONE_LAUNCH
    a.ph_lo = 0; a.ph_hi = NPH;
    hipLaunchKernelGGL(fwd, dim3(grid), dim3(NWAVES * 64), LDS_BYTES, stream, a);
#else
    for (int li = 0; li < NPH; ++li) { a.ph_lo = li; a.ph_hi = li + 1; hipLaunchKernelGGL(fwd, dim3(grid), dim3(NWAVES * 64), LDS_BYTES, stream, a); }
#endif
}
```

```cpp
#include <hip/hip_runtime.h>
#include <cstdio>
#include <cstdint>
namespace pg8 {
#define PG8_LAS __attribute__((address_space(3)))
typedef unsigned short bf16_t;
typedef short bf16x8 __attribute__((ext_vector_type(8)));
typedef float f32x4 __attribute__((ext_vector_type(4)));
typedef unsigned u32x4 __attribute__((ext_vector_type(4)));
typedef int v4i_t __attribute__((ext_vector_type(4)));
typedef int v8i_t __attribute__((ext_vector_type(8)));
#ifndef PG8_F8_SCALE
#define PG8_F8_SCALE 0
#endif
constexpr int BM = 256, BK = 64, HALF = 128, HTB = HALF * BK * 2  , STAGE_BYTES = 8 * HTB, NXCD = 8, WGM = 8;

__host__ __device__ __forceinline__ int lds_byte(int r, int c) { const int st = (r >> 4) * 2 + (c >> 5), rr = r & 15, cc = c & 31, ob = rr * 64 + cc * 2; return st * 1024 + (ob ^ (((ob >> 9) & 1) << 5)); }
__host__ __device__ __forceinline__ void stage_rc(int b, int& R, int& C) { const int st = b / 1024, sb = b % 1024, swz = sb ^ (((sb >> 9) & 1) << 5); R = (st >> 1) * 16 + swz / 64; C = (st & 1) * 32 + (swz % 64) / 2; }
__host__ __device__ __forceinline__ int perm32(int rho) { const int n = rho >> 4, i = rho & 15; return 8 * (i >> 2) + 4 * n + (i & 3); }

struct Unit { int pm, pn, pb; };
struct Gemm { const bf16_t* A; const bf16_t* Bt; int K; };

struct Order {
    int nM, nN, nwg, G, c, moe;
    __device__ void init(int nM_, int nN_, int G_, int c_, int moe_) { nM = nM_; nN = nN_; nwg = nM * nN; G = G_; c = c_; moe = moe_; }
    __device__ bool next(int i, Unit& u) const {
        const long L = (long)i * G + c; if (L >= nwg) return false;
        int wgid = (int)L; { const int q = nwg / NXCD, r = nwg % NXCD, xcd = wgid % NXCD, off = wgid / NXCD; wgid = (xcd < r ? xcd * (q + 1) : r * (q + 1) + (xcd - r) * q) + off; }
        const int nig = WGM * nN, gid = wgid / nig, fm = gid * WGM, gsz = (nM - fm) < WGM ? (nM - fm) : WGM;
        u.pm = fm + ((wgid % nig) % gsz); u.pn = (wgid % nig) / gsz;
        u.pb = moe ? ((u.pm < 128 ? (u.pm >> 3) : (u.pm - 128)) * nN + u.pn) : u.pn;
        return true;
    }
    __device__ __forceinline__ void a_ready(const Unit&) const {}
    __device__ __forceinline__ void done(const Unit&) const {}
};

__device__ __forceinline__ unsigned cvt_pk_bf16(float lo, float hi) { unsigned r; asm volatile("v_cvt_pk_bf16_f32 %0, %1, %2" : "=v"(r) : "v"(lo), "v"(hi)); return r; }

template <bool F8_> struct EpiBf16T {
    static constexpr bool PERM = true, AFTER_DRAIN = false, F8 = F8_;
    bf16_t* O; int ldc; float scale;
    __device__ __forceinline__ void operator()(const f32x4 (&acc)[2][2][4][2], const Unit& u, int wr, int wc, int fr, int fq) const {
        const int row0 = u.pm * BM + wr * 64 + fr; const int col0 = u.pn * BM + wc * 32 + 8 * fq;
#pragma unroll
        for (int ai = 0; ai < 2; ++ai)
#pragma unroll
            for (int m = 0; m < 4; ++m) { bf16_t* rowp = O + (size_t)(row0 + ai * HALF + m * 16) * ldc + col0;
#pragma unroll
                for (int bj = 0; bj < 2; ++bj) { const f32x4 v0 = acc[ai][bj][m][0] * scale, v1 = acc[ai][bj][m][1] * scale;
                    u32x4 w; w.x = cvt_pk_bf16(v0[0], v0[1]); w.y = cvt_pk_bf16(v0[2], v0[3]); w.z = cvt_pk_bf16(v1[0], v1[1]); w.w = cvt_pk_bf16(v1[2], v1[3]);
                    *(u32x4*)(rowp + bj * HALF) = w; } }
    }
};
__device__ __forceinline__ float silu_f(float x) { return x * __builtin_amdgcn_rcpf(1.0f + __expf(-x)); }
typedef EpiBf16T<false> EpiBf16;
typedef EpiBf16T<true> EpiBf16F8;
__device__ __forceinline__ float clamp448(float x) { return __builtin_fminf(__builtin_fmaxf(x, -448.0f), 448.0f); }
__device__ __forceinline__ unsigned pk4_fp8(float a, float b, float c, float d) { unsigned w = 0u; w = __builtin_amdgcn_cvt_pk_fp8_f32(a, b, w, false); w = __builtin_amdgcn_cvt_pk_fp8_f32(c, d, w, true); return w; }
struct EpiSwigluF8 {
    static constexpr bool PERM = true, AFTER_DRAIN = false, F8 = true;
    unsigned char* O; int ldc; float in_inv, out_scale;
    __device__ __forceinline__ void operator()(const f32x4 (&acc)[2][2][4][2], const Unit& u, int wr, int wc, int fr, int fq) const {
        const int row0 = u.pm * BM + wr * 64 + fr; const int col0 = u.pn * HALF + wc * 32 + 8 * fq;
#pragma unroll
        for (int ai = 0; ai < 2; ++ai)
#pragma unroll
            for (int m = 0; m < 4; ++m) { unsigned char* rowp = O + (size_t)(row0 + ai * HALF + m * 16) * ldc + col0;
                const f32x4 G0 = acc[ai][0][m][0], G1 = acc[ai][0][m][1], U0 = acc[ai][1][m][0], U1 = acc[ai][1][m][1];
                const float ce = -in_inv * 1.4426950408889634f, cm = in_inv * in_inv * out_scale;
                float h0[4], h1[4];
#pragma unroll
                for (int j = 0; j < 4; ++j) { h0[j] = clamp448((G0[j] * U0[j]) * (cm * __builtin_amdgcn_rcpf(1.0f + __builtin_amdgcn_exp2f(G0[j] * ce)))); h1[j] = clamp448((G1[j] * U1[j]) * (cm * __builtin_amdgcn_rcpf(1.0f + __builtin_amdgcn_exp2f(G1[j] * ce)))); }
                typedef unsigned u32x2 __attribute__((ext_vector_type(2)));
                u32x2 w; w.x = pk4_fp8(h0[0], h0[1], h0[2], h0[3]); w.y = pk4_fp8(h1[0], h1[1], h1[2], h1[3]);
                *(u32x2*)rowp = w; }
    }
};
struct EpiSwiglu {
    static constexpr bool PERM = true, AFTER_DRAIN = false, F8 = false;
    bf16_t* O; int ldc;
    __device__ __forceinline__ void operator()(const f32x4 (&acc)[2][2][4][2], const Unit& u, int wr, int wc, int fr, int fq) const {
        const int row0 = u.pm * BM + wr * 64 + fr; const int col0 = u.pn * HALF + wc * 32 + 8 * fq;
#pragma unroll
        for (int ai = 0; ai < 2; ++ai)
#pragma unroll
            for (int m = 0; m < 4; ++m) { bf16_t* rowp = O + (size_t)(row0 + ai * HALF + m * 16) * ldc + col0;
                const f32x4 g0 = acc[ai][0][m][0], g1 = acc[ai][0][m][1], u0 = acc[ai][1][m][0], u1 = acc[ai][1][m][1];
                u32x4 w; w.x = cvt_pk_bf16(silu_f(g0[0]) * u0[0], silu_f(g0[1]) * u0[1]); w.y = cvt_pk_bf16(silu_f(g0[2]) * u0[2], silu_f(g0[3]) * u0[3]);
                w.z = cvt_pk_bf16(silu_f(g1[0]) * u1[0], silu_f(g1[1]) * u1[1]); w.w = cvt_pk_bf16(silu_f(g1[2]) * u1[2], silu_f(g1[3]) * u1[3]);
                *(u32x4*)rowp = w; }
    }
};

template <class Epi, class Sched, bool ALIGN_EPI = false, bool SP2 = false>
__device__ __forceinline__ void gemm_phase(PG8_LAS unsigned char* lds, const Gemm g, const Sched& S, const Epi& E) {
    int tid_ = threadIdx.x; asm volatile("" : "+v"(tid_));
    const int tid = tid_ & 511, wid = __builtin_amdgcn_readfirstlane(tid >> 6), lane = tid & 63, wr = wid >> 2, wc = wid & 3, fr = lane & 15, fq = lane >> 4;
    const int K = g.K, nt = K / BK;
    unsigned voffA[2], voffB[2];
#pragma unroll
    for (int i = 0; i < 2; ++i) { int R, C; stage_rc(tid * 16 + i * 8192, R, C); const int Rb = Epi::PERM ? ((R & ~31) + perm32(R & 31)) : R;
        voffA[i] = (unsigned)(R * K + C) * 2u; voffB[i] = (unsigned)(Rb * K + C) * 2u; }
    const size_t kstep = (size_t)(BK * 2);
    const size_t hstep = (size_t)HALF * K * 2;
    const size_t tstep = 2 * hstep;
    const unsigned ldsw = (unsigned)wid * 1024u;
    const int aoff = lds_byte(wr * 64 + fr, fq * 8), boff = lds_byte(wc * 32 + fr, fq * 8);
#define PG8_SA(b, h) (((b) * 2 + (h)) * HTB)
#define PG8_SB(b, h) ((4 + (b) * 2 + (h)) * HTB)
#define PG8_STAGE(bufoff, gbase, voff) do { _Pragma("unroll") for (int _i = 0; _i < 2; ++_i) \
        __builtin_amdgcn_global_load_lds((const unsigned*)((const char*)(gbase) + (voff)[_i]), (PG8_LAS unsigned*)(lds + (bufoff) + ldsw + _i * 8192), 16, 0, 0); } while (0)
#define PG8_LD16(off) (*(const PG8_LAS v4i_t*)(lds + (off)))
#define PG8_LDA(dst, b, h) do { _Pragma("unroll") for (int m = 0; m < 4; ++m) { if constexpr (Epi::F8) { const v4i_t lo_ = PG8_LD16(PG8_SA(b, h) + aoff + m * 2048), hi_ = PG8_LD16(PG8_SA(b, h) + aoff + m * 2048 + 1024); dst##8[m] = __builtin_shufflevector(lo_, hi_, 0, 1, 2, 3, 4, 5, 6, 7); } \
        else { _Pragma("unroll") for (int k = 0; k < 2; ++k) dst[m][k] = *(const PG8_LAS bf16x8*)(lds + PG8_SA(b, h) + aoff + m * 2048 + k * 1024); } } } while (0)
#define PG8_LDB(dst, b, h) do { _Pragma("unroll") for (int n = 0; n < 2; ++n) { if constexpr (Epi::F8) { const v4i_t lo_ = PG8_LD16(PG8_SB(b, h) + boff + n * 2048), hi_ = PG8_LD16(PG8_SB(b, h) + boff + n * 2048 + 1024); dst##8[n] = __builtin_shufflevector(lo_, hi_, 0, 1, 2, 3, 4, 5, 6, 7); } \
        else { _Pragma("unroll") for (int k = 0; k < 2; ++k) dst[n][k] = *(const PG8_LAS bf16x8*)(lds + PG8_SB(b, h) + boff + n * 2048 + k * 1024); } } } while (0)
#define PG8_MMA(ai, bj, At, Bt) do { __builtin_amdgcn_s_setprio(1); _Pragma("unroll") for (int m = 0; m < 4; ++m) _Pragma("unroll") for (int n = 0; n < 2; ++n) { \
        if constexpr (Epi::F8) { asm volatile("v_mfma_f32_16x16x128_f8f6f4 %0, %1, %2, %0" : "+v"(acc[ai][bj][m][n]) : "v"(Bt##8[n]), "v"(At##8[m])); } \
        else { _Pragma("unroll") for (int k = 0; k < 2; ++k) acc[ai][bj][m][n] = __builtin_amdgcn_mfma_f32_16x16x32_bf16(Bt[n][k], At[m][k], acc[ai][bj][m][n], 0, 0, 0); } } \
        __builtin_amdgcn_s_setprio(0); } while (0)
#define PG8_WAIT_V(n) asm volatile("s_waitcnt vmcnt(" #n ")" ::: "memory")
#define PG8_WAIT_L(n) asm volatile("s_waitcnt lgkmcnt(" #n ")" ::: "memory")
#define PG8_BAR __builtin_amdgcn_s_barrier()
#define PG8_SCHED __builtin_amdgcn_sched_barrier(0)
    Unit cur, nxt; int ui = 0;
    if (!S.next(0, cur)) return;
    f32x4 acc[2][2][4][2];
#pragma unroll
    for (int a = 0; a < 2; ++a)
#pragma unroll
        for (int b = 0; b < 2; ++b)
#pragma unroll
            for (int m = 0; m < 4; ++m)
#pragma unroll
                for (int n = 0; n < 2; ++n) acc[a][b][m][n] = (f32x4){0.f, 0.f, 0.f, 0.f};
    bf16x8 At[4][2], B0[2][2], B1[2][2]; v8i_t At8[4], B08[2], B18[2];
    const char* cA = (const char*)g.A + (size_t)cur.pm * tstep; const char* cB = (const char*)g.Bt + (size_t)cur.pb * tstep;
    S.a_ready(cur);
    if constexpr (SP2) {
        PG8_STAGE(PG8_SB(0, 0), cB, voffB); PG8_STAGE(PG8_SB(0, 1), cB + hstep, voffB); PG8_STAGE(PG8_SA(0, 0), cA, voffA); PG8_STAGE(PG8_SA(0, 1), cA + hstep, voffA);
        if (wr == 1) PG8_BAR;
        PG8_WAIT_V(2); PG8_BAR;
        PG8_STAGE(PG8_SB(1, 0), cB + kstep, voffB); PG8_STAGE(PG8_SA(1, 0), cA + kstep, voffA); PG8_STAGE(PG8_SB(1, 1), cB + hstep + kstep, voffB);
        PG8_WAIT_V(6); PG8_BAR;
    } else {
        PG8_STAGE(PG8_SB(0, 0), cB, voffB); PG8_STAGE(PG8_SA(0, 0), cA, voffA); PG8_STAGE(PG8_SB(0, 1), cB + hstep, voffB); PG8_STAGE(PG8_SA(0, 1), cA + hstep, voffA);
        if (wr == 1) PG8_BAR;
        PG8_WAIT_V(4); PG8_BAR;
        PG8_STAGE(PG8_SB(1, 0), cB + kstep, voffB); PG8_STAGE(PG8_SA(1, 0), cA + kstep, voffA); PG8_STAGE(PG8_SB(1, 1), cB + hstep + kstep, voffB);
        PG8_WAIT_V(6); PG8_BAR;
    }
    for (;;) {
        const bool has_next = S.next(ui + 1, nxt);
        const char* nA = has_next ? (const char*)g.A + (size_t)nxt.pm * tstep : cA; const char* nB = has_next ? (const char*)g.Bt + (size_t)nxt.pb * tstep : cB;
        for (int t = 0; t < nt; t += 2) {
            const bool last = (t == nt - 2);
            const char* a1 = cA + (size_t)(t + 1) * kstep;
            const char* a2 = last ? nA : cA + (size_t)(t + 2) * kstep; const char* b2 = last ? nB : cB + (size_t)(t + 2) * kstep;
            const char* a3 = a2 + kstep; const char* b3 = b2 + kstep;
            if (last && has_next) S.a_ready(nxt);
            if constexpr (SP2) {
            PG8_LDB(B0, 0, 0); PG8_LDB(B1, 0, 1); PG8_SCHED; PG8_LDA(At, 0, 0); PG8_STAGE(PG8_SA(1, 1), a1 + hstep, voffA);
            PG8_WAIT_V(8); PG8_WAIT_L(0); PG8_BAR; PG8_MMA(0, 0, At, B0); PG8_MMA(0, 1, At, B1); PG8_BAR; PG8_SCHED;
            PG8_LDA(At, 0, 1); PG8_STAGE(PG8_SB(0, 0), b2, voffB); PG8_STAGE(PG8_SB(0, 1), b2 + hstep, voffB); PG8_STAGE(PG8_SA(0, 0), a2, voffA);
            PG8_WAIT_V(8); PG8_WAIT_L(0); PG8_BAR; PG8_MMA(1, 0, At, B0); PG8_MMA(1, 1, At, B1); PG8_BAR; PG8_SCHED;
            PG8_LDB(B0, 1, 0); PG8_LDB(B1, 1, 1); PG8_SCHED; PG8_LDA(At, 1, 0); PG8_STAGE(PG8_SA(0, 1), a2 + hstep, voffA);
            PG8_WAIT_V(8); PG8_WAIT_L(0); PG8_BAR; PG8_MMA(0, 0, At, B0); PG8_MMA(0, 1, At, B1); PG8_BAR; PG8_SCHED;
            PG8_LDA(At, 1, 1); PG8_STAGE(PG8_SB(1, 0), b3, voffB); PG8_STAGE(PG8_SB(1, 1), b3 + hstep, voffB); PG8_STAGE(PG8_SA(1, 0), a3, voffA);
            PG8_WAIT_V(8); PG8_WAIT_L(0); PG8_BAR; PG8_MMA(1, 0, At, B0); PG8_MMA(1, 1, At, B1); PG8_BAR; PG8_SCHED;
            } else {
            PG8_LDB(B0, 0, 0); PG8_SCHED; PG8_LDA(At, 0, 0); PG8_STAGE(PG8_SA(1, 1), a1 + hstep, voffA);
            PG8_WAIT_L(8); PG8_BAR; PG8_WAIT_L(0); PG8_MMA(0, 0, At, B0); PG8_BAR; PG8_SCHED;
            PG8_LDB(B1, 0, 1); PG8_STAGE(PG8_SB(0, 0), b2, voffB);
            PG8_BAR; PG8_WAIT_L(0); PG8_MMA(0, 1, At, B1); PG8_BAR;
            PG8_LDA(At, 0, 1); PG8_STAGE(PG8_SA(0, 0), a2, voffA);
            PG8_BAR; PG8_WAIT_L(0); PG8_MMA(1, 0, At, B0); PG8_BAR; PG8_SCHED;
            PG8_STAGE(PG8_SB(0, 1), b2 + hstep, voffB);
            PG8_WAIT_V(6); PG8_BAR; PG8_MMA(1, 1, At, B1); PG8_BAR;
            PG8_LDB(B0, 1, 0); PG8_SCHED; PG8_LDA(At, 1, 0); PG8_STAGE(PG8_SA(0, 1), a2 + hstep, voffA);
            PG8_WAIT_L(8); PG8_BAR; PG8_WAIT_L(0); PG8_MMA(0, 0, At, B0); PG8_BAR; PG8_SCHED;
            PG8_LDB(B1, 1, 1); PG8_STAGE(PG8_SB(1, 0), b3, voffB);
            PG8_BAR; PG8_WAIT_L(0); PG8_MMA(0, 1, At, B1); PG8_BAR;
            PG8_LDA(At, 1, 1); PG8_STAGE(PG8_SA(1, 0), a3, voffA);
            PG8_BAR; PG8_WAIT_L(0); PG8_MMA(1, 0, At, B0); PG8_BAR; PG8_SCHED;
            PG8_STAGE(PG8_SB(1, 1), b3 + hstep, voffB);
            PG8_WAIT_V(6); PG8_BAR; PG8_MMA(1, 1, At, B1); PG8_BAR;
            }
        }
        if constexpr (Epi::F8) { asm volatile("s_nop 15\n\ts_nop 15" ::: "memory"); }
        if constexpr (ALIGN_EPI) { if (wr == 0) PG8_BAR; }
        if constexpr (!Epi::AFTER_DRAIN) { E(acc, cur, wr, wc, fr, fq); S.done(cur); }
        if (!has_next) break;
#pragma unroll
        for (int a = 0; a < 2; ++a)
#pragma unroll
            for (int b = 0; b < 2; ++b)
#pragma unroll
                for (int m = 0; m < 4; ++m)
#pragma unroll
                    for (int n = 0; n < 2; ++n) acc[a][b][m][n] = (f32x4){0.f, 0.f, 0.f, 0.f};
        cur = nxt; cA = nA; cB = nB; ++ui;
        if constexpr (ALIGN_EPI) { if (wr == 1) PG8_BAR; }
    }
    PG8_WAIT_V(0);
    if constexpr (!ALIGN_EPI) { if (wr == 0) PG8_BAR; }
    PG8_BAR;
    if constexpr (Epi::AFTER_DRAIN) { E.fused(acc, cur, wr, wc, fr, fq, lds, wid, lane); S.done(cur); }
#undef PG8_SA
#undef PG8_SB
#undef PG8_STAGE
#undef PG8_LDA
#undef PG8_LDB
#undef PG8_MMA
#undef PG8_LD16
#undef PG8_WAIT_V
#undef PG8_WAIT_L
#undef PG8_BAR
#undef PG8_SCHED
}
}

#ifndef PG8_SP2
#define PG8_SP2 true
#endif
#ifndef PG8_ALIGN
#define PG8_ALIGN true
#endif
constexpr int D = 1024, SEQ = 8192, NLAT = 16384, CTXL = 256, NCTX = 512, NTOK = NLAT + NCTX;
constexpr int NE = 16, FF = 2816, EVEN_IN = 2560, ODD_IN = 2080;
constexpr int MOE_LAT = 32768, MOE_ROWS = 36864;
constexpr float EPS = 1e-6f;
constexpr int NWAVES = 8;
enum { I_X = 0, I_C, I_CTX, I_CCTX, I_WMOD, I_BMOD, I_NORMG, I_WINE, I_WOUTE, I_CONVW, I_CONVB, I_CLNG, I_CLNB, I_RPB, I_WINO, I_WOUTO, I_POOLW, I_POOLS, I_GATEW, I_GATEB, I_HEADG, I_ROUTER, I_WG, I_WU, I_WD, N_IN };

constexpr size_t MiB = 1u << 20;
constexpr size_t alup(size_t x) { return (x + MiB - 1) / MiB * MiB; }
constexpr size_t WS_CTL = 0, CTL_ZERO_BYTES = MiB;
constexpr size_t WS_MOD = WS_CTL + MiB;
constexpr size_t WS_ROPE = WS_MOD + alup((size_t)2 * 3 * 6144 * 4);
constexpr size_t WS_AFF = WS_ROPE + MiB;
constexpr size_t WS_INV = WS_AFF + alup((size_t)NTOK * 16 * 4);
constexpr size_t WS_ROWTOK = WS_INV + alup((size_t)NTOK * 16 * 4);
constexpr size_t WS_LR = WS_ROWTOK + alup((size_t)MOE_ROWS * 4);
constexpr size_t WS_WINE = WS_LR + alup((size_t)NTOK * 32 * 4);
constexpr size_t WS_WOUTE = WS_WINE + alup((size_t)2560 * 1024 * 2);
constexpr size_t WS_WINO = WS_WOUTE + alup((size_t)1024 * 1024 * 2);
constexpr size_t WS_WOUTO = WS_WINO + alup((size_t)2080 * 1024 * 2);
constexpr size_t WS_POOLW = WS_WOUTO + alup((size_t)1024 * 1024 * 2);
constexpr size_t WS_W1 = WS_POOLW + MiB;
constexpr size_t WS_W2 = WS_W1 + alup((size_t)2 * 16 * 5632 * 1024 * 2);
constexpr size_t WS_H = WS_W2 + alup((size_t)2 * 16 * 1024 * 2816 * 2);
constexpr size_t WS_X1 = WS_H + alup((size_t)NTOK * 1024 * 2);
constexpr size_t WS_XN2 = WS_X1 + alup((size_t)NTOK * 1024 * 4);
constexpr size_t WS_PBUF = WS_XN2 + alup((size_t)NTOK * 1024 * 2);
constexpr size_t WS_MIX = WS_PBUF + alup((size_t)NTOK * 2560 * 2);
constexpr size_t WS_YO = WS_MIX + alup((size_t)NTOK * 1024 * 2);
constexpr size_t WS_MOE = WS_YO + alup((size_t)NTOK * 1024 * 2);
constexpr size_t WS_XG = WS_MOE;
constexpr size_t WS_HID = WS_XG + alup((size_t)MOE_ROWS * 1024 * 2);
constexpr size_t WS_Y = WS_HID + alup((size_t)MOE_ROWS * 2816 * 2);
constexpr size_t WS_END = WS_Y + alup((size_t)MOE_ROWS * 1024 * 2);
constexpr size_t WS_DPOOL = WS_MOE;
constexpr size_t WS_QR = WS_DPOOL + alup((size_t)NLAT * 512 * 2);
constexpr size_t WS_KR = WS_QR + alup((size_t)NLAT * 256 * 4);
constexpr size_t WS_GF = WS_KR + alup((size_t)NTOK * 256 * 4);
constexpr size_t WS_GB = WS_GF + alup((size_t)NTOK * 256 * 4);
constexpr size_t WS_QE = WS_GB + alup((size_t)NTOK * 256 * 4);
constexpr size_t WS_KD = WS_QE + alup((size_t)2 * NLAT * 256 * 2);
constexpr size_t WS_UT = WS_KD + alup((size_t)2 * NLAT * 256 * 2);
constexpr size_t WS_DC = WS_UT + alup((size_t)16 * 132 * 8192 * 4);
constexpr size_t WS_ST = WS_DC + MiB;
constexpr size_t WS_OACC = WS_ST + alup((size_t)16 * 128 * 8192 * 2);
constexpr size_t WS_GLA_END = WS_OACC + alup((size_t)2 * NLAT * 512 * 4);
static_assert(WS_GLA_END <= WS_END, "overlay fits");
constexpr int CW_TMO = 0, CW_BAR = 4096;

constexpr int RING_OFF = 0, RING_BYTES = 131072;
constexpr int LDSCTL_OFF = RING_BYTES, MISC_OFF = LDSCTL_OFF + 320;
constexpr int LDS_BYTES = 147456;

#define GAS __attribute__((address_space(1)))
#define LAS __attribute__((address_space(3)))
typedef unsigned short bf16;
typedef unsigned v4u __attribute__((ext_vector_type(4)));
typedef unsigned v2u __attribute__((ext_vector_type(2)));
typedef float f32x4 __attribute__((ext_vector_type(4)));
typedef short bf16x8 __attribute__((ext_vector_type(8)));
typedef GAS unsigned gu32;
#define RLX_AGENT __ATOMIC_RELAXED, __HIP_MEMORY_SCOPE_AGENT
#define LDS_WAIT() asm volatile("s_waitcnt lgkmcnt(0)" ::: "memory")
#define VM_WAIT() asm volatile("s_waitcnt vmcnt(0)" ::: "memory")
__device__ __forceinline__ unsigned f2bf(float f) { unsigned u = __builtin_bit_cast(unsigned, f); return (u + 0x7fffu + ((u >> 16) & 1u)) >> 16; }
typedef float f32x2_c __attribute__((ext_vector_type(2)));
typedef __bf16 bf16x2_c __attribute__((ext_vector_type(2)));
__device__ __forceinline__ unsigned pk2(float lo, float hi) { f32x2_c v; v.x = lo; v.y = hi; const bf16x2_c r = __builtin_convertvector(v, bf16x2_c); return __builtin_bit_cast(unsigned, r); }
__device__ __forceinline__ float bflo(unsigned w) { return __builtin_bit_cast(float, w << 16); }
__device__ __forceinline__ float bfhi(unsigned w) { return __builtin_bit_cast(float, w & 0xffff0000u); }
__device__ __forceinline__ float bf2f(bf16 b) { return __builtin_bit_cast(float, ((unsigned)b) << 16); }
template <int CTRL> __device__ __forceinline__ float dpp_mov(float v) { return __builtin_bit_cast(float, __builtin_amdgcn_update_dpp(0, __builtin_bit_cast(int, v), CTRL, 0xF, 0xF, true)); }
__device__ __forceinline__ float lane_xor1(float v) { return dpp_mov<0xB1>(v); }
__device__ __forceinline__ float lane_xor2(float v) { return dpp_mov<0x4E>(v); }
__device__ __forceinline__ float lane_xor4(float v) { return dpp_mov<0x1B>(dpp_mov<0x141>(v)); }
__device__ __forceinline__ float lane_xor8(float v) { return dpp_mov<0x141>(dpp_mov<0x140>(v)); }
__device__ __forceinline__ float row16_sum(float v) { v += lane_xor1(v); v += lane_xor2(v); v += dpp_mov<0x141>(v); v += dpp_mov<0x140>(v); return v; }
__device__ __forceinline__ float wave_sum(float v) {
    v = row16_sum(v); const int b = __builtin_bit_cast(int, v);
    const float r0 = __builtin_bit_cast(float, __builtin_amdgcn_readlane(b, 0)), r1 = __builtin_bit_cast(float, __builtin_amdgcn_readlane(b, 16)), r2 = __builtin_bit_cast(float, __builtin_amdgcn_readlane(b, 32)), r3 = __builtin_bit_cast(float, __builtin_amdgcn_readlane(b, 48));
    return (r0 + r1) + (r2 + r3);
}
typedef unsigned u32x2_t __attribute__((ext_vector_type(2)));
__device__ __forceinline__ void swap16(float v, float& own, float& other) { const u32x2_t r = __builtin_amdgcn_permlane16_swap(__builtin_bit_cast(unsigned, v), __builtin_bit_cast(unsigned, v), false, false); const unsigned r0 = r.x, r1 = r.y; own = __builtin_bit_cast(float, r0); other = __builtin_bit_cast(float, r1); }
__device__ __forceinline__ void swap32(float v, float& own, float& other) { const u32x2_t r = __builtin_amdgcn_permlane32_swap(__builtin_bit_cast(unsigned, v), __builtin_bit_cast(unsigned, v), false, false); const unsigned r0 = r.x, r1 = r.y; own = __builtin_bit_cast(float, r0); other = __builtin_bit_cast(float, r1); }
__device__ __forceinline__ float xor16_max(float v) { float a, b; swap16(v, a, b); return fmaxf(a, b); }
__device__ __forceinline__ float xor32_max(float v) { float a, b; swap32(v, a, b); return fmaxf(a, b); }
__device__ __forceinline__ float xor16_sum(float v) { float a, b; swap16(v, a, b); return a + b; }
__device__ __forceinline__ float xor32_sum(float v) { float a, b; swap32(v, a, b); return a + b; }
__device__ __forceinline__ float silu(float x) { return x / (1.0f + __expf(-x)); }
__device__ __forceinline__ float sigmoidf(float x) { return 1.0f / (1.0f + __expf(-x)); }
#define XB_TMO      128
#define XB_XCNT(j)  (256  + 64 * (j))
#define XB_XSUB(j)  (1280 + 64 * (j))
#define XB_XGEN(j)  (2304 + 64 * (j))
#define XB_TOP      3328
#define XB_TOPGEN   3392
#define XCD_BAR_WORDS 3456
#define XB_SPIN_CAP (1u << 18)

__device__ __forceinline__ unsigned xb_ld(unsigned* p)              { return __hip_atomic_load(p, __ATOMIC_RELAXED, __HIP_MEMORY_SCOPE_AGENT); }
__device__ __forceinline__ unsigned xb_add(unsigned* p, unsigned v) { return __hip_atomic_fetch_add(p, v, __ATOMIC_RELAXED, __HIP_MEMORY_SCOPE_AGENT); }
__device__ __forceinline__ unsigned xb_xcc_id() { return (unsigned)__builtin_amdgcn_s_getreg((3 << 11) | 20) & 0xFu; }
#define XB_SPIN(cond, bar) do { unsigned _sp = 0; while (cond) { __builtin_amdgcn_s_sleep(1); \
    if ((++_sp & 255u) == 0u) { if (xb_ld(&(bar)[XB_TMO])) break; if (_sp > XB_SPIN_CAP) { atomicAdd(&(bar)[XB_TMO], 1u); break; } } } } while (0)

struct XcdBarrier {
    unsigned* bar; unsigned x;
    volatile LAS unsigned* st;
};

__device__ __forceinline__ XcdBarrier xcd_barrier_post(unsigned* bar, volatile LAS unsigned* st) {
    XcdBarrier b; b.bar = bar; b.x = xb_xcc_id(); b.st = st;
    if (threadIdx.x == 0) (void)xb_add(&bar[XB_XCNT(b.x)], 1u);
    return b;
}
__device__ __forceinline__ void xcd_barrier_complete(unsigned* bar, unsigned x, unsigned& nloc, unsigned& nx) {
    const unsigned G = gridDim.x * gridDim.y * gridDim.z;
    unsigned sum, cnt, mine, sp = 0u;
    for (;;) {
        sum = 0u; cnt = 0u; mine = 0u;
#pragma unroll
        for (unsigned j = 0; j < 16; ++j) { const unsigned c = xb_ld(&bar[XB_XCNT(j)]); sum += c; cnt += (c > 0u) ? 1u : 0u; mine = (j == x) ? c : mine; }
        if (sum == G) break;
        __builtin_amdgcn_s_sleep(1);
        if ((++sp & 255u) == 0u) { if (xb_ld(&bar[XB_TMO])) break; if (sp > XB_SPIN_CAP) { atomicAdd(&bar[XB_TMO], 1u); break; } }
    }
    nloc = mine > 0u ? mine : 1u; nx = cnt > 0u ? cnt : 1u;
}

__device__ __forceinline__ void xcd_barrier(const XcdBarrier& b) {
    asm volatile("s_waitcnt vmcnt(0)" ::: "memory");
    __syncthreads();
    if (threadIdx.x == 0) {
        unsigned* bar = b.bar;
        __builtin_amdgcn_s_waitcnt(0);
        unsigned nloc = b.st[0], nx = b.st[1];
        if (nloc == 0u) { xcd_barrier_complete(bar, b.x, nloc, nx); b.st[0] = nloc; b.st[1] = nx; }
        const unsigned old = xb_add(&bar[XB_XSUB(b.x)], 1u);
        const unsigned gen = old / nloc;
        if (old + 1u == (gen + 1u) * nloc) {
            __builtin_amdgcn_fence(__ATOMIC_RELEASE, "agent");
            asm volatile("s_waitcnt vmcnt(0)" ::: "memory");
            const unsigned og = xb_add(&bar[XB_TOP], 1u);
            const unsigned tg = og / nx;
            if (og + 1u == (tg + 1u) * nx) xb_add(&bar[XB_TOPGEN], 1u);
            else XB_SPIN(xb_ld(&bar[XB_TOPGEN]) == tg, bar);
            __builtin_amdgcn_fence(__ATOMIC_ACQUIRE, "agent");
            xb_add(&bar[XB_XGEN(b.x)], 1u);
            asm volatile("s_waitcnt vmcnt(0)" ::: "memory");
        } else {
            XB_SPIN(xb_ld(&bar[XB_XGEN(b.x)]) == gen, bar);
            __builtin_amdgcn_fence(__ATOMIC_ACQUIRE, "agent");
            asm volatile("s_waitcnt vmcnt(0)" ::: "memory");
        }
    }
    __syncthreads();
}

#define CAS __attribute__((address_space(4)))
struct Args { const float* in[N_IN]; float* out; unsigned char* ws; int ph_lo, ph_hi; };
struct Ctx {
    LAS unsigned char* lds;
    const CAS Args* a; float* out; unsigned char* ws;
    int tid, lane, wave, G, gw, ngw;
};
#define WSP(T, off) ((T*)(c.ws + (off)))

__device__ __forceinline__ f32x4 wave_tile16(const bf16* A, int lda, const bf16* Bt, int ldb, int K, int lane) {
    const bf16* ap = A + (size_t)(lane & 15) * lda + 8 * (lane >> 4);
    const bf16* bp = Bt + (size_t)(lane & 15) * ldb + 8 * (lane >> 4);
    f32x4 acc = {0.f, 0.f, 0.f, 0.f};
#pragma unroll 8
    for (int k = 0; k < K; k += 32) {
        const bf16x8 a = *(const bf16x8*)(ap + k), b = *(const bf16x8*)(bp + k);
        acc = __builtin_amdgcn_mfma_f32_16x16x32_bf16(b, a, acc, 0, 0, 0);
    }
    return acc;
}

__device__ __forceinline__ void transpose_tile(const float* W, int N, int k0, int n0, bf16* dst, int ldd, LAS float* scr, int lane) {
#pragma unroll 8
    for (int i = 0; i < 32; ++i) { const int kk = 2 * i + (lane >> 5); scr[kk * 33 + (lane & 31)] = W[(size_t)(k0 + kk) * N + n0 + (lane & 31)]; }
    LDS_WAIT(); asm volatile("" ::: "memory");
    const int cc = lane & 7;
#pragma unroll
    for (int j = 0; j < 4; ++j) { const int n = (lane >> 3) + 8 * j; const LAS float* s = scr + (8 * cc) * 33 + n;
        v4u o; o.x = pk2(s[0 * 33], s[1 * 33]); o.y = pk2(s[2 * 33], s[3 * 33]); o.z = pk2(s[4 * 33], s[5 * 33]); o.w = pk2(s[6 * 33], s[7 * 33]);
        *(v4u*)(dst + (size_t)n * ldd + 8 * cc) = o; }
    LDS_WAIT(); asm volatile("" ::: "memory");
}

constexpr float SC_W = 64.0f, SC_X = 16.0f, SC_H = 8.0f;
__device__ __forceinline__ void transpose64_f8(const float* W, int N, int k0, int n0, unsigned char* dst, int ldd, LAS float* scr, int lane) {
    const int cq = lane & 15, rq = lane >> 4;
    f32x4 v[16];
#pragma unroll
    for (int i = 0; i < 16; ++i) v[i] = *(const f32x4*)(W + (size_t)(k0 + rq + 4 * i) * N + n0 + 4 * cq);
#pragma unroll
    for (int i = 0; i < 16; ++i) *(LAS f32x4*)(scr + (rq + 4 * i) * 64 + 4 * cq) = v[i];
    LDS_WAIT(); asm volatile("" ::: "memory");
    unsigned o[16];
#pragma unroll
    for (int j = 0; j < 16; ++j) o[j] = pg8::pk4_fp8(scr[(4 * j) * 64 + lane] * SC_W, scr[(4 * j + 1) * 64 + lane] * SC_W, scr[(4 * j + 2) * 64 + lane] * SC_W, scr[(4 * j + 3) * 64 + lane] * SC_W);
#pragma unroll
    for (int t = 0; t < 4; ++t) { v4u w; w.x = o[4 * t]; w.y = o[4 * t + 1]; w.z = o[4 * t + 2]; w.w = o[4 * t + 3]; *(v4u*)(dst + (size_t)lane * ldd + 16 * t) = w; }
    LDS_WAIT(); asm volatile("" ::: "memory");
}

constexpr int CV_NIT = 32 * 528;
constexpr int CV_FILL = 648;
__device__ __forceinline__ void convert_tiles(const Ctx& c, unsigned* qctr, int first, int base, int limit, int maxn) {
    volatile LAS unsigned* qslot = (volatile LAS unsigned*)(c.lds + MISC_OFF) + 16;
    f32x4 v[8];
    int it = first, buf = 0, par = 0, done = 0;
    if (first < 0) { if (c.tid == 0) qslot[2] = (unsigned)base + __hip_atomic_fetch_add(qctr, 1u, __ATOMIC_RELAXED, __HIP_MEMORY_SCOPE_AGENT); __syncthreads(); it = (int)qslot[2]; }
    const float* src = nullptr; int N = 0, k0 = 0, n0 = 0, le = 0, which = 0;
#define PRO_DECODE(IT) do { le = (IT) / 528; const int q_ = (IT) % 528; which = q_ / 176; const int r_ = q_ % 176; \
        if (which < 2) { n0 = 256 * (r_ / 16); k0 = 64 * (r_ % 16); N = 2816; src = c.a->in[which ? I_WU : I_WG] + (size_t)le * 1024 * 2816; } \
        else { n0 = 256 * (r_ / 44); k0 = 64 * (r_ % 44); N = 1024; src = c.a->in[I_WD] + (size_t)le * 2816 * 1024; } } while (0)
#define PRO_LOAD() do { _Pragma("unroll") for (int i = 0; i < 8; ++i) v[i] = __builtin_nontemporal_load((const f32x4*)(src + (size_t)(k0 + 8 * c.wave + i) * N + n0 + 4 * c.lane)); } while (0)
    if (it < limit) { PRO_DECODE(it); PRO_LOAD(); }
    while (it < limit) {
        ++done;
        unsigned nx = (unsigned)limit; if (c.tid == 0 && done < maxn) nx = (unsigned)base + __hip_atomic_fetch_add(qctr, 1u, __ATOMIC_RELAXED, __HIP_MEMORY_SCOPE_AGENT);
        LAS float* img = (LAS float*)(c.lds + buf * 65536);
#pragma unroll
        for (int i = 0; i < 8; ++i) *(LAS f32x4*)(img + (8 * c.wave + i) * 256 + 4 * c.lane) = v[i];
        const int n = n0 + (c.tid & 255), kh = c.tid >> 8;
        unsigned char* dst = which < 2 ? WSP(unsigned char, WS_W1) + ((size_t)le * 5632 + (n / 128) * 256 + (n % 128) + which * 128) * 1024 + k0 + 32 * kh
                                       : WSP(unsigned char, WS_W2) + ((size_t)le * 1024 + n) * 2816 + k0 + 32 * kh;
        if (c.tid == 0) qslot[par] = nx;
        __syncthreads();
        const int nxt = (int)qslot[par];
        if (nxt < limit) { PRO_DECODE(nxt); PRO_LOAD(); }
        const LAS float* s = img + (32 * kh) * 256 + (c.tid & 255);
#pragma unroll
        for (int t = 0; t < 2; ++t) { v4u w;
            w.x = pg8::pk4_fp8(s[(16 * t + 0) * 256] * SC_W, s[(16 * t + 1) * 256] * SC_W, s[(16 * t + 2) * 256] * SC_W, s[(16 * t + 3) * 256] * SC_W);
            w.y = pg8::pk4_fp8(s[(16 * t + 4) * 256] * SC_W, s[(16 * t + 5) * 256] * SC_W, s[(16 * t + 6) * 256] * SC_W, s[(16 * t + 7) * 256] * SC_W);
            w.z = pg8::pk4_fp8(s[(16 * t + 8) * 256] * SC_W, s[(16 * t + 9) * 256] * SC_W, s[(16 * t + 10) * 256] * SC_W, s[(16 * t + 11) * 256] * SC_W);
            w.w = pg8::pk4_fp8(s[(16 * t + 12) * 256] * SC_W, s[(16 * t + 13) * 256] * SC_W, s[(16 * t + 14) * 256] * SC_W, s[(16 * t + 15) * 256] * SC_W);
            *(v4u*)(dst + 16 * t) = w; }
        it = nxt; buf ^= 1; par ^= 1;
    }
    __syncthreads();
#undef PRO_DECODE
#undef PRO_LOAD
}
__device__ __forceinline__ void convert_fill(const Ctx& c, int maxn) { convert_tiles(c, (unsigned*)(c.ws + WS_CTL) + 2048 + 64, -1, CV_NIT - CV_FILL, CV_NIT, maxn); }

constexpr int TI_WINE = (1024 / 64) * (2560 / 32), TI_WOUT = (1024 / 64) * (1024 / 32), TI_WINO = (1024 / 64) * (2080 / 32), TI_POOL = 4 * 2 * 4;
constexpr int TI_SMALL = TI_WINE + 2 * TI_WOUT + TI_WINO + TI_POOL;
constexpr int TI_GU = (1024 / 64) * (2816 / 64), TI_DN = (2816 / 64) * (1024 / 64);
constexpr int TI_PER_LE = 2 * TI_GU + TI_DN;
constexpr int TI_TOTAL = TI_SMALL + 32 * TI_PER_LE;

__device__ __forceinline__ void ph_prologue(const Ctx& c) {
    if (blockIdx.x < 192) {
        LAS float* sl = (LAS float*)c.lds;
        LAS float* red = sl + 3 * 1024;
        for (int i = c.tid; i < 3072; i += 512) { const int s = i >> 10, k = i & 1023; const float v = s < 2 ? c.a->in[I_C][s * 1024 + k] : c.a->in[I_CCTX][k]; sl[i] = silu(v); }
        __syncthreads();
        const int item = blockIdx.x, l = item / 96, j = 64 * (item % 96) + c.lane;
        const float* W = c.a->in[I_WMOD] + (size_t)l * 1024 * 6144 + j;
        float a0 = 0.f, a1 = 0.f, a2 = 0.f;
#pragma unroll 8
        for (int kk = 0; kk < 128; ++kk) { const int k = c.wave * 128 + kk; const float w = W[(size_t)k * 6144]; a0 += sl[k] * w; a1 += sl[1024 + k] * w; a2 += sl[2048 + k] * w; }
        red[(c.wave * 3 + 0) * 64 + c.lane] = a0; red[(c.wave * 3 + 1) * 64 + c.lane] = a1; red[(c.wave * 3 + 2) * 64 + c.lane] = a2;
        __syncthreads();
        if (c.wave < 3) { float s = 0.f;
#pragma unroll
            for (int w = 0; w < 8; ++w) s += red[(w * 3 + c.wave) * 64 + c.lane];
            WSP(float, WS_MOD)[(l * 3 + c.wave) * 6144 + j] = s + c.a->in[I_BMOD][l * 6144 + j]; }
        __syncthreads();
    }
    { const int g = blockIdx.x * 512 + c.tid;
      if (g < 192 * 16) { const int pos = g >> 4, f = g & 15; const float inv = powf(10000.0f, -(float)f / 16.0f); const float ang = (float)(pos < 128 ? pos : pos - 128) * inv;
          float sn, cs; sincosf(ang, &sn, &cs); float* T = WSP(float, WS_ROPE); T[g * 2] = cs; T[g * 2 + 1] = sn; } }
    LAS float* scr = (LAS float*)(c.lds + c.wave * 16384);
    for (int it = c.gw; it < TI_SMALL; it += c.ngw) {
        int r = it;
        {
            if (r < TI_WINE) { const int nb = 2560 / 32, kb = r / nb, n0 = 32 * (r % nb); transpose_tile(c.a->in[I_WINE], 2560, 64 * kb, n0, WSP(bf16, WS_WINE) + (size_t)n0 * 1024 + 64 * kb, 1024, scr, c.lane); continue; } r -= TI_WINE;
            if (r < TI_WOUT) { const int nb = 32, kb = r / nb, n0 = 32 * (r % nb); transpose_tile(c.a->in[I_WOUTE], 1024, 64 * kb, n0, WSP(bf16, WS_WOUTE) + (size_t)n0 * 1024 + 64 * kb, 1024, scr, c.lane); continue; } r -= TI_WOUT;
            if (r < TI_WOUT) { const int nb = 32, kb = r / nb, n0 = 32 * (r % nb); transpose_tile(c.a->in[I_WOUTO], 1024, 64 * kb, n0, WSP(bf16, WS_WOUTO) + (size_t)n0 * 1024 + 64 * kb, 1024, scr, c.lane); continue; } r -= TI_WOUT;
            if (r < TI_WINO) { const int nb = 2080 / 32, kb = r / nb, n0 = 32 * (r % nb); transpose_tile(c.a->in[I_WINO], 2080, 64 * kb, n0, WSP(bf16, WS_WINO) + (size_t)n0 * 1024 + 64 * kb, 1024, scr, c.lane); continue; } r -= TI_WINO;
            { const int g = r / 8, kb = (r % 8) / 4, n0 = 32 * (r % 4);
              transpose_tile(c.a->in[I_POOLW] + (size_t)g * 128 * 128, 128, 64 * kb, n0, WSP(bf16, WS_POOLW) + (size_t)g * 128 * 128 + (size_t)n0 * 128 + 64 * kb, 128, scr, c.lane); continue; }
        }
    }
    __syncthreads();
    convert_tiles(c, (unsigned*)(c.ws + WS_CTL) + 2048, (int)blockIdx.x, (int)c.G, CV_NIT - CV_FILL, 1 << 30);
}

__device__ __forceinline__ void ph_adaln0(const Ctx& c) {
    const f32x4* g4 = (const f32x4*)c.a->in[I_NORMG];
    for (int m = c.gw; m < NTOK; m += c.ngw) {
        const f32x4* xr = (const f32x4*)(m < NLAT ? c.a->in[I_X] + (size_t)m * 1024 : c.a->in[I_CTX] + (size_t)(m - NLAT) * 1024);
        const int s = m < NLAT ? m / SEQ : 2;
        const f32x4* mod4 = (const f32x4*)(WSP(float, WS_MOD) + (size_t)s * 6144);
        f32x4 x[4]; float ss = 0.f;
#pragma unroll
        for (int j = 0; j < 4; ++j) { x[j] = xr[c.lane + 64 * j]; ss += (x[j][0] * x[j][0] + x[j][1] * x[j][1]) + (x[j][2] * x[j][2] + x[j][3] * x[j][3]); }
        const float rs = 1.0f / sqrtf(wave_sum(ss) * (1.0f / 1024.0f) + EPS);
        v2u* ho = (v2u*)(WSP(bf16, WS_H) + (size_t)m * 1024);
#pragma unroll
        for (int j = 0; j < 4; ++j) { const int idx = c.lane + 64 * j; const f32x4 o = x[j] * rs * g4[idx] * (mod4[256 + idx] + 1.0f) + mod4[idx];
            v2u pk; pk.x = pk2(o[0], o[1]); pk.y = pk2(o[2], o[3]); ho[idx] = pk; }
    }
}

__device__ __forceinline__ void ph_conv(const Ctx& c) {
    LAS bf16* glu = (LAS bf16*)c.lds;
    LAS float* yb = (LAS float*)(c.lds + 65536);
    const bf16* P = WSP(bf16, WS_PBUF);
    const int ch = c.tid;
    float w[31];
#pragma unroll
    for (int i = 0; i < 31; ++i) w[i] = c.a->in[I_CONVW][i * 512 + ch];
    const float cb = c.a->in[I_CONVB][ch];
    const bool g256 = (c.G == 256); const int nrnd = g256 ? 3 : (NTOK / 32 + (int)c.G - 1) / (int)c.G;
    for (int rnd = 0; rnd < nrnd; ++rnd) {
        const int item = (g256 && rnd == 2) ? 512 + (int)blockIdx.x - 16 : (int)blockIdx.x + rnd * (int)c.G;
        if (item >= NTOK / 32 || item < 0 || (g256 && rnd == 2 && (int)blockIdx.x < 16)) continue;
        const int t0 = item * 32;
        int lo, hi; if (t0 < NLAT) { lo = (t0 / SEQ) * SEQ; hi = lo + SEQ; } else { lo = NLAT + ((t0 - NLAT) / CTXL) * CTXL; hi = lo + CTXL; }
        for (int i = c.tid; i < 62 * 64; i += 512) { const int rr = i >> 6, c8 = (i & 63) * 8, row = t0 - 15 + rr;
            v4u o = {0u, 0u, 0u, 0u};
            if (row >= lo && row < hi) { const v4u a = *(const v4u*)(P + (size_t)row * 2560 + c8), b = *(const v4u*)(P + (size_t)row * 2560 + 512 + c8);
                o.x = pk2(bflo(a.x) * sigmoidf(bflo(b.x)), bfhi(a.x) * sigmoidf(bfhi(b.x))); o.y = pk2(bflo(a.y) * sigmoidf(bflo(b.y)), bfhi(a.y) * sigmoidf(bfhi(b.y)));
                o.z = pk2(bflo(a.z) * sigmoidf(bflo(b.z)), bfhi(a.z) * sigmoidf(bfhi(b.z))); o.w = pk2(bflo(a.w) * sigmoidf(bflo(b.w)), bfhi(a.w) * sigmoidf(bfhi(b.w))); }
            *(LAS v4u*)(glu + rr * 512 + c8) = o; }
        __syncthreads();
        float acc[32];
#pragma unroll
        for (int t = 0; t < 32; ++t) acc[t] = cb;
#pragma unroll
        for (int rr = 0; rr < 62; ++rr) { const float gv = bf2f(glu[rr * 512 + ch]);
#pragma unroll
            for (int t = 0; t < 32; ++t) if (rr - t >= 0 && rr - t <= 30) acc[t] += gv * w[rr - t]; }
#pragma unroll
        for (int t = 0; t < 32; ++t) yb[t * 512 + ch] = acc[t];
        __syncthreads();
#pragma unroll
        for (int tt = 0; tt < 4; ++tt) { const int t = c.wave * 4 + tt;
            const f32x4 v0 = *(const LAS f32x4*)(yb + t * 512 + 8 * c.lane), v1 = *(const LAS f32x4*)(yb + t * 512 + 8 * c.lane + 4);
            const float mu = wave_sum((v0[0] + v0[1]) + (v0[2] + v0[3]) + (v1[0] + v1[1]) + (v1[2] + v1[3])) * (1.0f / 512.0f);
            float q = 0.f; float d[8];
#pragma unroll
            for (int j = 0; j < 4; ++j) { d[j] = v0[j] - mu; d[4 + j] = v1[j] - mu; }
#pragma unroll
            for (int j = 0; j < 8; ++j) q += d[j] * d[j];
            const float rstd = 1.0f / sqrtf(wave_sum(q) * (1.0f / 512.0f) + EPS);
            float o[8];
#pragma unroll
            for (int j = 0; j < 8; ++j) { const int k = 8 * c.lane + j; o[j] = silu(d[j] * rstd * c.a->in[I_CLNG][k] + c.a->in[I_CLNB][k]); }
            v4u pk; pk.x = pk2(o[0], o[1]); pk.y = pk2(o[2], o[3]); pk.z = pk2(o[4], o[5]); pk.w = pk2(o[6], o[7]);
            *(v4u*)(WSP(bf16, WS_MIX) + (size_t)(t0 + t) * 1024 + 8 * c.lane) = pk; }
        __syncthreads();
    }
}

__device__ __forceinline__ void ph_na_naive(const Ctx& c) {
    const bf16* P = WSP(bf16, WS_PBUF);
    const int qc = c.tid & 63, h = c.tid >> 6;
    for (int item = blockIdx.x; item < 256 + 8; item += c.G) {
        int b, r = 0, m; const bool lat = item < 256;
        if (lat) { b = item >> 7; r = item & 127; m = b * SEQ + r * 64 + qc; } else { const int ci = item - 256; b = ci >> 2; m = NLAT + b * CTXL + (ci & 3) * 64 + qc; }
        float q[64], o[64];
        { const bf16* qp = P + (size_t)m * 2560 + 1024 + h * 64;
#pragma unroll
          for (int d = 0; d < 64; d += 8) { const v4u a = *(const v4u*)(qp + d); q[d] = bflo(a.x) * 0.125f; q[d + 1] = bfhi(a.x) * 0.125f; q[d + 2] = bflo(a.y) * 0.125f; q[d + 3] = bfhi(a.y) * 0.125f;
              q[d + 4] = bflo(a.z) * 0.125f; q[d + 5] = bfhi(a.z) * 0.125f; q[d + 6] = bflo(a.w) * 0.125f; q[d + 7] = bfhi(a.w) * 0.125f; } }
#pragma unroll
        for (int d = 0; d < 64; ++d) o[d] = 0.f;
        float mx = -1e30f, l = 0.f;
        const int rs = lat ? min(max(r - 4, 0), 120) : 0, cs = min(max(qc - 8, 0), 48);
        const int nwin = lat ? 128 : 0;
        for (int kk = 0; kk < nwin + 256; ++kk) {
            int tok; float bias = 0.f;
            if (kk < nwin) { const int i = kk >> 4, j = kk & 15; tok = b * SEQ + (rs + i) * 64 + cs + j; bias = c.a->in[I_RPB][(h * 15 + (rs + i - r + 7)) * 31 + (cs + j - qc + 15)]; }
            else tok = NLAT + b * CTXL + (kk - nwin);
            const bf16* kp = P + (size_t)tok * 2560 + 1536 + h * 64; const bf16* vp = kp + 512;
            float s = 0.f;
#pragma unroll
            for (int d = 0; d < 64; d += 8) { const v4u a = *(const v4u*)(kp + d);
                s += q[d] * bflo(a.x) + q[d + 1] * bfhi(a.x) + q[d + 2] * bflo(a.y) + q[d + 3] * bfhi(a.y) + q[d + 4] * bflo(a.z) + q[d + 5] * bfhi(a.z) + q[d + 6] * bflo(a.w) + q[d + 7] * bfhi(a.w); }
            s += bias;
            const float mn = fmaxf(mx, s), al = __expf(mx - mn), p = __expf(s - mn);
            l = l * al + p; mx = mn;
#pragma unroll
            for (int d = 0; d < 64; d += 8) { const v4u a = *(const v4u*)(vp + d);
                o[d] = o[d] * al + p * bflo(a.x); o[d + 1] = o[d + 1] * al + p * bfhi(a.x); o[d + 2] = o[d + 2] * al + p * bflo(a.y); o[d + 3] = o[d + 3] * al + p * bfhi(a.y);
                o[d + 4] = o[d + 4] * al + p * bflo(a.z); o[d + 5] = o[d + 5] * al + p * bfhi(a.z); o[d + 6] = o[d + 6] * al + p * bflo(a.w); o[d + 7] = o[d + 7] * al + p * bfhi(a.w); }
        }
        const float il = 1.0f / l;
        bf16* op = WSP(bf16, WS_MIX) + (size_t)m * 1024 + 512 + h * 64;
#pragma unroll
        for (int d = 0; d < 64; d += 8) { v4u pk; pk.x = pk2(o[d] * il, o[d + 1] * il); pk.y = pk2(o[d + 2] * il, o[d + 3] * il); pk.z = pk2(o[d + 4] * il, o[d + 5] * il); pk.w = pk2(o[d + 6] * il, o[d + 7] * il);
            *(v4u*)(op + d) = pk; }
    }
}

__device__ __forceinline__ void ph_outproj_ctx_tiles(const Ctx& c, size_t ws_wout) {
    for (int t = c.gw; t < 32 * 64; t += c.ngw) { const int mt = t >> 6, nt = t & 63;
        const f32x4 a = wave_tile16(WSP(bf16, WS_MIX) + (size_t)(NLAT + 16 * mt) * 1024, 1024, WSP(bf16, ws_wout) + (size_t)(16 * nt) * 1024, 1024, 1024, c.lane);
        v2u pk; pk.x = pk2(a[0], a[1]); pk.y = pk2(a[2], a[3]);
        *(v2u*)(WSP(bf16, WS_YO) + (size_t)(NLAT + 16 * mt + (c.lane & 15)) * 1024 + 16 * nt + 4 * (c.lane >> 4)) = pk; }
}
__device__ __forceinline__ void ph_inproj_odd_tiles(const Ctx& c) {
    const bf16* H = WSP(bf16, WS_H); const bf16* W = WSP(bf16, WS_WINO);
    for (int t = c.gw; t < 2048 + 32 * 48 + 64; t += c.ngw) {
        if (t < 2048) { const int mt = t >> 1, nt = t & 1;
            const f32x4 a = wave_tile16(H + (size_t)(16 * mt) * 1024, 1024, W + (size_t)(2048 + 16 * nt) * 1024, 1024, 1024, c.lane);
            *(f32x4*)(WSP(float, WS_LR) + (size_t)(16 * mt + (c.lane & 15)) * 32 + 16 * nt + 4 * (c.lane >> 4)) = a; }
        else if (t < 2048 + 32 * 48) { const int u = t - 2048, mt = u / 48, nt = u % 48;
            const f32x4 a = wave_tile16(H + (size_t)(NLAT + 16 * mt) * 1024, 1024, W + (size_t)(768 + 16 * nt) * 1024, 1024, 1024, c.lane);
            v2u pk; pk.x = pk2(a[0], a[1]); pk.y = pk2(a[2], a[3]);
            *(v2u*)(WSP(bf16, WS_PBUF) + (size_t)(NLAT + 16 * mt + (c.lane & 15)) * 2048 + 768 + 16 * nt + 4 * (c.lane >> 4)) = pk; }
        else { const int u = t - 2048 - 32 * 48, mt = u >> 1, nt = u & 1;
            const f32x4 a = wave_tile16(H + (size_t)(NLAT + 16 * mt) * 1024, 1024, W + (size_t)(2048 + 16 * nt) * 1024, 1024, 1024, c.lane);
            *(f32x4*)(WSP(float, WS_LR) + (size_t)(NLAT + 16 * mt + (c.lane & 15)) * 32 + 16 * nt + 4 * (c.lane >> 4)) = a; }
    }
}
__device__ __forceinline__ void ph_pool_tiles(const Ctx& c) {
    for (int t = c.gw; t < 1024 * 32; t += c.ngw) { const int mt = t >> 5, g = (t >> 3) & 3, et = t & 7;
        const f32x4 a = wave_tile16(WSP(bf16, WS_DPOOL) + (size_t)(16 * mt) * 512 + g * 128, 512, WSP(bf16, WS_POOLW) + (size_t)g * 128 * 128 + (size_t)(16 * et) * 128, 128, 128, c.lane);
        const int col = g * 128 + 16 * et + 4 * (c.lane >> 4); const float* sc = c.a->in[I_POOLS] + col;
        v2u pk; pk.x = pk2(a[0] * sc[0], a[1] * sc[1]); pk.y = pk2(a[2] * sc[2], a[3] * sc[3]);
        *(v2u*)(WSP(bf16, WS_MIX) + (size_t)(16 * mt + (c.lane & 15)) * 1024 + col) = pk; }
}

__device__ __forceinline__ void ph_post(const Ctx& c, int layer, int nrows) {
    LAS float* rw = (LAS float*)c.lds;
    { const float* R = c.a->in[I_ROUTER] + (size_t)layer * 1024 * 16;
      for (int i = c.tid; i < 1024 * 16; i += 512) { const int k = i >> 4, e = i & 15, rho = (k & 3) * 256 + ((k >> 8) & 3) * 64 + ((k >> 2) & 63); rw[rho * 16 + 4 * ((e >> 2) ^ ((rho >> 2) & 3)) + (e & 3)] = R[i]; } }
    __syncthreads();
    const f32x4* ng4 = (const f32x4*)(c.a->in[I_NORMG] + (size_t)layer * 4 * 1024);
    const int per = (nrows + c.ngw - 1) / c.ngw, m0 = c.gw * per, m1 = min(m0 + per, nrows);
    const unsigned ln = (unsigned)c.lane;
    if (m0 < m1) {
        int scur = -1;
        f32x4 G1[4], G2[4], M2[4], M3[4], M4[4], xin[4]; v2u yy[4];
#define POST_LOADROW(M) do { const f32x4* xr_ = (const f32x4*)(layer == 0 ? ((M) < NLAT ? c.a->in[I_X] + (size_t)(M) * 1024 : c.a->in[I_CTX] + (size_t)((M) - NLAT) * 1024) : WSP(float, WS_X1) + (size_t)(M) * 1024); \
            const v2u* yr_ = (const v2u*)(WSP(bf16, WS_YO) + (size_t)(M) * 1024); _Pragma("unroll") for (int j = 0; j < 4; ++j) { xin[j] = __builtin_nontemporal_load(xr_ + ln + 64u * j); yy[j] = __builtin_nontemporal_load(yr_ + ln + 64u * j); } } while (0)
        POST_LOADROW(m0);
        for (int m = m0; m < m1; ++m) {
            const int s = m < NLAT ? m / SEQ : 2;
            if (s != scur) { scur = s; const f32x4* mod4 = (const f32x4*)(WSP(float, WS_MOD) + (size_t)(layer * 3 + s) * 6144);
                const f32x4* m2p = mod4 + 512; const f32x4* m3p = mod4 + 768; const f32x4* m4p = mod4 + 1024; const f32x4* g1p = ng4 + 256; const f32x4* g2p = ng4 + 512;
#pragma unroll
                for (int j = 0; j < 4; ++j) { const unsigned idx = ln + 64u * j; G1[j] = g1p[idx]; G2[j] = g2p[idx]; M2[j] = m2p[idx]; M3[j] = m3p[idx]; M4[j] = m4p[idx] + 1.0f; } }
            f32x4 x[4], xi[4]; float ss = 0.f;
#pragma unroll
            for (int j = 0; j < 4; ++j) { x[j] = (f32x4){bflo(yy[j].x), bfhi(yy[j].x), bflo(yy[j].y), bfhi(yy[j].y)}; xi[j] = xin[j]; ss += (x[j][0] * x[j][0] + x[j][1] * x[j][1]) + (x[j][2] * x[j][2] + x[j][3] * x[j][3]); }
            if (m + 1 < m1) POST_LOADROW(m + 1);
            const float ry = 1.0f / sqrtf(wave_sum(ss) * (1.0f / 1024.0f) + EPS);
            float s1 = 0.f;
            f32x4* x1r = (f32x4*)(WSP(float, WS_X1) + (size_t)m * 1024);
#pragma unroll
            for (int j = 0; j < 4; ++j) { x[j] = xi[j] + M2[j] * (x[j] * ry * G1[j]); s1 += (x[j][0] * x[j][0] + x[j][1] * x[j][1]) + (x[j][2] * x[j][2] + x[j][3] * x[j][3]); x1r[ln + 64u * j] = x[j]; }
            const float r1 = 1.0f / sqrtf(wave_sum(s1) * (1.0f / 1024.0f) + EPS);
            unsigned* xo = (unsigned*)(WSP(unsigned char, WS_XN2) + (size_t)m * 1024);
#pragma unroll
            for (int j = 0; j < 4; ++j) { x[j] = x[j] * r1 * G2[j] * M4[j] + M3[j];
                xo[ln + 64u * j] = pg8::pk4_fp8(pg8::clamp448(x[j][0] * SC_X), pg8::clamp448(x[j][1] * SC_X), pg8::clamp448(x[j][2] * SC_X), pg8::clamp448(x[j][3] * SC_X)); }
            float lg[16];
#pragma unroll
            for (int e = 0; e < 16; ++e) lg[e] = 0.f;
#pragma unroll
            for (int j = 0; j < 4; ++j)
#pragma unroll
                for (int t = 0; t < 4; ++t) { const float xn = x[j][t];
                    const LAS float* wr = rw + (t * 256 + 64 * j) * 16 + c.lane * 16; const int sw = (c.lane >> 2) & 3;
                    const f32x4 w0 = *(const LAS f32x4*)(wr + 4 * (0 ^ sw)), w1 = *(const LAS f32x4*)(wr + 4 * (1 ^ sw)), w2 = *(const LAS f32x4*)(wr + 4 * (2 ^ sw)), w3 = *(const LAS f32x4*)(wr + 4 * (3 ^ sw));
#pragma unroll
                    for (int u = 0; u < 4; ++u) { lg[u] += xn * w0[u]; lg[4 + u] += xn * w1[u]; lg[8 + u] += xn * w2[u]; lg[12 + u] += xn * w3[u]; }
                    asm volatile("" ::: "memory"); }
            float a8[8], a4[4], a2[2], a1;
            { const bool hi = (c.lane & 1) != 0;
#pragma unroll
              for (int i = 0; i < 8; ++i) { const float snd = hi ? lg[i] : lg[8 + i]; const float rcv = lane_xor1(snd); a8[i] = (hi ? lg[8 + i] : lg[i]) + rcv; } }
            { const bool hi = (c.lane & 2) != 0;
#pragma unroll
              for (int i = 0; i < 4; ++i) { const float snd = hi ? a8[i] : a8[4 + i]; const float rcv = lane_xor2(snd); a4[i] = (hi ? a8[4 + i] : a8[i]) + rcv; } }
            { const bool hi = (c.lane & 4) != 0;
#pragma unroll
              for (int i = 0; i < 2; ++i) { const float snd = hi ? a4[i] : a4[2 + i]; const float rcv = lane_xor4(snd); a2[i] = (hi ? a4[2 + i] : a4[i]) + rcv; } }
            { const bool hi = (c.lane & 8) != 0; const float snd = hi ? a2[0] : a2[1]; const float rcv = lane_xor8(snd); a1 = (hi ? a2[1] : a2[0]) + rcv; }
            a1 = xor16_sum(a1); a1 = xor32_sum(a1);
            float mx = a1;
            mx = fmaxf(mx, lane_xor1(mx)); mx = fmaxf(mx, lane_xor2(mx)); mx = fmaxf(mx, lane_xor4(mx)); mx = fmaxf(mx, lane_xor8(mx));
            const float ex = expf(a1 - mx); float den = ex;
            den = row16_sum(den);
            const int eidx = ((c.lane & 1) << 3) | ((c.lane & 2) << 1) | ((c.lane & 4) >> 1) | ((c.lane & 8) >> 3);
            if (c.lane < 16) WSP(float, WS_AFF)[(size_t)m * 16 + eidx] = ex / den;
        }
#undef POST_LOADROW
    }
    __syncthreads();
}

__device__ __forceinline__ void ph_topk_gather(const Ctx& c, int nlat_tasks, int nctx_lists) {
    LAS unsigned* keys = (LAS unsigned*)c.lds;
    LAS int* hist = (LAS int*)(c.lds + 32768);
    LAS int* cg = (LAS int*)(c.lds + 32768 + 1024);
    LAS int* ce = cg + 512;
    LAS unsigned* ctl = (LAS unsigned*)(ce + 512);
    LAS int* slot_tok = (LAS int*)(c.lds + 40960);
    const float* aff = WSP(float, WS_AFF); int* inv = WSP(int, WS_INV); int* rowtok = WSP(int, WS_ROWTOK);
    for (int task = blockIdx.x; task < nlat_tasks + nctx_lists; task += c.G) {
        int n, cap, tok0, rowbase, e, part, nparts;
        if (task < nlat_tasks) { const int lid = task >> 3; part = task & 7; nparts = 8; const int b = lid >> 4; e = lid & 15; n = SEQ; cap = 1024; tok0 = b * SEQ; rowbase = e * 2048 + b * 1024; }
        else { const int lid = task - nlat_tasks; part = 0; nparts = 1; const int b = lid >> 4; e = lid & 15; n = CTXL; cap = 32; tok0 = NLAT + b * CTXL; rowbase = MOE_LAT + e * 256 + b * 32; }
        const int cpt = n / 512 > 0 ? n / 512 : 1;
        for (int i = c.tid; i < n; i += 512) keys[i] = __builtin_bit_cast(unsigned, aff[(size_t)(tok0 + i) * 16 + e]);
        if (n <= 512) {
            __syncthreads();
            if (c.tid < n) { const unsigned key = keys[c.tid]; int rank = 0;
                for (int j = 0; j < n; ++j) { const unsigned kj = keys[j]; rank += (kj > key || (kj == key && j < c.tid)) ? 1 : 0; }
                const int slot = rank < cap ? rank : -1;
                if (slot >= 0) slot_tok[slot] = tok0 + c.tid;
                inv[(size_t)(tok0 + c.tid) * 16 + e] = slot >= 0 ? rowbase + slot : -1; if (slot >= 0) rowtok[rowbase + slot] = tok0 + c.tid; }
        } else {
        if (c.tid == 0) { ctl[0] = 0u; ctl[1] = (unsigned)cap; }
        __syncthreads();
        for (int pass = 0; pass < 4; ++pass) {
            const int shift = 24 - 8 * pass;
            if (c.tid < 256) hist[c.tid] = 0;
            __syncthreads();
            const unsigned prefix = ctl[0];
            for (int i = c.tid; i < n; i += 512) { const unsigned k = keys[i]; if (pass == 0 || (k >> (shift + 8)) == prefix) __hip_atomic_fetch_add(&hist[(k >> shift) & 255u], 1, __ATOMIC_RELAXED, __HIP_MEMORY_SCOPE_WORKGROUP); }
            __syncthreads();
            if (c.wave == 0) {
                const int kth = (int)ctl[1];
                const int h0 = hist[4 * c.lane], h1 = hist[4 * c.lane + 1], h2 = hist[4 * c.lane + 2], h3 = hist[4 * c.lane + 3];
                const int mine = h0 + h1 + h2 + h3;
                int suf = mine;
#pragma unroll
                for (int o = 1; o < 64; o <<= 1) { const int t = __shfl_down(suf, o); if (c.lane + o < 64) suf += t; }
                const int above = suf - mine;
                if (above < kth && suf >= kth) {
                    int cum = above, sel, rem;
                    if (cum + h3 >= kth) { sel = 3; rem = kth - cum; } else { cum += h3;
                    if (cum + h2 >= kth) { sel = 2; rem = kth - cum; } else { cum += h2;
                    if (cum + h1 >= kth) { sel = 1; rem = kth - cum; } else { cum += h1; sel = 0; rem = kth - cum; } } }
                    ctl[0] = (prefix << 8) | (unsigned)(4 * c.lane + sel); ctl[1] = (unsigned)rem; }
            }
            __syncthreads();
        }
        const unsigned T = ctl[0]; const int need_eq = (int)ctl[1]; const int ngt = cap - need_eq;
        { int g = 0, q = 0;
          for (int j = 0; j < cpt; ++j) { const int i = c.tid * cpt + j; if (i < n) { const unsigned k = keys[i]; g += (k > T); q += (k == T); } }
          cg[c.tid] = g; ce[c.tid] = q; }
        __syncthreads();
        if (c.wave == 0) {
            int g[8], q[8], sg = 0, sq = 0;
#pragma unroll
            for (int j = 0; j < 8; ++j) { g[j] = cg[c.lane * 8 + j]; q[j] = ce[c.lane * 8 + j]; sg += g[j]; sq += q[j]; }
            int ig = sg, iq = sq;
#pragma unroll
            for (int o = 1; o < 64; o <<= 1) { const int tg = __shfl_up(ig, o), tq = __shfl_up(iq, o); if (c.lane >= o) { ig += tg; iq += tq; } }
            int eg = ig - sg, eq = iq - sq;
#pragma unroll
            for (int j = 0; j < 8; ++j) { cg[c.lane * 8 + j] = eg; ce[c.lane * 8 + j] = eq; eg += g[j]; eq += q[j]; }
        }
        __syncthreads();
        { int g = cg[c.tid], q = ce[c.tid];
          for (int j = 0; j < cpt; ++j) { const int i = c.tid * cpt + j; if (i < n) { const unsigned k = keys[i]; int slot = -1;
              if (k > T) { slot = g; ++g; } else if (k == T) { if (q < need_eq) slot = ngt + q; ++q; }
              if (slot >= 0) slot_tok[slot] = tok0 + i;
              if ((i * nparts) / n == part) { inv[(size_t)(tok0 + i) * 16 + e] = slot >= 0 ? rowbase + slot : -1; if (slot >= 0) rowtok[rowbase + slot] = tok0 + i; } } } }
        }
        __syncthreads();
        { const int per = cap / nparts, s0 = part * per;
          for (int base = s0 + c.wave; base < s0 + per; base += NWAVES * 8) { v4u vals[8]; int sls[8];
#pragma unroll
              for (int u = 0; u < 8; ++u) { const int sl = base + NWAVES * u; sls[u] = sl; if (sl < s0 + per) { const int tok = slot_tok[sl]; vals[u] = ((const v4u*)(WSP(unsigned char, WS_XN2) + (size_t)tok * 1024))[c.lane]; } }
#pragma unroll
              for (int u = 0; u < 8; ++u) if (sls[u] < s0 + per) ((v4u*)(WSP(unsigned char, WS_XG) + (size_t)(rowbase + sls[u]) * 1024))[c.lane] = vals[u]; } }
        if (task >= nlat_tasks && task < nlat_tasks + 16) {
            for (int i = 64 + c.wave; i < 256; i += NWAVES) { ((v4u*)(WSP(unsigned char, WS_XG) + (size_t)(MOE_LAT + e * 256 + i) * 1024))[c.lane] = (v4u){0u, 0u, 0u, 0u}; if (c.lane == 0) rowtok[MOE_LAT + e * 256 + i] = -1; } }
        __syncthreads();
    }
}

__device__ __forceinline__ void ph_combine(const Ctx& c, int layer, int nrows) {
    const float* ng = c.a->in[I_NORMG] + (size_t)layer * 4 * 1024;
    const int per = (nrows + c.ngw - 1) / c.ngw, m0 = c.gw * per, m1 = min(m0 + per, nrows);
    const unsigned ln = (unsigned)c.lane;
    if (m0 < m1) {
        int scur = -1;
        f32x4 G3[2][2], M5[2][2], GN[2][2], MS[2][2], MH[2][2];
        int inv_n; float aff_n; f32x4 x1n[2][2];
#define CMB_LOADROW(M) do { inv_n = ln < 16u ? WSP(int, WS_INV)[(size_t)(M) * 16 + ln] : -1; aff_n = ln < 16u ? WSP(float, WS_AFF)[(size_t)(M) * 16 + ln] : 0.f; \
            const f32x4* xr_ = (const f32x4*)(WSP(float, WS_X1) + (size_t)(M) * 1024); _Pragma("unroll") for (int j = 0; j < 2; ++j) { x1n[j][0] = xr_[2u * ln + 128u * j]; x1n[j][1] = xr_[2u * ln + 128u * j + 1u]; } } while (0)
        CMB_LOADROW(m0);
        for (int m = m0; m < m1; ++m) {
            const int s = m < NLAT ? m / SEQ : 2;
            if (s != scur) { scur = s; const f32x4* mod4 = (const f32x4*)(WSP(float, WS_MOD) + (size_t)(layer * 3 + s) * 6144); const f32x4* g34 = (const f32x4*)(ng + 3 * 1024);
                const f32x4* gn4 = (const f32x4*)(c.a->in[I_NORMG] + (size_t)4 * 1024); const f32x4* mn4 = (const f32x4*)(WSP(float, WS_MOD) + (size_t)(3 + s) * 6144);
#pragma unroll
                for (int j = 0; j < 2; ++j)
#pragma unroll
                    for (int hh = 0; hh < 2; ++hh) { const unsigned idx = 2u * ln + 128u * j + hh; G3[j][hh] = g34[idx]; M5[j][hh] = (mod4 + 1280)[idx];
                        if (layer == 0) { GN[j][hh] = gn4[idx]; MS[j][hh] = (mn4 + 256)[idx] + 1.0f; MH[j][hh] = mn4[idx]; } } }
            const int myinv = inv_n; const float myaff = aff_n; f32x4 x1c[2][2];
#pragma unroll
            for (int j = 0; j < 2; ++j) { x1c[j][0] = x1n[j][0]; x1c[j][1] = x1n[j][1]; }
            if (m + 1 < m1) CMB_LOADROW(m + 1);
            float f[16];
#pragma unroll
            for (int i = 0; i < 16; ++i) f[i] = 0.f;
            unsigned long long mask = __ballot(myinv >= 0);
            while (mask) {
                int rows[4]; float as[4]; v4u v[4][2];
#pragma unroll
                for (int u = 0; u < 4; ++u) { rows[u] = -1; as[u] = 0.f;
                    if (mask) { const int e = __builtin_ctzll(mask); mask &= mask - 1; rows[u] = __shfl(myinv, e); as[u] = __shfl(myaff, e); } }
#pragma unroll
                for (int u = 0; u < 4; ++u) if (rows[u] >= 0) { const v4u* src = (const v4u*)(WSP(bf16, WS_Y) + (size_t)rows[u] * 1024); v[u][0] = __builtin_nontemporal_load(src + ln); v[u][1] = __builtin_nontemporal_load(src + ln + 64u); }
#pragma unroll
                for (int u = 0; u < 4; ++u) if (rows[u] >= 0) { const float a = as[u];
#pragma unroll
                    for (int j = 0; j < 2; ++j) { const v4u w = v[u][j];
                        f[8 * j + 0] += a * bflo(w.x); f[8 * j + 1] += a * bfhi(w.x); f[8 * j + 2] += a * bflo(w.y); f[8 * j + 3] += a * bfhi(w.y);
                        f[8 * j + 4] += a * bflo(w.z); f[8 * j + 5] += a * bfhi(w.z); f[8 * j + 6] += a * bflo(w.w); f[8 * j + 7] += a * bfhi(w.w); } }
            }
            float ss = 0.f;
#pragma unroll
            for (int i = 0; i < 16; ++i) ss += f[i] * f[i];
            const float rf = 1.0f / sqrtf(wave_sum(ss) * (1.0f / 1024.0f) + EPS);
            f32x4 x[2][2]; float s2 = 0.f;
#pragma unroll
            for (int j = 0; j < 2; ++j)
#pragma unroll
                for (int hh = 0; hh < 2; ++hh) { const f32x4 fv = (f32x4){f[8 * j + 4 * hh], f[8 * j + 4 * hh + 1], f[8 * j + 4 * hh + 2], f[8 * j + 4 * hh + 3]};
                    x[j][hh] = x1c[j][hh] + M5[j][hh] * (fv * rf * G3[j][hh]); s2 += (x[j][hh][0] * x[j][hh][0] + x[j][hh][1] * x[j][hh][1]) + (x[j][hh][2] * x[j][hh][2] + x[j][hh][3] * x[j][hh][3]); }
            if (layer == 0) {
                const float r2 = 1.0f / sqrtf(wave_sum(s2) * (1.0f / 1024.0f) + EPS);
                f32x4* x1r = (f32x4*)(WSP(float, WS_X1) + (size_t)m * 1024); v4u* ho = (v4u*)(WSP(bf16, WS_H) + (size_t)m * 1024);
#pragma unroll
                for (int j = 0; j < 2; ++j) { x1r[2u * ln + 128u * j] = x[j][0]; x1r[2u * ln + 128u * j + 1u] = x[j][1];
                    const f32x4 o0 = x[j][0] * r2 * GN[j][0] * MS[j][0] + MH[j][0], o1 = x[j][1] * r2 * GN[j][1] * MS[j][1] + MH[j][1];
                    v4u pk; pk.x = pk2(o0[0], o0[1]); pk.y = pk2(o0[2], o0[3]); pk.z = pk2(o1[0], o1[1]); pk.w = pk2(o1[2], o1[3]); ho[ln + 64u * j] = pk; }
            } else {
                f32x4* orow = (f32x4*)(c.out + (size_t)m * 1024);
#pragma unroll
                for (int j = 0; j < 2; ++j) { orow[2u * ln + 128u * j] = x[j][0]; orow[2u * ln + 128u * j + 1u] = x[j][1]; }
            }
        }
#undef CMB_LOADROW
    }
}

__device__ __forceinline__ void ph_prep_odd(const Ctx& c) {
    const bf16* P = WSP(bf16, WS_PBUF);
    for (int it = blockIdx.x * 512 + c.tid; it < NLAT * 64; it += c.G * 512) {
        const int m = it >> 6, c8 = (it & 63) * 8, t = m & (SEQ - 1), b0 = m - t;
        const int win = 2 << (c8 >> 7), lo = max(t - win / 2, 0), hi = min(t + win / 2, SEQ);
        float sum[8];
#pragma unroll
        for (int j = 0; j < 8; ++j) sum[j] = 0.f;
        for (int tt = lo; tt < hi; ++tt) { const v4u a = *(const v4u*)(P + (size_t)(b0 + tt) * 2048 + c8);
            sum[0] += bflo(a.x); sum[1] += bfhi(a.x); sum[2] += bflo(a.y); sum[3] += bfhi(a.y); sum[4] += bflo(a.z); sum[5] += bfhi(a.z); sum[6] += bflo(a.w); sum[7] += bfhi(a.w); }
        const v4u a = *(const v4u*)(P + (size_t)m * 2048 + c8); const float inv = 1.0f / (float)(hi - lo);
        v4u o; o.x = pk2(sum[0] * inv - bflo(a.x), sum[1] * inv - bfhi(a.x)); o.y = pk2(sum[2] * inv - bflo(a.y), sum[3] * inv - bfhi(a.y));
        o.z = pk2(sum[4] * inv - bflo(a.z), sum[5] * inv - bfhi(a.z)); o.w = pk2(sum[6] * inv - bflo(a.w), sum[7] * inv - bfhi(a.w));
        *(v4u*)(WSP(bf16, WS_DPOOL) + (size_t)m * 512 + c8) = o;
    }
    const int hd = c.tid & 255, d = hd & 63;
    float gw0[16], gw1[16];
#pragma unroll
    for (int r = 0; r < 16; ++r) { gw0[r] = c.a->in[I_GATEW][r * 256 + hd]; gw1[r] = c.a->in[I_GATEW][(16 + r) * 256 + hd]; }
    const float gb0 = c.a->in[I_GATEB][hd], gb1 = c.a->in[I_GATEB][256 + hd];
    const float* rope = WSP(float, WS_ROPE);
    for (int m = blockIdx.x * 2 + (c.tid >> 8); m < NTOK; m += c.G * 2) {
        const float* lr = WSP(float, WS_LR) + (size_t)m * 32;
        float z0 = gb0, z1 = gb1;
#pragma unroll
        for (int r = 0; r < 16; ++r) { z0 += lr[r] * gw0[r]; z1 += lr[16 + r] * gw1[r]; }
        const float l0 = fminf(z0, 0.f) - log1pf(expf(-fabsf(z0))), l1 = fminf(z1, 0.f) - log1pf(expf(-fabsf(z1)));
        WSP(float, WS_GF)[(size_t)m * 256 + hd] = l0 * (1.0f / 16.0f); WSP(float, WS_GB)[(size_t)m * 256 + hd] = l1 * (1.0f / 16.0f);
        const bf16* pr = P + (size_t)m * 2048;
        if (m < NLAT) {
            const int t = m & (SEQ - 1), pos = (d & 32) ? 128 + (t & 63) : (t >> 6), f = d & 15;
            const float cs = rope[(pos * 16 + f) * 2], sn = rope[(pos * 16 + f) * 2 + 1];
            const int d1 = hd & ~16, d2 = hd | 16;
            const float q1 = bf2f(pr[512 + d1]), q2 = bf2f(pr[512 + d2]), k1 = bf2f(pr[768 + d1]), k2 = bf2f(pr[768 + d2]);
            const bool second = (d & 16) != 0;
            WSP(float, WS_QR)[(size_t)m * 256 + hd] = (second ? q1 * sn + q2 * cs : q1 * cs - q2 * sn) * 0.125f;
            WSP(float, WS_KR)[(size_t)m * 256 + hd] = second ? k1 * sn + k2 * cs : k1 * cs - k2 * sn;
        } else WSP(float, WS_KR)[(size_t)m * 256 + hd] = bf2f(pr[768 + hd]);
    }
}

__device__ __forceinline__ void ph_gla_naive(const Ctx& c) {
    const bf16* P = WSP(bf16, WS_PBUF);
    for (int item = blockIdx.x; item < 256; item += c.G) {
        const int es = item & 15, dir = (item >> 4) & 1, h = (item >> 5) & 3, b = item >> 7;
        const int e = es * 8 + c.wave, d = c.lane;
        const float* G = dir ? WSP(float, WS_GB) : WSP(float, WS_GF);
        float* O = WSP(float, WS_OACC) + (size_t)dir * NLAT * 512;
        float S = 0.f;
        for (int blk = 0; blk < (CTXL + SEQ) / 8; ++blk) {
            float gg[8], kk[8], vv[8], qq[8]; int mm[8];
#pragma unroll
            for (int j = 0; j < 8; ++j) { const int step = blk * 8 + j; int m;
                if (step < CTXL) m = NLAT + b * CTXL + (dir ? CTXL - 1 - step : step); else { const int t = step - CTXL; m = b * SEQ + (dir ? SEQ - 1 - t : t); }
                mm[j] = m; gg[j] = G[(size_t)m * 256 + h * 64 + d]; kk[j] = WSP(float, WS_KR)[(size_t)m * 256 + h * 64 + d]; vv[j] = bf2f(P[(size_t)m * 2048 + 1024 + h * 128 + e]);
                qq[j] = m < NLAT ? WSP(float, WS_QR)[(size_t)m * 256 + h * 64 + d] : 0.f; }
#pragma unroll
            for (int j = 0; j < 8; ++j) { S = expf(gg[j]) * S + kk[j] * vv[j];
                if (blk >= CTXL / 8) { const float o = wave_sum(qq[j] * S); if (c.lane == 0) O[(size_t)mm[j] * 512 + h * 128 + e] = o; } }
        }
    }
}
__device__ __forceinline__ void ph_gla_out(const Ctx& c) {
    for (int m = c.gw; m < NLAT; m += c.ngw) {
        const float* o0 = WSP(float, WS_OACC) + (size_t)m * 512 + 8 * c.lane; const float* o1 = o0 + (size_t)NLAT * 512;
        float o[8]; float ss = 0.f;
#pragma unroll
        for (int j = 0; j < 8; ++j) { o[j] = o0[j] + o1[j]; ss += o[j] * o[j]; }
        ss = row16_sum(ss);
        const float rn = 1.0f / sqrtf(ss * (1.0f / 128.0f) + EPS);
        const v4u rr = *(const v4u*)(WSP(bf16, WS_PBUF) + (size_t)m * 2048 + 1536 + 8 * c.lane);
        const float r[8] = {bflo(rr.x), bfhi(rr.x), bflo(rr.y), bfhi(rr.y), bflo(rr.z), bfhi(rr.z), bflo(rr.w), bfhi(rr.w)};
        float v[8];
#pragma unroll
        for (int j = 0; j < 8; ++j) v[j] = o[j] * rn * c.a->in[I_HEADG][8 * c.lane + j] * silu(r[j]);
        v4u pk; pk.x = pk2(v[0], v[1]); pk.y = pk2(v[2], v[3]); pk.z = pk2(v[4], v[5]); pk.w = pk2(v[6], v[7]);
        *(v4u*)(WSP(bf16, WS_MIX) + (size_t)m * 1024 + 512 + 8 * c.lane) = pk;
    }
}

constexpr int GP = 72, GVP = 136;
typedef short s16x4_t __attribute__((ext_vector_type(4)));
constexpr int GP_unused = 0;
__device__ __forceinline__ bf16x8 mk8(v2u lo, v2u hi) { v4u t; t.x = lo.x; t.y = lo.y; t.z = hi.x; t.w = hi.y; return __builtin_bit_cast(bf16x8, t); }

__device__ __forceinline__ float logsig16(float z) { return (fminf(z, 0.f) - __logf(1.0f + __expf(-fabsf(z)))) * (1.0f / 16.0f); }
__device__ __forceinline__ void ph_gla_g1(const Ctx& c) {
    LAS bf16* keT = (LAS bf16*)c.lds;
    LAS bf16* vL = keT + 2 * 64 * GP;
    LAS float* tot = (LAS float*)(vL + 64 * GVP);
    LAS float* lrL = tot + 2 * 8 * 64;
    LAS bf16* kL = (LAS bf16*)(lrL + 64 * 32);
    LAS bf16* qL = kL + 64 * 64;
    LAS bf16* qkL = qL + 64 * 64;
    const bf16* P = WSP(bf16, WS_PBUF);
    const float* rope = WSP(float, WS_ROPE);
    const int d = c.tid & 63, tg = c.tid >> 6, q = c.lane >> 4, l15 = c.lane & 15;
    const int d1 = d & ~16, d2 = d | 16, fi = d & 15; const bool second = (d & 16) != 0, colhalf = (d & 32) != 0;
    for (int item = blockIdx.x; item < 2 * 4 * 132; item += c.G) {
        const int cidx = item % 132, h = (item / 132) & 3, b = item / (132 * 4);
        const bool lat = cidx >= 4;
        const int m0 = lat ? b * SEQ + 64 * (cidx - 4) : NLAT + b * CTXL + 64 * cidx;
        { const f32x4* src = (const f32x4*)(WSP(float, WS_LR) + (size_t)m0 * 32); ((LAS f32x4*)lrL)[c.tid] = src[c.tid];
          const int row = c.tid >> 3, ch = c.tid & 7; const bf16* pr = P + (size_t)(m0 + row) * 2048 + h * 64 + 8 * ch;
          *(LAS v4u*)(kL + row * 64 + 8 * ch) = *(const v4u*)(pr + 768); if (lat) *(LAS v4u*)(qL + row * 64 + 8 * ch) = *(const v4u*)(pr + 512);
#pragma unroll
          for (int r2 = 0; r2 < 2; ++r2) { const int id = c.tid + 512 * r2, vr = id >> 4, vc = id & 15; *(LAS v4u*)(vL + vr * GVP + 8 * vc) = *(const v4u*)(P + (size_t)(m0 + vr) * 2048 + 1024 + h * 128 + 8 * vc); } }
        float gw0[16], gw1[16];
#pragma unroll
        for (int r = 0; r < 16; ++r) { gw0[r] = c.a->in[I_GATEW][r * 256 + h * 64 + d]; gw1[r] = c.a->in[I_GATEW][(16 + r) * 256 + h * 64 + d]; }
        const float gb0 = c.a->in[I_GATEB][h * 64 + d], gb1 = c.a->in[I_GATEB][256 + h * 64 + d];
        float csr = 1.f, snr = 0.f; if (lat && !colhalf) { csr = rope[((cidx - 4) * 16 + fi) * 2]; snr = rope[((cidx - 4) * 16 + fi) * 2 + 1]; }
        __syncthreads();
        float pf[8], pb[8];
#pragma unroll
        for (int j = 0; j < 8; ++j) { const LAS float* lr = lrL + (8 * tg + j) * 32; float z0 = gb0, z1 = gb1;
#pragma unroll
            for (int r = 0; r < 16; ++r) { z0 += lr[r] * gw0[r]; z1 += lr[16 + r] * gw1[r]; }
            pf[j] = logsig16(z0); pb[j] = logsig16(z1); }
#pragma unroll
        for (int j = 1; j < 8; ++j) pf[j] += pf[j - 1];
#pragma unroll
        for (int j = 6; j >= 0; --j) pb[j] += pb[j + 1];
        tot[(0 * 8 + tg) * 64 + d] = pf[7]; tot[(1 * 8 + tg) * 64 + d] = pb[0];
        __syncthreads();
        float offf = 0.f, offb = 0.f, Bf = 0.f, Bb = 0.f;
#pragma unroll
        for (int g = 0; g < 8; ++g) { const float tf = tot[g * 64 + d], tb = tot[(8 + g) * 64 + d]; Bf += tf; Bb += tb; offf += g < tg ? tf : 0.f; offb += g > tg ? tb : 0.f; }
        float kef[8], keb[8];
#pragma unroll
        for (int j = 0; j < 8; ++j) { const int tj = 8 * tg + j; const float bfj = offf + pf[j], bbj = offb + pb[j];
            float kv, qv = 0.f;
            if (lat) { float cs = csr, sn = snr; if (colhalf) { cs = rope[((128 + tj) * 16 + fi) * 2]; sn = rope[((128 + tj) * 16 + fi) * 2 + 1]; }
                const float k1 = bf2f(kL[tj * 64 + d1]), k2 = bf2f(kL[tj * 64 + d2]), q1 = bf2f(qL[tj * 64 + d1]), q2 = bf2f(qL[tj * 64 + d2]);
                kv = second ? k1 * sn + k2 * cs : k1 * cs - k2 * sn; qv = (second ? q1 * sn + q2 * cs : q1 * cs - q2 * sn) * 0.125f; }
            else kv = bf2f(kL[tj * 64 + d]);
            kef[j] = kv * __expf(Bf - bfj); keb[j] = kv * __expf(Bb - bbj);
            if (lat) { qkL[(0 * 64 + tj) * 64 + d] = (bf16)f2bf(qv * __expf(bfj)); qkL[(1 * 64 + tj) * 64 + d] = (bf16)f2bf(kv * __expf(-bfj));
                qkL[(2 * 64 + tj) * 64 + d] = (bf16)f2bf(qv * __expf(bbj)); qkL[(3 * 64 + tj) * 64 + d] = (bf16)f2bf(kv * __expf(-bbj)); } }
        { v4u w; w.x = pk2(kef[0], kef[1]); w.y = pk2(kef[2], kef[3]); w.z = pk2(kef[4], kef[5]); w.w = pk2(kef[6], kef[7]); *(LAS v4u*)(keT + (size_t)d * GP + 8 * tg) = w;
          w.x = pk2(keb[0], keb[1]); w.y = pk2(keb[2], keb[3]); w.z = pk2(keb[4], keb[5]); w.w = pk2(keb[6], keb[7]); *(LAS v4u*)(keT + (size_t)(64 + d) * GP + 8 * tg) = w; }
        if (tg == 0) { float* DCp = WSP(float, WS_DC);
            DCp[((size_t)(0 * 8 + b * 4 + h) * 132 + cidx) * 64 + d] = __expf(Bf); DCp[((size_t)(1 * 8 + b * 4 + h) * 132 + cidx) * 64 + d] = __expf(Bb); }
        __syncthreads();
        if (lat) {
#pragma unroll
            for (int r2 = 0; r2 < 4; ++r2) { const int id = c.tid + 512 * r2, arr = id >> 9, row = (id >> 3) & 63, ch = id & 7;
                bf16* dst = ((arr & 1) ? WSP(bf16, WS_KD) : WSP(bf16, WS_QE)) + (size_t)(arr >> 1) * NLAT * 256 + (size_t)(m0 + row) * 256 + h * 64 + 8 * ch;
                *(v4u*)dst = *(const LAS v4u*)(qkL + (arr * 64 + row) * 64 + 8 * ch); } }
        { const LAS bf16* vb = vL + (size_t)(8 * q + (l15 >> 2)) * GVP + 16 * c.wave + 4 * (l15 & 3);
          const bf16x8 av0 = mk8(__builtin_bit_cast(v2u, __builtin_amdgcn_ds_read_tr16_b64_v4i16((LAS s16x4_t*)vb)), __builtin_bit_cast(v2u, __builtin_amdgcn_ds_read_tr16_b64_v4i16((LAS s16x4_t*)(vb + 4 * GVP))));
          const bf16x8 av1 = mk8(__builtin_bit_cast(v2u, __builtin_amdgcn_ds_read_tr16_b64_v4i16((LAS s16x4_t*)(vb + 32 * GVP))), __builtin_bit_cast(v2u, __builtin_amdgcn_ds_read_tr16_b64_v4i16((LAS s16x4_t*)(vb + 36 * GVP))));
#pragma unroll
          for (int dir = 0; dir < 2; ++dir)
#pragma unroll
            for (int dt = 0; dt < 4; ++dt) {
                const bf16x8 b0 = *(const LAS bf16x8*)(keT + (size_t)(dir * 64 + 16 * dt + l15) * GP + 8 * q), b1 = *(const LAS bf16x8*)(keT + (size_t)(dir * 64 + 16 * dt + l15) * GP + 32 + 8 * q);
                f32x4 acc = {0.f, 0.f, 0.f, 0.f};
                acc = __builtin_amdgcn_mfma_f32_16x16x32_bf16(av0, b0, acc, 0, 0, 0); acc = __builtin_amdgcn_mfma_f32_16x16x32_bf16(av1, b1, acc, 0, 0, 0);
                float* U = WSP(float, WS_UT) + ((size_t)(dir * 8 + b * 4 + h) * 132 + cidx) * 8192 + (size_t)(16 * c.wave + 4 * q) * 64 + 16 * dt + l15;
#pragma unroll
                for (int r = 0; r < 4; ++r) U[r * 64] = acc[r]; } }
        __syncthreads();
    }
}

constexpr int PP = 520;
__device__ __forceinline__ void ph_pool(const Ctx& c) {
    LAS bf16* uL = (LAS bf16*)c.lds;
    const bf16* P = WSP(bf16, WS_PBUF);
    const int q = c.lane >> 4, l15 = c.lane & 15;
    for (int item = blockIdx.x; item < NLAT / 64; item += c.G) {
        const int mbase = item * 64, tb = mbase & (SEQ - 1);
        for (int i = c.tid; i < 80 * 64; i += 512) { const int r = i >> 6, c8 = (i & 63) * 8, t = tb - 8 + r;
            v4u a = {0u, 0u, 0u, 0u}; if (t >= 0 && t < SEQ) a = *(const v4u*)(P + (size_t)(mbase - 8 + r) * 2048 + c8);
            *(LAS v4u*)(uL + r * PP + c8) = a; }
        __syncthreads();
        v4u dv[8];
#pragma unroll
        for (int i = 0; i < 8; ++i) { const int id = c.tid + 512 * i, tt = id >> 6, c8 = (id & 63) * 8, t = tb + tt;
            const int hw = 1 << (c8 >> 7), lo = max(t - hw, 0), hi = min(t + hw, SEQ);
            float sum[8];
#pragma unroll
            for (int j = 0; j < 8; ++j) sum[j] = 0.f;
            for (int u = -hw; u < hw; ++u) { const v4u a = *(const LAS v4u*)(uL + (tt + 8 + u) * PP + c8);
                sum[0] += bflo(a.x); sum[1] += bfhi(a.x); sum[2] += bflo(a.y); sum[3] += bfhi(a.y); sum[4] += bflo(a.z); sum[5] += bfhi(a.z); sum[6] += bflo(a.w); sum[7] += bfhi(a.w); }
            const v4u a = *(const LAS v4u*)(uL + (tt + 8) * PP + c8); const float inv = 1.0f / (float)(hi - lo);
            dv[i].x = pk2(sum[0] * inv - bflo(a.x), sum[1] * inv - bfhi(a.x)); dv[i].y = pk2(sum[2] * inv - bflo(a.y), sum[3] * inv - bfhi(a.y));
            dv[i].z = pk2(sum[4] * inv - bflo(a.z), sum[5] * inv - bfhi(a.z)); dv[i].w = pk2(sum[6] * inv - bflo(a.w), sum[7] * inv - bfhi(a.w)); }
        __syncthreads();
#pragma unroll
        for (int i = 0; i < 8; ++i) { const int id = c.tid + 512 * i, tt = id >> 6, c8 = (id & 63) * 8; *(LAS v4u*)(uL + (tt + 8) * PP + c8) = dv[i]; }
        __syncthreads();
        for (int i = 0; i < 16; ++i) { const int tl = c.wave + 8 * i, mt = tl >> 5, g = (tl >> 3) & 3, et = tl & 7;
            const LAS bf16* ap = uL + (8 + 16 * mt + l15) * PP + g * 128 + 8 * q; const bf16* bp = WSP(bf16, WS_POOLW) + (size_t)g * 128 * 128 + (size_t)(16 * et + l15) * 128 + 8 * q;
            f32x4 acc = {0.f, 0.f, 0.f, 0.f};
#pragma unroll
            for (int ks = 0; ks < 4; ++ks) acc = __builtin_amdgcn_mfma_f32_16x16x32_bf16(*(const bf16x8*)(bp + 32 * ks), *(const LAS bf16x8*)(ap + 32 * ks), acc, 0, 0, 0);
            const int col = g * 128 + 16 * et + 4 * q; const float* sc = c.a->in[I_POOLS] + col;
            v2u pk; pk.x = pk2(acc[0] * sc[0], acc[1] * sc[1]); pk.y = pk2(acc[2] * sc[2], acc[3] * sc[3]);
            *(v2u*)(WSP(bf16, WS_MIX) + (size_t)(mbase + 16 * mt + l15) * 1024 + col) = pk; }
        __syncthreads();
    }
}

__device__ __forceinline__ void ph_gla_g2(const Ctx& c) {
    for (int el = blockIdx.x * 512 + c.tid; el < 16 * 8192; el += c.G * 512) {
        const int combo = el >> 13, ed = el & 8191, d = ed & 63, dir = combo >> 3;
        const float* U = WSP(float, WS_UT) + (size_t)combo * 132 * 8192 + ed; const float* Dp = WSP(float, WS_DC) + (size_t)combo * 132 * 64 + d;
        bf16* So = WSP(bf16, WS_ST) + (size_t)combo * 128 * 8192 + ed;
        float S = 0.f;
        for (int s4 = 0; s4 < 132; s4 += 4) {
            float u[4], dd[4]; int ci[4];
#pragma unroll
            for (int j = 0; j < 4; ++j) { const int step = s4 + j; ci[j] = dir == 0 ? step : (step < 4 ? 3 - step : 135 - step); u[j] = __builtin_nontemporal_load(U + (size_t)ci[j] * 8192); dd[j] = Dp[ci[j] * 64]; }
#pragma unroll
            for (int j = 0; j < 4; ++j) { if (ci[j] >= 4) So[(size_t)(ci[j] - 4) * 8192] = (bf16)f2bf(S); S = dd[j] * S + u[j]; }
        }
    }
}

__device__ __forceinline__ void ph_gla_g3(const Ctx& c) {
    LAS bf16* qe = (LAS bf16*)c.lds;
    LAS bf16* kd = qe + 2 * 64 * GP;
    LAS bf16* vL = kd + 2 * 64 * GP;
    LAS bf16* STl = vL + 64 * GVP;
    LAS float* ssq = (LAS float*)(STl + 2 * 128 * GP);
    const bf16* P = WSP(bf16, WS_PBUF);
    const int q = c.lane >> 4, l15 = c.lane & 15, it = c.wave & 3, eh = c.wave >> 2;
    for (int item = blockIdx.x; item < 2 * 4 * 128; item += c.G) {
        const int lc = item & 127, h = (item >> 7) & 3, b = item >> 9, m0 = b * SEQ + 64 * lc;
        { const int row = c.tid >> 3, ch = c.tid & 7;
#pragma unroll
          for (int dir = 0; dir < 2; ++dir) { const size_t o = ((size_t)dir * NLAT + m0 + row) * 256 + h * 64 + 8 * ch;
              *(LAS v4u*)(qe + (size_t)(dir * 64 + row) * GP + 8 * ch) = *(const v4u*)(WSP(bf16, WS_QE) + o); *(LAS v4u*)(kd + (size_t)(dir * 64 + row) * GP + 8 * ch) = *(const v4u*)(WSP(bf16, WS_KD) + o); }
#pragma unroll
          for (int dir = 0; dir < 2; ++dir)
#pragma unroll
            for (int r = 0; r < 2; ++r) { const int id = c.tid + 512 * r, e = id >> 3, ch8 = id & 7;
                *(LAS v4u*)(STl + (size_t)(dir * 128 + e) * GP + 8 * ch8) = *(const v4u*)(WSP(bf16, WS_ST) + ((size_t)(dir * 8 + b * 4 + h) * 128 + lc) * 8192 + e * 64 + 8 * ch8); } }
#pragma unroll
        for (int r2 = 0; r2 < 2; ++r2) { const int id = c.tid + 512 * r2, vr = id >> 4, vc = id & 15; *(LAS v4u*)(vL + vr * GVP + 8 * vc) = *(const v4u*)(P + (size_t)(m0 + vr) * 2048 + 1024 + h * 128 + 8 * vc); }
        __syncthreads();
        f32x4 acc[4];
#pragma unroll
        for (int nt = 0; nt < 4; ++nt) acc[nt] = (f32x4){0.f, 0.f, 0.f, 0.f};
        const int iq = 16 * it + l15;
#pragma unroll
        for (int dir = 0; dir < 2; ++dir) {
            const bf16x8 bq0 = *(const LAS bf16x8*)(qe + (size_t)(dir * 64 + iq) * GP + 8 * q), bq1 = *(const LAS bf16x8*)(qe + (size_t)(dir * 64 + iq) * GP + 32 + 8 * q);
            f32x4 s[4];
#pragma unroll
            for (int jt = 0; jt < 4; ++jt) {
                const bf16x8 a0 = *(const LAS bf16x8*)(kd + (size_t)(dir * 64 + 16 * jt + l15) * GP + 8 * q), a1 = *(const LAS bf16x8*)(kd + (size_t)(dir * 64 + 16 * jt + l15) * GP + 32 + 8 * q);
                f32x4 t = {0.f, 0.f, 0.f, 0.f};
                t = __builtin_amdgcn_mfma_f32_16x16x32_bf16(a0, bq0, t, 0, 0, 0); t = __builtin_amdgcn_mfma_f32_16x16x32_bf16(a1, bq1, t, 0, 0, 0);
#pragma unroll
                for (int r = 0; r < 4; ++r) { const int j = 16 * jt + 4 * q + r; const bool keep = dir == 0 ? (j <= iq) : (j >= iq); t[r] = keep ? t[r] : 0.f; }
                s[jt] = t; }
            bf16x8 pbf[2];
#pragma unroll
            for (int ks = 0; ks < 2; ++ks) { v4u w; w.x = pk2(s[2 * ks][0], s[2 * ks][1]); w.y = pk2(s[2 * ks][2], s[2 * ks][3]); w.z = pk2(s[2 * ks + 1][0], s[2 * ks + 1][1]); w.w = pk2(s[2 * ks + 1][2], s[2 * ks + 1][3]);
                pbf[ks] = __builtin_bit_cast(bf16x8, w); }
#pragma unroll
            for (int nt = 0; nt < 4; ++nt) { const int er = 64 * eh + 16 * nt + l15;
                const bf16x8 s0 = *(const LAS bf16x8*)(STl + (size_t)(dir * 128 + er) * GP + 8 * q), s1 = *(const LAS bf16x8*)(STl + (size_t)(dir * 128 + er) * GP + 32 + 8 * q);
                acc[nt] = __builtin_amdgcn_mfma_f32_16x16x32_bf16(s0, bq0, acc[nt], 0, 0, 0); acc[nt] = __builtin_amdgcn_mfma_f32_16x16x32_bf16(s1, bq1, acc[nt], 0, 0, 0);
#pragma unroll
                for (int ks = 0; ks < 2; ++ks) { const LAS bf16* vb = vL + (size_t)(32 * ks + 4 * q + (l15 >> 2)) * GVP + 64 * eh + 16 * nt + 4 * (l15 & 3);
                    const v2u lo = __builtin_bit_cast(v2u, __builtin_amdgcn_ds_read_tr16_b64_v4i16((LAS s16x4_t*)vb)), hi = __builtin_bit_cast(v2u, __builtin_amdgcn_ds_read_tr16_b64_v4i16((LAS s16x4_t*)(vb + 16 * GVP)));
                    acc[nt] = __builtin_amdgcn_mfma_f32_16x16x32_bf16(mk8(lo, hi), pbf[ks], acc[nt], 0, 0, 0); } }
        }
        float ss = 0.f;
#pragma unroll
        for (int nt = 0; nt < 4; ++nt) ss += (acc[nt][0] * acc[nt][0] + acc[nt][1] * acc[nt][1]) + (acc[nt][2] * acc[nt][2] + acc[nt][3] * acc[nt][3]);
        ss = xor16_sum(ss); ss = xor32_sum(ss);
        if (q == 0) ssq[eh * 64 + iq] = ss;
        __syncthreads();
        const float rn = 1.0f / sqrtf((ssq[iq] + ssq[64 + iq]) * (1.0f / 128.0f) + EPS);
#pragma unroll
        for (int nt = 0; nt < 4; ++nt) { const int e = 64 * eh + 16 * nt + 4 * q; const size_t m = (size_t)(m0 + iq);
            const v2u rr = *(const v2u*)(P + m * 2048 + 1536 + h * 128 + e); const float* hg = c.a->in[I_HEADG] + h * 128 + e;
            v2u o; o.x = pk2(acc[nt][0] * rn * hg[0] * silu(bflo(rr.x)), acc[nt][1] * rn * hg[1] * silu(bfhi(rr.x))); o.y = pk2(acc[nt][2] * rn * hg[2] * silu(bflo(rr.y)), acc[nt][3] * rn * hg[3] * silu(bfhi(rr.y)));
            *(v2u*)(WSP(bf16, WS_MIX) + m * 1024 + 512 + h * 128 + e) = o; }
        __syncthreads();
    }
}

constexpr int NP = 72;
constexpr float LOG2E = 1.4426950408889634f;
template <int QG, bool WIN>
__device__ __forceinline__ void na_qgroup(const LAS bf16* Kt, const bf16x8 (&vf)[4][2], const LAS float* bp, const float (&cap)[3][4], const bf16x8 (&qf)[2], f32x4 (&o)[4], float& mrun, float& lrun, int q, int l15) {
    constexpr int KT_LO = WIN ? (QG <= 1 ? 0 : QG - 1) : 0, KT_HI = WIN ? (QG == 0 ? 1 : (QG == 3 ? 3 : QG + 1)) : 3;
    f32x4 s[4];
#pragma unroll
    for (int kt = 0; kt < 4; ++kt) if (kt >= KT_LO && kt <= KT_HI) {
        const bf16x8 a0 = *(const LAS bf16x8*)(Kt + (size_t)(16 * kt + l15) * NP + 8 * q), a1 = *(const LAS bf16x8*)(Kt + (size_t)(16 * kt + l15) * NP + 32 + 8 * q);
        f32x4 t = {0.f, 0.f, 0.f, 0.f};
        t = __builtin_amdgcn_mfma_f32_16x16x32_bf16(a0, qf[0], t, 0, 0, 0); t = __builtin_amdgcn_mfma_f32_16x16x32_bf16(a1, qf[1], t, 0, 0, 0);
        s[kt] = t; }
    float mx = -1e30f;
#pragma unroll
    for (int kt = 0; kt < 4; ++kt) if (kt >= KT_LO && kt <= KT_HI) {
#pragma unroll
        for (int r = 0; r < 4; ++r) { float v;
            if (WIN) v = fminf(__builtin_fmaf(s[kt][r], 0.125f * LOG2E, bp[16 * kt + r]), cap[kt - KT_LO][r]); else v = s[kt][r] * (0.125f * LOG2E);
            s[kt][r] = v; mx = fmaxf(mx, v); } }
    mx = xor16_max(mx); mx = xor32_max(mx);
    const float mnew = fmaxf(mrun, mx), alpha = __builtin_amdgcn_exp2f(mrun - mnew);
    mrun = mnew;
    float psum = 0.f;
#pragma unroll
    for (int kt = 0; kt < 4; ++kt) {
        if (kt >= KT_LO && kt <= KT_HI) {
#pragma unroll
            for (int r = 0; r < 4; ++r) { const float p = __builtin_amdgcn_exp2f(s[kt][r] - mnew); s[kt][r] = p; psum += p; } }
        else s[kt] = (f32x4){0.f, 0.f, 0.f, 0.f}; }
    lrun = lrun * alpha + psum;
#pragma unroll
    for (int nt = 0; nt < 4; ++nt) o[nt] = o[nt] * alpha;
#pragma unroll
    for (int ks = 0; ks < 2; ++ks) if (2 * ks + 1 >= KT_LO && 2 * ks <= KT_HI) {
        v4u w; w.x = pk2(s[2 * ks][0], s[2 * ks][1]); w.y = pk2(s[2 * ks][2], s[2 * ks][3]); w.z = pk2(s[2 * ks + 1][0], s[2 * ks + 1][1]); w.w = pk2(s[2 * ks + 1][2], s[2 * ks + 1][3]);
        const bf16x8 pb = __builtin_bit_cast(bf16x8, w);
#pragma unroll
        for (int nt = 0; nt < 4; ++nt) o[nt] = __builtin_amdgcn_mfma_f32_16x16x32_bf16(vf[nt][ks], pb, o[nt], 0, 0, 0); }
}
__device__ __forceinline__ void na_load_vf(const LAS bf16* Vt, bf16x8 (&vf)[4][2], int q, int l15) {
    const LAS bf16* base = Vt + (size_t)(4 * q + (l15 >> 2)) * NP + 4 * (l15 & 3);
#pragma unroll
    for (int nt = 0; nt < 4; ++nt)
#pragma unroll
        for (int ks = 0; ks < 2; ++ks) {
            const s16x4_t lo = __builtin_amdgcn_ds_read_tr16_b64_v4i16((LAS s16x4_t*)(base + (size_t)(32 * ks) * NP + 16 * nt)), hi = __builtin_amdgcn_ds_read_tr16_b64_v4i16((LAS s16x4_t*)(base + (size_t)(32 * ks + 16) * NP + 16 * nt));
            vf[nt][ks] = mk8(__builtin_bit_cast(v2u, lo), __builtin_bit_cast(v2u, hi)); }
}
__device__ __forceinline__ void ph_na(const Ctx& c) {
    LAS bf16* Kb = (LAS bf16*)c.lds;
    LAS bf16* Vb = Kb + 2 * 64 * NP;
    LAS float* rpbL = (LAS float*)(Vb + 2 * 64 * NP);
    const bf16* P = WSP(bf16, WS_PBUF);
    const int q = c.lane >> 4, l15 = c.lane & 15, hq = c.wave & 1;
    const int lkey = c.tid >> 3, lch = c.tid & 7;
    for (int item = blockIdx.x; item < 512 + 16; item += c.G) {
        const bool lat = item < 512;
        int b, h, r0 = 0, rlo = 0, nwin = 0;
        if (lat) { const int rb = item & 31; h = (item >> 5) & 7; b = item >> 8; r0 = 4 * rb; rlo = min(max(r0 - 4, 0), 120); nwin = min(max(r0 - 1, 0), 120) + 7 - rlo + 1; }
        else { const int ci = item - 512; h = ci & 7; b = ci >> 3; }
        const int nsteps = nwin + 4, r = r0 + (c.wave >> 1), rs = min(max(r - 4, 0), 120);
        for (int i = c.tid; i < 465; i += 512) rpbL[i] = c.a->in[I_RPB][h * 465 + i] * LOG2E;
        bf16x8 qf[2][2];
#pragma unroll
        for (int g = 0; g < 2; ++g) { const int qt = lat ? b * SEQ + r * 64 + 16 * (2 * hq + g) + l15 : NLAT + b * CTXL + 32 * c.wave + 16 * g + l15;
#pragma unroll
            for (int ks = 0; ks < 2; ++ks) qf[g][ks] = *(const bf16x8*)(P + (size_t)qt * 2560 + 1024 + h * 64 + 32 * ks + 8 * q); }
        f32x4 o[2][4];
#pragma unroll
        for (int g = 0; g < 2; ++g)
#pragma unroll
            for (int nt = 0; nt < 4; ++nt) o[g][nt] = (f32x4){0.f, 0.f, 0.f, 0.f};
        float mrun[2] = {-1e30f, -1e30f}, lrun[2] = {0.f, 0.f};
        float cap[2][3][4]; int bidx[2];
#pragma unroll
        for (int g = 0; g < 2; ++g) { const int QGr = 2 * hq + g, qc = 16 * QGr + l15, cs = min(max(qc - 8, 0), 48), ktlo = QGr <= 1 ? 0 : QGr - 1; bidx[g] = 4 * q - qc + 15;
#pragma unroll
            for (int t = 0; t < 3; ++t)
#pragma unroll
                for (int rr = 0; rr < 4; ++rr) { const int kc = 16 * (ktlo + t) + 4 * q + rr; cap[g][t][rr] = (unsigned)(kc - cs) < 16u ? __builtin_inff() : -1e30f; } }
        v4u kreg, vreg;
        { const int tok0 = nwin > 0 ? b * SEQ + rlo * 64 : NLAT + b * CTXL; const bf16* src = P + (size_t)(tok0 + lkey) * 2560 + 1536 + h * 64 + 8 * lch; kreg = *(const v4u*)src; vreg = *(const v4u*)(src + 512); }
        for (int s = 0; s < nsteps; ++s) {
            LAS bf16* Kt = Kb + (s & 1) * 64 * NP; LAS bf16* Vt = Vb + (s & 1) * 64 * NP;
            *(LAS v4u*)(Kt + (size_t)lkey * NP + 8 * lch) = kreg;
            *(LAS v4u*)(Vt + (size_t)lkey * NP + 8 * lch) = vreg;
            __syncthreads();
            if (s + 1 < nsteps) { const int s1 = s + 1; const int tok0 = s1 < nwin ? b * SEQ + (rlo + s1) * 64 : NLAT + b * CTXL + 64 * (s1 - nwin);
                const bf16* src = P + (size_t)(tok0 + lkey) * 2560 + 1536 + h * 64 + 8 * lch; kreg = *(const v4u*)src; vreg = *(const v4u*)(src + 512); }
            if (s < nwin) { const int kr = rlo + s;
                if (kr >= rs && kr < rs + 8) { bf16x8 vf[4][2]; na_load_vf(Vt, vf, q, l15); const LAS float* rpbrow = rpbL + (kr - r + 7) * 31;
                    if (hq == 0) { na_qgroup<0, true>(Kt, vf, rpbrow + bidx[0], cap[0], qf[0], o[0], mrun[0], lrun[0], q, l15); na_qgroup<1, true>(Kt, vf, rpbrow + bidx[1], cap[1], qf[1], o[1], mrun[1], lrun[1], q, l15); }
                    else { na_qgroup<2, true>(Kt, vf, rpbrow + bidx[0], cap[0], qf[0], o[0], mrun[0], lrun[0], q, l15); na_qgroup<3, true>(Kt, vf, rpbrow + bidx[1], cap[1], qf[1], o[1], mrun[1], lrun[1], q, l15); } } }
            else { bf16x8 vf[4][2]; na_load_vf(Vt, vf, q, l15);
                na_qgroup<0, false>(Kt, vf, rpbL, cap[0], qf[0], o[0], mrun[0], lrun[0], q, l15); na_qgroup<0, false>(Kt, vf, rpbL, cap[1], qf[1], o[1], mrun[1], lrun[1], q, l15); }
        }
#pragma unroll
        for (int g = 0; g < 2; ++g) { float l = lrun[g]; l = xor16_sum(l); l = xor32_sum(l); const float il = 1.0f / l;
            const int qt = lat ? b * SEQ + r * 64 + 16 * (2 * hq + g) + l15 : NLAT + b * CTXL + 32 * c.wave + 16 * g + l15;
#pragma unroll
            for (int nt = 0; nt < 4; ++nt) { v2u pk; pk.x = pk2(o[g][nt][0] * il, o[g][nt][1] * il); pk.y = pk2(o[g][nt][2] * il, o[g][nt][3] * il);
                *(v2u*)(WSP(bf16, WS_MIX) + (size_t)qt * 1024 + 512 + h * 64 + 16 * nt + 4 * q) = pk; } }
        __syncthreads();
    }
}


typedef int v8i_c __attribute__((ext_vector_type(8)));
typedef int v4i_c __attribute__((ext_vector_type(4)));
__device__ __forceinline__ v8i_c ld32(const unsigned char* p) { const v4i_c lo = *(const v4i_c*)p, hi = *(const v4i_c*)(p + 16); return __builtin_shufflevector(lo, hi, 0, 1, 2, 3, 4, 5, 6, 7); }
template <int NT, int KS, int APITCH, int MT> __device__ __forceinline__ void ctx_pass(const Ctx& c, const unsigned char* A, int lda, const unsigned char* B0, const unsigned char* B1, int ldb, f32x4 (&acc)[MT][NT], int mt0) {
    const int l15 = c.lane & 15, q = c.lane >> 4;
    LAS unsigned char* aL = c.lds;
    v8i_c b[KS][NT];
    { const unsigned char* bp0 = B0 + (size_t)l15 * ldb + 32 * q; const unsigned char* bp1 = B1 + (size_t)l15 * ldb + 32 * q;
#pragma unroll
      for (int ks = 0; ks < KS; ++ks) { b[ks][0] = ld32(bp0 + 128 * ks); if (NT > 1) b[ks][NT - 1] = ld32(bp1 + 128 * ks); } }
    __syncthreads();
    constexpr int CPR = KS * 8;
    for (int i = c.tid; i < 64 * CPR; i += 512) { const int row = i / CPR, ch = i % CPR; *(LAS v4i_c*)(aL + row * APITCH + 16 * ch) = *(const v4i_c*)(A + (size_t)row * lda + 16 * ch); }
    __syncthreads();
#pragma unroll
    for (int ks = 0; ks < KS; ++ks) {
        v8i_c a[MT];
#pragma unroll
        for (int mt = 0; mt < MT; ++mt) { const LAS unsigned char* p = aL + (16 * (mt0 + mt) + l15) * APITCH + 128 * ks + 32 * q; const v4i_c lo = *(const LAS v4i_c*)p, hi = *(const LAS v4i_c*)(p + 16); a[mt] = __builtin_shufflevector(lo, hi, 0, 1, 2, 3, 4, 5, 6, 7); }
#pragma unroll
        for (int mt = 0; mt < MT; ++mt)
#pragma unroll
            for (int nt = 0; nt < NT; ++nt) asm volatile("v_mfma_f32_16x16x128_f8f6f4 %0, %1, %2, %0" : "+v"(acc[mt][nt]) : "v"(b[ks][nt]), "v"(a[mt]));
    }
}
__device__ __forceinline__ void ph_moe_ctx1(const Ctx& c, int layer) {
    const unsigned char* W1 = WSP(unsigned char, WS_W1) + (size_t)layer * 16 * 5632 * 1024;
    const int l15 = c.lane & 15, q = c.lane >> 4;
    for (int item = blockIdx.x; item < 16 * 22; item += c.G) {
        const int e = item / 22, pn = item % 22;
        const unsigned char* A = WSP(unsigned char, WS_XG) + (size_t)(MOE_LAT + e * 256) * 1024;
        const unsigned char* Bg = W1 + ((size_t)e * 5632 + pn * 256 + 16 * c.wave) * 1024;
        f32x4 acc[4][2];
#pragma unroll
        for (int mt = 0; mt < 4; ++mt) { acc[mt][0] = (f32x4){0.f, 0.f, 0.f, 0.f}; acc[mt][1] = (f32x4){0.f, 0.f, 0.f, 0.f}; }
        ctx_pass<2, 8, 1040, 4>(c, A, 1024, Bg, Bg + (size_t)128 * 1024, 1024, acc, 0);
        asm volatile("s_nop 15\n\ts_nop 15" ::: "memory");
        const float in_inv = 1.0f / (SC_X * SC_W);
#pragma unroll
        for (int mt = 0; mt < 4; ++mt) { const f32x4 g = acc[mt][0] * in_inv, u = acc[mt][1] * (in_inv * SC_H);
            const unsigned w = pg8::pk4_fp8(pg8::clamp448(pg8::silu_f(g[0]) * u[0]), pg8::clamp448(pg8::silu_f(g[1]) * u[1]), pg8::clamp448(pg8::silu_f(g[2]) * u[2]), pg8::clamp448(pg8::silu_f(g[3]) * u[3]));
            *(unsigned*)(WSP(unsigned char, WS_HID) + (size_t)(MOE_LAT + e * 256 + 16 * mt + l15) * FF + pn * 128 + 16 * c.wave + 4 * q) = w; }
    }
    __syncthreads();
}
__device__ __forceinline__ void ph_moe_ctx2(const Ctx& c, int layer) {
    const unsigned char* W2 = WSP(unsigned char, WS_W2) + (size_t)layer * 16 * 1024 * 2816;
    const int l15 = c.lane & 15, q = c.lane >> 4, nt = c.wave & 3, mh = c.wave >> 2;
    for (int item = blockIdx.x; item < 16 * 16; item += c.G) {
        const int e = item >> 4, cb = item & 15;
        const unsigned char* A = WSP(unsigned char, WS_HID) + (size_t)(MOE_LAT + e * 256) * FF;
        const unsigned char* B = W2 + ((size_t)e * 1024 + cb * 64 + 16 * nt) * FF;
        f32x4 acc[2][1];
        acc[0][0] = (f32x4){0.f, 0.f, 0.f, 0.f}; acc[1][0] = (f32x4){0.f, 0.f, 0.f, 0.f};
        ctx_pass<1, 11, 1424, 2>(c, A, FF, B, B, FF, acc, 2 * mh);
        ctx_pass<1, 11, 1424, 2>(c, A + 1408, FF, B + 1408, B + 1408, FF, acc, 2 * mh);
        asm volatile("s_nop 15\n\ts_nop 15" ::: "memory");
        const float sc = 1.0f / (SC_H * SC_W);
#pragma unroll
        for (int mt = 0; mt < 2; ++mt) { const f32x4 v = acc[mt][0] * sc; v2u pk; pk.x = pk2(v[0], v[1]); pk.y = pk2(v[2], v[3]);
            *(v2u*)(WSP(bf16, WS_Y) + (size_t)(MOE_LAT + e * 256 + 16 * (2 * mh + mt) + l15) * 1024 + cb * 64 + 16 * nt + 4 * q) = pk; }
    }
    __syncthreads();
}

#ifndef GLA_NAIVE
#define GLA_NAIVE 0
#endif
#ifndef NA_NAIVE
#define NA_NAIVE 0
#endif
#ifndef MK_ONE_LAUNCH
#define MK_ONE_LAUNCH 1
#endif
constexpr int NPH = 23;
#define MKCTX() Ctx c; c.lds = lds; { unsigned long long a_ = (unsigned long long)a; asm volatile("" : "+s"(a_)); const unsigned lo_ = __builtin_amdgcn_readfirstlane((unsigned)a_), hi_ = __builtin_amdgcn_readfirstlane((unsigned)(a_ >> 32)); c.a = (const CAS Args*)(((unsigned long long)hi_ << 32) | lo_); } c.out = a->out; c.ws = a->ws; { int t_ = threadIdx.x; asm volatile("" : "+v"(t_)); c.tid = t_ & 511; } c.lane = c.tid & 63; c.wave = __builtin_amdgcn_readfirstlane(c.tid >> 6); c.G = gridDim.x; \
    c.gw = blockIdx.x * NWAVES + c.wave; c.ngw = c.G * NWAVES
__device__ __forceinline__ void P_prologue(LAS unsigned char* lds, const CAS Args* a) { MKCTX(); ph_prologue(c); }
__device__ __forceinline__ void P_fill(LAS unsigned char* lds, const CAS Args* a, int maxn) { MKCTX(); convert_fill(c, maxn); }
__device__ __forceinline__ void P_adaln0(LAS unsigned char* lds, const CAS Args* a) { MKCTX(); ph_adaln0(c); }
__device__ __forceinline__ void P_conv(LAS unsigned char* lds, const CAS Args* a) { MKCTX(); ph_conv(c); }
#if NA_NAIVE
__device__ __forceinline__ void P_na(LAS unsigned char* lds, const CAS Args* a) { MKCTX(); ph_na_naive(c); }
#else
__device__ __forceinline__ void P_na(LAS unsigned char* lds, const CAS Args* a) { MKCTX(); ph_na(c); }
#endif
__device__ __forceinline__ void P_outproj_ctx(LAS unsigned char* lds, const CAS Args* a) { MKCTX(); ph_outproj_ctx_tiles(c, WS_WOUTE); }
__device__ __forceinline__ void P_inproj_odd_tiles(LAS unsigned char* lds, const CAS Args* a) { MKCTX(); ph_inproj_odd_tiles(c); }
__device__ __forceinline__ void P_prep_odd(LAS unsigned char* lds, const CAS Args* a) { MKCTX(); ph_prep_odd(c); }
__device__ __forceinline__ void P_pool(LAS unsigned char* lds, const CAS Args* a) { MKCTX(); ph_pool(c); }
__device__ __forceinline__ void P_gla_naive(LAS unsigned char* lds, const CAS Args* a) { MKCTX(); ph_gla_naive(c); }
__device__ __forceinline__ void P_gla_out(LAS unsigned char* lds, const CAS Args* a) { MKCTX(); ph_gla_out(c); }
__device__ __forceinline__ void P_gla_g1(LAS unsigned char* lds, const CAS Args* a) { MKCTX(); ph_gla_g1(c); }
__device__ __forceinline__ void P_gla_g2(LAS unsigned char* lds, const CAS Args* a) { MKCTX(); ph_gla_g2(c); }
__device__ __forceinline__ void P_gla_g3(LAS unsigned char* lds, const CAS Args* a) { MKCTX(); ph_gla_g3(c); }
__device__ __forceinline__ void P_post(LAS unsigned char* lds, const CAS Args* a, int layer, int ntok) { MKCTX(); ph_post(c, layer, ntok); }
__device__ __forceinline__ void P_topk_gather(LAS unsigned char* lds, const CAS Args* a, int nctx) { MKCTX(); ph_topk_gather(c, 256, nctx); }
__device__ __forceinline__ void P_moe_ctx1(LAS unsigned char* lds, const CAS Args* a, int layer) { MKCTX(); ph_moe_ctx1(c, layer); }
__device__ __forceinline__ void P_moe_ctx2(LAS unsigned char* lds, const CAS Args* a, int layer) { MKCTX(); ph_moe_ctx2(c, layer); }
__device__ __forceinline__ void P_combine(LAS unsigned char* lds, const CAS Args* a, int layer, int ntok) { MKCTX(); ph_combine(c, layer, ntok); }
template <int K, int NN, int LDC> __device__ __forceinline__ void P_gemm_bf16(LAS unsigned char* lds, const bf16* A, const bf16* Bt, bf16* O, int nM) {
    pg8::Gemm g{A, Bt, K}; pg8::Order S; S.init(nM, NN, (int)gridDim.x, (int)blockIdx.x, 0);
    pg8::EpiBf16 E{O, LDC, 1.0f}; pg8::gemm_phase<pg8::EpiBf16, pg8::Order, PG8_ALIGN, PG8_SP2>(lds, g, S, E);
}
template <int KB, int NN, int LDC> __device__ __forceinline__ void P_gemm_f8_bf16(LAS unsigned char* lds, const unsigned char* A, const unsigned char* Bt, bf16* O, int nM) {
    pg8::Gemm g{(const bf16*)A, (const bf16*)Bt, KB / 2}; pg8::Order S; S.init(nM, NN, (int)gridDim.x, (int)blockIdx.x, 1);
    pg8::EpiBf16F8 E{O, LDC, 1.0f / (SC_H * SC_W)}; pg8::gemm_phase<pg8::EpiBf16F8, pg8::Order, PG8_ALIGN, PG8_SP2>(lds, g, S, E);
}
template <int KB, int NN, int LDC> __device__ __forceinline__ void P_gemm_f8_swiglu(LAS unsigned char* lds, const unsigned char* A, const unsigned char* Bt, unsigned char* O, int nM) {
    pg8::Gemm g{(const bf16*)A, (const bf16*)Bt, KB / 2}; pg8::Order S; S.init(nM, NN, (int)gridDim.x, (int)blockIdx.x, 1);
    pg8::EpiSwigluF8 E{O, LDC, 1.0f / (SC_X * SC_W), SC_H}; pg8::gemm_phase<pg8::EpiSwigluF8, pg8::Order, PG8_ALIGN, PG8_SP2>(lds, g, S, E);
}

__global__ void __launch_bounds__(NWAVES * 64, 2) fwd(Args args) {
    extern __shared__ __attribute__((aligned(16))) unsigned char lds_raw[];
    LAS unsigned char* lds = (LAS unsigned char*)lds_raw;
    const CAS Args* a = (const CAS Args*)__builtin_amdgcn_kernarg_segment_ptr();
    unsigned char* ws = args.ws;
    const int tid = threadIdx.x;
    volatile LAS unsigned* MISC = (volatile LAS unsigned*)(lds + MISC_OFF);
    for (int u = tid; u < (LDS_BYTES - LDSCTL_OFF) / 4; u += NWAVES * 64) ((LAS unsigned*)(lds + LDSCTL_OFF))[u] = 0u;
    __syncthreads();
    const int lo = args.ph_lo, hi = args.ph_hi;
    XcdBarrier bar; bar.bar = (unsigned*)(ws + WS_CTL) + CW_BAR; bar.x = 0; bar.st = nullptr;
    if (hi - lo > 1) bar = xcd_barrier_post((unsigned*)(ws + WS_CTL) + CW_BAR, MISC + 8);
#ifndef PROBE_MASK
#define PROBE_MASK 0
#endif
#ifndef PROBE_N
#define PROBE_N 2
#endif
#define REP(k) (((k) != 17 && (k) != 10 && (((PROBE_MASK) >> ((k) < 17 ? (k) : (k) - 12)) & 1)) ? PROBE_N : 1)
#define REPX(b) ((((PROBE_MASK) >> (b)) & 1) ? PROBE_N : 1)
#define RX(b, call) do { for (int rx_ = 0; rx_ < REPX(b); ++rx_) { call; } } while (0)
#define IN(k) (lo <= (k) && (k) < hi)
#define SEAM(k) do { if (IN(k) && IN((k) + 1)) xcd_barrier(bar); } while (0)
#define WP(off) ((bf16*)(ws + (off)))
    if (IN(0)) for (int rep_ = 0; rep_ < REP(0); ++rep_) { P_prologue(lds, a); } SEAM(0);
    if (IN(1)) for (int rep_ = 0; rep_ < REP(1); ++rep_) { P_adaln0(lds, a); } SEAM(1);
    if (IN(2)) for (int rep_ = 0; rep_ < REP(2); ++rep_) { P_gemm_bf16<1024, EVEN_IN / 256, EVEN_IN>(lds, WP(WS_H), WP(WS_WINE), WP(WS_PBUF), NTOK / 256); if (gridDim.x == 256 && blockIdx.x >= 148) P_fill(lds, a, 6); }     SEAM(2);
    if (IN(3)) for (int rep_ = 0; rep_ < REP(3); ++rep_) { RX(17, P_conv(lds, a)); RX(18, P_na(lds, a)); } SEAM(3);
    if (IN(4)) for (int rep_ = 0; rep_ < REP(4); ++rep_) { P_gemm_bf16<1024, 4, 1024>(lds, WP(WS_MIX), WP(WS_WOUTE), WP(WS_YO), NLAT / 256); RX(19, P_outproj_ctx(lds, a)); } SEAM(4);
#define COMMON(layer, p0, ntok, nlists, nrows) \
    if (IN(p0 + 0)) for (int rep_ = 0; rep_ < REP(p0 + 0); ++rep_) { P_post(lds, a, layer, ntok); } SEAM(p0 + 0); \
    if (IN(p0 + 1)) for (int rep_ = 0; rep_ < REP(p0 + 1); ++rep_) { P_topk_gather(lds, a, (nlists) - 32); if (layer == 1) P_fill(lds, a, 1 << 30); }     do { if (IN(p0 + 1) && IN(p0 + 3)) xcd_barrier(bar); } while (0); \
    if (IN(p0 + 3)) for (int rep_ = 0; rep_ < REP(p0 + 3); ++rep_) { P_gemm_f8_swiglu<1024, 22, FF>(lds, ws + WS_XG, ws + WS_W1 + (size_t)layer * 16 * 5632 * 1024, ws + WS_HID, MOE_LAT / 256); if ((nrows) > MOE_LAT) P_moe_ctx1(lds, a, layer); } SEAM(p0 + 3); \
    if (IN(p0 + 4)) for (int rep_ = 0; rep_ < REP(p0 + 4); ++rep_) { P_gemm_f8_bf16<FF, 4, 1024>(lds, ws + WS_HID, ws + WS_W2 + (size_t)layer * 16 * 1024 * 2816, WP(WS_Y), MOE_LAT / 256); if ((nrows) > MOE_LAT) P_moe_ctx2(lds, a, layer); } SEAM(p0 + 4); \
    if (IN(p0 + 5)) for (int rep_ = 0; rep_ < REP(p0 + 5); ++rep_) { P_combine(lds, a, layer, ntok); }
    COMMON(0, 5, NTOK, 64, MOE_ROWS) SEAM(10);
    if (IN(11)) for (int rep_ = 0; rep_ < REP(11); ++rep_) { P_gemm_bf16<1024, 8, 2048>(lds, WP(WS_H), WP(WS_WINO), WP(WS_PBUF), NLAT / 256); RX(20, P_inproj_odd_tiles(lds, a)); }
    do { if (IN(11) && IN(13)) xcd_barrier(bar); } while (0);
#if GLA_NAIVE
    if (IN(12)) for (int rep_ = 0; rep_ < REP(12); ++rep_) { P_prep_odd(lds, a); } SEAM(12);
    if (IN(13)) for (int rep_ = 0; rep_ < REP(13); ++rep_) { P_pool(lds, a); P_gla_naive(lds, a); } SEAM(13);
    if (IN(14)) for (int rep_ = 0; rep_ < REP(14); ++rep_) { P_gla_out(lds, a); } SEAM(14);
    SEAM(15);
#else
    if (IN(13)) for (int rep_ = 0; rep_ < REP(13); ++rep_) { RX(21, P_pool(lds, a)); RX(22, P_gla_g1(lds, a)); } SEAM(13);
    if (IN(14)) for (int rep_ = 0; rep_ < REP(14); ++rep_) { P_gla_g2(lds, a); } SEAM(14);
    if (IN(15)) for (int rep_ = 0; rep_ < REP(15); ++rep_) { P_gla_g3(lds, a); } SEAM(15);
#endif
    if (IN(16)) for (int rep_ = 0; rep_ < REP(16); ++rep_) { P_gemm_bf16<1024, 4, 1024>(lds, WP(WS_MIX), WP(WS_WOUTO), WP(WS_YO), NLAT / 256); } SEAM(16);
    COMMON(1, 17, NLAT, 32, MOE_LAT)
#undef COMMON
#undef IN
#undef SEAM
#undef WP
}

extern "C" void kernel_launch(void* const* d_in, const int* in_sizes, int n_in, void* d_out, int out_size, void* d_ws, size_t ws_size, hipStream_t stream) {
    static int grid = 0;
    if (grid == 0) {
        if (n_in != N_IN || out_size != NLAT * D || ws_size < WS_END) { fprintf(stderr, "kernel_launch: unexpected shapes (n_in %d, out %d, ws %zu, need %zu)\n", n_in, out_size, ws_size, (size_t)WS_END); grid = -1; return; }
        int dev = 0, cus = 0, per_cu = 0;
        if (hipGetDevice(&dev) != hipSuccess || hipDeviceGetAttribute(&cus, hipDeviceAttributeMultiprocessorCount, dev) != hipSuccess) { grid = -1; return; }
        if (hipFuncSetAttribute((const void*)fwd, hipFuncAttributeMaxDynamicSharedMemorySize, LDS_BYTES) != hipSuccess) { fprintf(stderr, "kernel_launch: hipFuncSetAttribute failed\n"); grid = -1; return; }
        if (hipOccupancyMaxActiveBlocksPerMultiprocessor(&per_cu, (const void*)fwd, NWAVES * 64, LDS_BYTES) != hipSuccess || per_cu < 1) fprintf(stderr, "kernel_launch: occupancy query reports %d\n", per_cu);
        (void)hipGetLastError();
        grid = cus;
    }
    if (grid < 0) return;
    (void)in_sizes;
    if (hipMemsetAsync((char*)d_ws + WS_CTL, 0, CTL_ZERO_BYTES, stream) != hipSuccess) return;
    Args a{};
    for (int i = 0; i < N_IN; ++i) a.in[i] = (const float*)d_in[i];
    a.out = (float*)d_out; a.ws = (unsigned char*)d_ws;
#if MK_ONE_LAUNCH
    a.ph_lo = 0; a.ph_hi = NPH;
    hipLaunchKernelGGL(fwd, dim3(grid), dim3(NWAVES * 64), LDS_BYTES, stream, a);
#else
    for (int li = 0; li < NPH; ++li) { a.ph_lo = li; a.ph_hi = li + 1; hipLaunchKernelGGL(fwd, dim3(grid), dim3(NWAVES * 64), LDS_BYTES, stream, a); }
#endif
}
```

```cpp
#include <hip/hip_runtime.h>
#include <cstdio>
#include <cstdint>
namespace pg8 {
#define PG8_LAS __attribute__((address_space(3)))
typedef unsigned short bf16_t;
typedef short bf16x8 __attribute__((ext_vector_type(8)));
typedef float f32x4 __attribute__((ext_vector_type(4)));
typedef unsigned u32x4 __attribute__((ext_vector_type(4)));
typedef int v4i_t __attribute__((ext_vector_type(4)));
typedef int v8i_t __attribute__((ext_vector_type(8)));
#ifndef PG8_F8_SCALE
#define PG8_F8_SCALE 0
#endif
constexpr int BM = 256, BK = 64, HALF = 128, HTB = HALF * BK * 2  , STAGE_BYTES = 8 * HTB, NXCD = 8, WGM = 8;

__host__ __device__ __forceinline__ int lds_byte(int r, int c) { const int st = (r >> 4) * 2 + (c >> 5), rr = r & 15, cc = c & 31, ob = rr * 64 + cc * 2; return st * 1024 + (ob ^ (((ob >> 9) & 1) << 5)); }
__host__ __device__ __forceinline__ void stage_rc(int b, int& R, int& C) { const int st = b / 1024, sb = b % 1024, swz = sb ^ (((sb >> 9) & 1) << 5); R = (st >> 1) * 16 + swz / 64; C = (st & 1) * 32 + (swz % 64) / 2; }
__host__ __device__ __forceinline__ int perm32(int rho) { const int n = rho >> 4, i = rho & 15; return 8 * (i >> 2) + 4 * n + (i & 3); }

struct Unit { int pm, pn, pb; };
struct Gemm { const bf16_t* A; const bf16_t* Bt; int K; };

struct Order {
    int nM, nN, nwg, G, c, moe;
    __device__ void init(int nM_, int nN_, int G_, int c_, int moe_) { nM = nM_; nN = nN_; nwg = nM * nN; G = G_; c = c_; moe = moe_; }
    __device__ bool next(int i, Unit& u) const {
        const long L = (long)i * G + c; if (L >= nwg) return false;
        int wgid = (int)L; { const int q = nwg / NXCD, r = nwg % NXCD, xcd = wgid % NXCD, off = wgid / NXCD; wgid = (xcd < r ? xcd * (q + 1) : r * (q + 1) + (xcd - r) * q) + off; }
        const int nig = WGM * nN, gid = wgid / nig, fm = gid * WGM, gsz = (nM - fm) < WGM ? (nM - fm) : WGM;
        u.pm = fm + ((wgid % nig) % gsz); u.pn = (wgid % nig) / gsz;
        u.pb = moe ? ((u.pm < 128 ? (u.pm >> 3) : (u.pm - 128)) * nN + u.pn) : u.pn;
        return true;
    }
    __device__ __forceinline__ void a_ready(const Unit&) const {}
    __device__ __forceinline__ void done(const Unit&) const {}
};

__device__ __forceinline__ unsigned cvt_pk_bf16(float lo, float hi) { unsigned r; asm volatile("v_cvt_pk_bf16_f32 %0, %1, %2" : "=v"(r) : "v"(lo), "v"(hi)); return r; }

template <bool F8_> struct EpiBf16T {
    static constexpr bool PERM = true, AFTER_DRAIN = false, F8 = F8_;
    bf16_t* O; int ldc; float scale;
    __device__ __forceinline__ void operator()(const f32x4 (&acc)[2][2][4][2], const Unit& u, int wr, int wc, int fr, int fq) const {
        const int row0 = u.pm * BM + wr * 64 + fr; const int col0 = u.pn * BM + wc * 32 + 8 * fq;
#pragma unroll
        for (int ai = 0; ai < 2; ++ai)
#pragma unroll
            for (int m = 0; m < 4; ++m) { bf16_t* rowp = O + (size_t)(row0 + ai * HALF + m * 16) * ldc + col0;
#pragma unroll
                for (int bj = 0; bj < 2; ++bj) { const f32x4 v0 = acc[ai][bj][m][0] * scale, v1 = acc[ai][bj][m][1] * scale;
                    u32x4 w; w.x = cvt_pk_bf16(v0[0], v0[1]); w.y = cvt_pk_bf16(v0[2], v0[3]); w.z = cvt_pk_bf16(v1[0], v1[1]); w.w = cvt_pk_bf16(v1[2], v1[3]);
                    *(u32x4*)(rowp + bj * HALF) = w; } }
    }
};
__device__ __forceinline__ float silu_f(float x) { return x * __builtin_amdgcn_rcpf(1.0f + __expf(-x)); }
typedef EpiBf16T<false> EpiBf16;
typedef EpiBf16T<true> EpiBf16F8;
__device__ __forceinline__ float clamp448(float x) { return __builtin_fminf(__builtin_fmaxf(x, -448.0f), 448.0f); }
__device__ __forceinline__ unsigned pk4_fp8(float a, float b, float c, float d) { unsigned w = 0u; w = __builtin_amdgcn_cvt_pk_fp8_f32(a, b, w, false); w = __builtin_amdgcn_cvt_pk_fp8_f32(c, d, w, true); return w; }
struct EpiSwigluF8 {
    static constexpr bool PERM = true, AFTER_DRAIN = false, F8 = true;
    unsigned char* O; int ldc; float in_inv, out_scale;
    __device__ __forceinline__ void operator()(const f32x4 (&acc)[2][2][4][2], const Unit& u, int wr, int wc, int fr, int fq) const {
        const int row0 = u.pm * BM + wr * 64 + fr; const int col0 = u.pn * HALF + wc * 32 + 8 * fq;
#pragma unroll
        for (int ai = 0; ai < 2; ++ai)
#pragma unroll
            for (int m = 0; m < 4; ++m) { unsigned char* rowp = O + (size_t)(row0 + ai * HALF + m * 16) * ldc + col0;
                const f32x4 G0 = acc[ai][0][m][0], G1 = acc[ai][0][m][1], U0 = acc[ai][1][m][0], U1 = acc[ai][1][m][1];
                const float ce = -in_inv * 1.4426950408889634f, cm = in_inv * in_inv * out_scale;
                float h0[4], h1[4];
#pragma unroll
                for (int j = 0; j < 4; ++j) { h0[j] = clamp448((G0[j] * U0[j]) * (cm * __builtin_amdgcn_rcpf(1.0f + __builtin_amdgcn_exp2f(G0[j] * ce)))); h1[j] = clamp448((G1[j] * U1[j]) * (cm * __builtin_amdgcn_rcpf(1.0f + __builtin_amdgcn_exp2f(G1[j] * ce)))); }
                typedef unsigned u32x2 __attribute__((ext_vector_type(2)));
                u32x2 w; w.x = pk4_fp8(h0[0], h0[1], h0[2], h0[3]); w.y = pk4_fp8(h1[0], h1[1], h1[2], h1[3]);
                *(u32x2*)rowp = w; }
    }
};
struct EpiSwiglu {
    static constexpr bool PERM = true, AFTER_DRAIN = false, F8 = false;
    bf16_t* O; int ldc;
    __device__ __forceinline__ void operator()(const f32x4 (&acc)[2][2][4][2], const Unit& u, int wr, int wc, int fr, int fq) const {
        const int row0 = u.pm * BM + wr * 64 + fr; const int col0 = u.pn * HALF + wc * 32 + 8 * fq;
#pragma unroll
        for (int ai = 0; ai < 2; ++ai)
#pragma unroll
            for (int m = 0; m < 4; ++m) { bf16_t* rowp = O + (size_t)(row0 + ai * HALF + m * 16) * ldc + col0;
                const f32x4 g0 = acc[ai][0][m][0], g1 = acc[ai][0][m][1], u0 = acc[ai][1][m][0], u1 = acc[ai][1][m][1];
                u32x4 w; w.x = cvt_pk_bf16(silu_f(g0[0]) * u0[0], silu_f(g0[1]) * u0[1]); w.y = cvt_pk_bf16(silu_f(g0[2]) * u0[2], silu_f(g0[3]) * u0[3]);
                w.z = cvt_pk_bf16(silu_f(g1[0]) * u1[0], silu_f(g1[1]) * u1[1]); w.w = cvt_pk_bf16(silu_f(g1[2]) * u1[2], silu_f(g1[3]) * u1[3]);
                *(u32x4*)rowp = w; }
    }
};

template <class Epi, class Sched, bool ALIGN_EPI = false, bool SP2 = false>
__device__ __forceinline__ void gemm_phase(PG8_LAS unsigned char* lds, const Gemm g, const Sched& S, const Epi& E) {
    int tid_ = threadIdx.x; asm volatile("" : "+v"(tid_));
    const int tid = tid_ & 511, wid = __builtin_amdgcn_readfirstlane(tid >> 6), lane = tid & 63, wr = wid >> 2, wc = wid & 3, fr = lane & 15, fq = lane >> 4;
    const int K = g.K, nt = K / BK;
    unsigned voffA[2], voffB[2];
#pragma unroll
    for (int i = 0; i < 2; ++i) { int R, C; stage_rc(tid * 16 + i * 8192, R, C); const int Rb = Epi::PERM ? ((R & ~31) + perm32(R & 31)) : R;
        voffA[i] = (unsigned)(R * K + C) * 2u; voffB[i] = (unsigned)(Rb * K + C) * 2u; }
    const size_t kstep = (size_t)(BK * 2);
    const size_t hstep = (size_t)HALF * K * 2;
    const size_t tstep = 2 * hstep;
    const unsigned ldsw = (unsigned)wid * 1024u;
    const int aoff = lds_byte(wr * 64 + fr, fq * 8), boff = lds_byte(wc * 32 + fr, fq * 8);
#define PG8_SA(b, h) (((b) * 2 + (h)) * HTB)
#define PG8_SB(b, h) ((4 + (b) * 2 + (h)) * HTB)
#define PG8_STAGE(bufoff, gbase, voff) do { _Pragma("unroll") for (int _i = 0; _i < 2; ++_i) \
        __builtin_amdgcn_global_load_lds((const unsigned*)((const char*)(gbase) + (voff)[_i]), (PG8_LAS unsigned*)(lds + (bufoff) + ldsw + _i * 8192), 16, 0, 0); } while (0)
#define PG8_LD16(off) (*(const PG8_LAS v4i_t*)(lds + (off)))
#define PG8_LDA(dst, b, h) do { _Pragma("unroll") for (int m = 0; m < 4; ++m) { if constexpr (Epi::F8) { const v4i_t lo_ = PG8_LD16(PG8_SA(b, h) + aoff + m * 2048), hi_ = PG8_LD16(PG8_SA(b, h) + aoff + m * 2048 + 1024); dst##8[m] = __builtin_shufflevector(lo_, hi_, 0, 1, 2, 3, 4, 5, 6, 7); } \
        else { _Pragma("unroll") for (int k = 0; k < 2; ++k) dst[m][k] = *(const PG8_LAS bf16x8*)(lds + PG8_SA(b, h) + aoff + m * 2048 + k * 1024); } } } while (0)
#define PG8_LDB(dst, b, h) do { _Pragma("unroll") for (int n = 0; n < 2; ++n) { if constexpr (Epi::F8) { const v4i_t lo_ = PG8_LD16(PG8_SB(b, h) + boff + n * 2048), hi_ = PG8_LD16(PG8_SB(b, h) + boff + n * 2048 + 1024); dst##8[n] = __builtin_shufflevector(lo_, hi_, 0, 1, 2, 3, 4, 5, 6, 7); } \
        else { _Pragma("unroll") for (int k = 0; k < 2; ++k) dst[n][k] = *(const PG8_LAS bf16x8*)(lds + PG8_SB(b, h) + boff + n * 2048 + k * 1024); } } } while (0)
#define PG8_MMA(ai, bj, At, Bt) do { __builtin_amdgcn_s_setprio(1); _Pragma("unroll") for (int m = 0; m < 4; ++m) _Pragma("unroll") for (int n = 0; n < 2; ++n) { \
        if constexpr (Epi::F8) { asm volatile("v_mfma_f32_16x16x128_f8f6f4 %0, %1, %2, %0" : "+v"(acc[ai][bj][m][n]) : "v"(Bt##8[n]), "v"(At##8[m])); } \
        else { _Pragma("unroll") for (int k = 0; k < 2; ++k) acc[ai][bj][m][n] = __builtin_amdgcn_mfma_f32_16x16x32_bf16(Bt[n][k], At[m][k], acc[ai][bj][m][n], 0, 0, 0); } } \
        __builtin_amdgcn_s_setprio(0); } while (0)
#define PG8_WAIT_V(n) asm volatile("s_waitcnt vmcnt(" #n ")" ::: "memory")
#define PG8_WAIT_L(n) asm volatile("s_waitcnt lgkmcnt(" #n ")" ::: "memory")
#define PG8_BAR __builtin_amdgcn_s_barrier()
#define PG8_SCHED __builtin_amdgcn_sched_barrier(0)
    Unit cur, nxt; int ui = 0;
    if (!S.next(0, cur)) return;
    f32x4 acc[2][2][4][2];
#pragma unroll
    for (int a = 0; a < 2; ++a)
#pragma unroll
        for (int b = 0; b < 2; ++b)
#pragma unroll
            for (int m = 0; m < 4; ++m)
#pragma unroll
                for (int n = 0; n < 2; ++n) acc[a][b][m][n] = (f32x4){0.f, 0.f, 0.f, 0.f};
    bf16x8 At[4][2], B0[2][2], B1[2][2]; v8i_t At8[4], B08[2], B18[2];
    const char* cA = (const char*)g.A + (size_t)cur.pm * tstep; const char* cB = (const char*)g.Bt + (size_t)cur.pb * tstep;
    S.a_ready(cur);
    if constexpr (SP2) {
        PG8_STAGE(PG8_SB(0, 0), cB, voffB); PG8_STAGE(PG8_SB(0, 1), cB + hstep, voffB); PG8_STAGE(PG8_SA(0, 0), cA, voffA); PG8_STAGE(PG8_SA(0, 1), cA + hstep, voffA);
        if (wr == 1) PG8_BAR;
        PG8_WAIT_V(2); PG8_BAR;
        PG8_STAGE(PG8_SB(1, 0), cB + kstep, voffB); PG8_STAGE(PG8_SA(1, 0), cA + kstep, voffA); PG8_STAGE(PG8_SB(1, 1), cB + hstep + kstep, voffB);
        PG8_WAIT_V(6); PG8_BAR;
    } else {
        PG8_STAGE(PG8_SB(0, 0), cB, voffB); PG8_STAGE(PG8_SA(0, 0), cA, voffA); PG8_STAGE(PG8_SB(0, 1), cB + hstep, voffB); PG8_STAGE(PG8_SA(0, 1), cA + hstep, voffA);
        if (wr == 1) PG8_BAR;
        PG8_WAIT_V(4); PG8_BAR;
        PG8_STAGE(PG8_SB(1, 0), cB + kstep, voffB); PG8_STAGE(PG8_SA(1, 0), cA + kstep, voffA); PG8_STAGE(PG8_SB(1, 1), cB + hstep + kstep, voffB);
        PG8_WAIT_V(6); PG8_BAR;
    }
    for (;;) {
        const bool has_next = S.next(ui + 1, nxt);
        const char* nA = has_next ? (const char*)g.A + (size_t)nxt.pm * tstep : cA; const char* nB = has_next ? (const char*)g.Bt + (size_t)nxt.pb * tstep : cB;
        for (int t = 0; t < nt; t += 2) {
            const bool last = (t == nt - 2);
            const char* a1 = cA + (size_t)(t + 1) * kstep;
            const char* a2 = last ? nA : cA + (size_t)(t + 2) * kstep; const char* b2 = last ? nB : cB + (size_t)(t + 2) * kstep;
            const char* a3 = a2 + kstep; const char* b3 = b2 + kstep;
            if (last && has_next) S.a_ready(nxt);
            if constexpr (SP2) {
            PG8_LDB(B0, 0, 0); PG8_LDB(B1, 0, 1); PG8_SCHED; PG8_LDA(At, 0, 0); PG8_STAGE(PG8_SA(1, 1), a1 + hstep, voffA);
            PG8_WAIT_V(8); PG8_WAIT_L(0); PG8_BAR; PG8_MMA(0, 0, At, B0); PG8_MMA(0, 1, At, B1); PG8_BAR; PG8_SCHED;
            PG8_LDA(At, 0, 1); PG8_STAGE(PG8_SB(0, 0), b2, voffB); PG8_STAGE(PG8_SB(0, 1), b2 + hstep, voffB); PG8_STAGE(PG8_SA(0, 0), a2, voffA);
            PG8_WAIT_V(8); PG8_WAIT_L(0); PG8_BAR; PG8_MMA(1, 0, At, B0); PG8_MMA(1, 1, At, B1); PG8_BAR; PG8_SCHED;
            PG8_LDB(B0, 1, 0); PG8_LDB(B1, 1, 1); PG8_SCHED; PG8_LDA(At, 1, 0); PG8_STAGE(PG8_SA(0, 1), a2 + hstep, voffA);
            PG8_WAIT_V(8); PG8_WAIT_L(0); PG8_BAR; PG8_MMA(0, 0, At, B0); PG8_MMA(0, 1, At, B1); PG8_BAR; PG8_SCHED;
            PG8_LDA(At, 1, 1); PG8_STAGE(PG8_SB(1, 0), b3, voffB); PG8_STAGE(PG8_SB(1, 1), b3 + hstep, voffB); PG8_STAGE(PG8_SA(1, 0), a3, voffA);
            PG8_WAIT_V(8); PG8_WAIT_L(0); PG8_BAR; PG8_MMA(1, 0, At, B0); PG8_MMA(1, 1, At, B1); PG8_BAR; PG8_SCHED;
            } else {
            PG8_LDB(B0, 0, 0); PG8_SCHED; PG8_LDA(At, 0, 0); PG8_STAGE(PG8_SA(1, 1), a1 + hstep, voffA);
            PG8_WAIT_L(8); PG8_BAR; PG8_WAIT_L(0); PG8_MMA(0, 0, At, B0); PG8_BAR; PG8_SCHED;
            PG8_LDB(B1, 0, 1); PG8_STAGE(PG8_SB(0, 0), b2, voffB);
            PG8_BAR; PG8_WAIT_L(0); PG8_MMA(0, 1, At, B1); PG8_BAR;
            PG8_LDA(At, 0, 1); PG8_STAGE(PG8_SA(0, 0), a2, voffA);
            PG8_BAR; PG8_WAIT_L(0); PG8_MMA(1, 0, At, B0); PG8_BAR; PG8_SCHED;
            PG8_STAGE(PG8_SB(0, 1), b2 + hstep, voffB);
            PG8_WAIT_V(6); PG8_BAR; PG8_MMA(1, 1, At, B1); PG8_BAR;
            PG8_LDB(B0, 1, 0); PG8_SCHED; PG8_LDA(At, 1, 0); PG8_STAGE(PG8_SA(0, 1), a2 + hstep, voffA);
            PG8_WAIT_L(8); PG8_BAR; PG8_WAIT_L(0); PG8_MMA(0, 0, At, B0); PG8_BAR; PG8_SCHED;
            PG8_LDB(B1, 1, 1); PG8_STAGE(PG8_SB(1, 0), b3, voffB);
            PG8_BAR; PG8_WAIT_L(0); PG8_MMA(0, 1, At, B1); PG8_BAR;
            PG8_LDA(At, 1, 1); PG8_STAGE(PG8_SA(1, 0), a3, voffA);
            PG8_BAR; PG8_WAIT_L(0); PG8_MMA(1, 0, At, B0); PG8_BAR; PG8_SCHED;
            PG8_STAGE(PG8_SB(1, 1), b3 + hstep, voffB);
            PG8_WAIT_V(6); PG8_BAR; PG8_MMA(1, 1, At, B1); PG8_BAR;
            }
        }
        if constexpr (Epi::F8) { asm volatile("s_nop 15\n\ts_nop 15" ::: "memory"); }
        if constexpr (ALIGN_EPI) { if (wr == 0) PG8_BAR; }
        if constexpr (!Epi::AFTER_DRAIN) { E(acc, cur, wr, wc, fr, fq); S.done(cur); }
        if (!has_next) break;
#pragma unroll
        for (int a = 0; a < 2; ++a)
#pragma unroll
            for (int b = 0; b < 2; ++b)
#pragma unroll
                for (int m = 0; m < 4; ++m)
#pragma unroll
                    for (int n = 0; n < 2; ++n) acc[a][b][m][n] = (f32x4){0.f, 0.f, 0.f, 0.f};
        cur = nxt; cA = nA; cB = nB; ++ui;
        if constexpr (ALIGN_EPI) { if (wr == 1) PG8_BAR; }
    }
    PG8_WAIT_V(0);
    if constexpr (!ALIGN_EPI) { if (wr == 0) PG8_BAR; }
    PG8_BAR;
    if constexpr (Epi::AFTER_DRAIN) { E.fused(acc, cur, wr, wc, fr, fq, lds, wid, lane); S.done(cur); }
#undef PG8_SA
#undef PG8_SB
#undef PG8_STAGE
#undef PG8_LDA
#undef PG8_LDB
#undef PG8_MMA
#undef PG8_LD16
#undef PG8_WAIT_V
#undef PG8_WAIT_L
#undef PG8_BAR
#undef PG8_SCHED
}
}

#ifndef PG8_SP2
#define PG8_SP2 true
#endif
#ifndef PG8_ALIGN
#define PG8_ALIGN true
#endif
constexpr int D = 1024, SEQ = 8192, NLAT = 16384, CTXL = 256, NCTX = 512, NTOK = NLAT + NCTX;
constexpr int NE = 16, FF = 2816, EVEN_IN = 2560, ODD_IN = 2080;
constexpr int MOE_LAT = 32768, MOE_ROWS = 36864;
constexpr float EPS = 1e-6f;
constexpr int NWAVES = 8;
enum { I_X = 0, I_C, I_CTX, I_CCTX, I_WMOD, I_BMOD, I_NORMG, I_WINE, I_WOUTE, I_CONVW, I_CONVB, I_CLNG, I_CLNB, I_RPB, I_WINO, I_WOUTO, I_POOLW, I_POOLS, I_GATEW, I_GATEB, I_HEADG, I_ROUTER, I_WG, I_WU, I_WD, N_IN };

constexpr size_t MiB = 1u << 20;
constexpr size_t alup(size_t x) { return (x + MiB - 1) / MiB * MiB; }
constexpr size_t WS_CTL = 0, CTL_ZERO_BYTES = MiB;
constexpr size_t WS_MOD = WS_CTL + MiB;
constexpr size_t WS_ROPE = WS_MOD + alup((size_t)2 * 3 * 6144 * 4);
constexpr size_t WS_AFF = WS_ROPE + MiB;
constexpr size_t WS_INV = WS_AFF + alup((size_t)NTOK * 16 * 4);
constexpr size_t WS_ROWTOK = WS_INV + alup((size_t)NTOK * 16 * 4);
constexpr size_t WS_LR = WS_ROWTOK + alup((size_t)MOE_ROWS * 4);
constexpr size_t WS_WINE = WS_LR + alup((size_t)NTOK * 32 * 4);
constexpr size_t WS_WOUTE = WS_WINE + alup((size_t)2560 * 1024 * 2);
constexpr size_t WS_WINO = WS_WOUTE + alup((size_t)1024 * 1024 * 2);
constexpr size_t WS_WOUTO = WS_WINO + alup((size_t)2080 * 1024 * 2);
constexpr size_t WS_POOLW = WS_WOUTO + alup((size_t)1024 * 1024 * 2);
constexpr size_t WS_W1 = WS_POOLW + MiB;
constexpr size_t WS_W2 = WS_W1 + alup((size_t)2 * 16 * 5632 * 1024 * 2);
constexpr size_t WS_H = WS_W2 + alup((size_t)2 * 16 * 1024 * 2816 * 2);
constexpr size_t WS_X1 = WS_H + alup((size_t)NTOK * 1024 * 2);
constexpr size_t WS_XN2 = WS_X1 + alup((size_t)NTOK * 1024 * 4);
constexpr size_t WS_PBUF = WS_XN2 + alup((size_t)NTOK * 1024 * 2);
constexpr size_t WS_MIX = WS_PBUF + alup((size_t)NTOK * 2560 * 2);
constexpr size_t WS_YO = WS_MIX + alup((size_t)NTOK * 1024 * 2);
constexpr size_t WS_MOE = WS_YO + alup((size_t)NTOK * 1024 * 2);
constexpr size_t WS_XG = WS_MOE;
constexpr size_t WS_HID = WS_XG + alup((size_t)MOE_ROWS * 1024 * 2);
constexpr size_t WS_Y = WS_HID + alup((size_t)MOE_ROWS * 2816 * 2);
constexpr size_t WS_END = WS_Y + alup((size_t)MOE_ROWS * 1024 * 2);
constexpr size_t WS_DPOOL = WS_MOE;
constexpr size_t WS_QR = WS_DPOOL + alup((size_t)NLAT * 512 * 2);
constexpr size_t WS_KR = WS_QR + alup((size_t)NLAT * 256 * 4);
constexpr size_t WS_GF = WS_KR + alup((size_t)NTOK * 256 * 4);
constexpr size_t WS_GB = WS_GF + alup((size_t)NTOK * 256 * 4);
constexpr size_t WS_QE = WS_GB + alup((size_t)NTOK * 256 * 4);
constexpr size_t WS_KD = WS_QE + alup((size_t)2 * NLAT * 256 * 2);
constexpr size_t WS_UT = WS_KD + alup((size_t)2 * NLAT * 256 * 2);
constexpr size_t WS_DC = WS_UT + alup((size_t)16 * 132 * 8192 * 4);
constexpr size_t WS_ST = WS_DC + MiB;
constexpr size_t WS_OACC = WS_ST + alup((size_t)16 * 128 * 8192 * 2);
constexpr size_t WS_GLA_END = WS_OACC + alup((size_t)2 * NLAT * 512 * 4);
static_assert(WS_GLA_END <= WS_END, "overlay fits");
constexpr int CW_TMO = 0, CW_BAR = 4096;

constexpr int RING_OFF = 0, RING_BYTES = 131072;
constexpr int LDSCTL_OFF = RING_BYTES, MISC_OFF = LDSCTL_OFF + 320;
constexpr int LDS_BYTES = 147456;

#define GAS __attribute__((address_space(1)))
#define LAS __attribute__((address_space(3)))
typedef unsigned short bf16;
typedef unsigned v4u __attribute__((ext_vector_type(4)));
typedef unsigned v2u __attribute__((ext_vector_type(2)));
typedef float f32x4 __attribute__((ext_vector_type(4)));
typedef short bf16x8 __attribute__((ext_vector_type(8)));
typedef GAS unsigned gu32;
#define RLX_AGENT __ATOMIC_RELAXED, __HIP_MEMORY_SCOPE_AGENT
#define LDS_WAIT() asm volatile("s_waitcnt lgkmcnt(0)" ::: "memory")
#define VM_WAIT() asm volatile("s_waitcnt vmcnt(0)" ::: "memory")
__device__ __forceinline__ unsigned f2bf(float f) { unsigned u = __builtin_bit_cast(unsigned, f); return (u + 0x7fffu + ((u >> 16) & 1u)) >> 16; }
typedef float f32x2_c __attribute__((ext_vector_type(2)));
typedef __bf16 bf16x2_c __attribute__((ext_vector_type(2)));
__device__ __forceinline__ unsigned pk2(float lo, float hi) { f32x2_c v; v.x = lo; v.y = hi; const bf16x2_c r = __builtin_convertvector(v, bf16x2_c); return __builtin_bit_cast(unsigned, r); }
__device__ __forceinline__ float bflo(unsigned w) { return __builtin_bit_cast(float, w << 16); }
__device__ __forceinline__ float bfhi(unsigned w) { return __builtin_bit_cast(float, w & 0xffff0000u); }
__device__ __forceinline__ float bf2f(bf16 b) { return __builtin_bit_cast(float, ((unsigned)b) << 16); }
template <int CTRL> __device__ __forceinline__ float dpp_mov(float v) { return __builtin_bit_cast(float, __builtin_amdgcn_update_dpp(0, __builtin_bit_cast(int, v), CTRL, 0xF, 0xF, true)); }
__device__ __forceinline__ float lane_xor1(float v) { return dpp_mov<0xB1>(v); }
__device__ __forceinline__ float lane_xor2(float v) { return dpp_mov<0x4E>(v); }
__device__ __forceinline__ float lane_xor4(float v) { return dpp_mov<0x1B>(dpp_mov<0x141>(v)); }
__device__ __forceinline__ float lane_xor8(float v) { return dpp_mov<0x141>(dpp_mov<0x140>(v)); }
__device__ __forceinline__ float row16_sum(float v) { v += lane_xor1(v); v += lane_xor2(v); v += dpp_mov<0x141>(v); v += dpp_mov<0x140>(v); return v; }
__device__ __forceinline__ float wave_sum(float v) {
    v = row16_sum(v); const int b = __builtin_bit_cast(int, v);
    const float r0 = __builtin_bit_cast(float, __builtin_amdgcn_readlane(b, 0)), r1 = __builtin_bit_cast(float, __builtin_amdgcn_readlane(b, 16)), r2 = __builtin_bit_cast(float, __builtin_amdgcn_readlane(b, 32)), r3 = __builtin_bit_cast(float, __builtin_amdgcn_readlane(b, 48));
    return (r0 + r1) + (r2 + r3);
}
typedef unsigned u32x2_t __attribute__((ext_vector_type(2)));
__device__ __forceinline__ void swap16(float v, float& own, float& other) { const u32x2_t r = __builtin_amdgcn_permlane16_swap(__builtin_bit_cast(unsigned, v), __builtin_bit_cast(unsigned, v), false, false); const unsigned r0 = r.x, r1 = r.y; own = __builtin_bit_cast(float, r0); other = __builtin_bit_cast(float, r1); }
__device__ __forceinline__ void swap32(float v, float& own, float& other) { const u32x2_t r = __builtin_amdgcn_permlane32_swap(__builtin_bit_cast(unsigned, v), __builtin_bit_cast(unsigned, v), false, false); const unsigned r0 = r.x, r1 = r.y; own = __builtin_bit_cast(float, r0); other = __builtin_bit_cast(float, r1); }
__device__ __forceinline__ float xor16_max(float v) { float a, b; swap16(v, a, b); return fmaxf(a, b); }
__device__ __forceinline__ float xor32_max(float v) { float a, b; swap32(v, a, b); return fmaxf(a, b); }
__device__ __forceinline__ float xor16_sum(float v) { float a, b; swap16(v, a, b); return a + b; }
__device__ __forceinline__ float xor32_sum(float v) { float a, b; swap32(v, a, b); return a + b; }
__device__ __forceinline__ float silu(float x) { return x / (1.0f + __expf(-x)); }
__device__ __forceinline__ float sigmoidf(float x) { return 1.0f / (1.0f + __expf(-x)); }
#define XB_TMO      128
#define XB_XCNT(j)  (256  + 64 * (j))
#define XB_XSUB(j)  (1280 + 64 * (j))
#define XB_XGEN(j)  (2304 + 64 * (j))
#define XB_TOP      3328
#define XB_TOPGEN   3392
#define XCD_BAR_WORDS 3456
#define XB_SPIN_CAP (1u << 18)

__device__ __forceinline__ unsigned xb_ld(unsigned* p)              { return __hip_atomic_load(p, __ATOMIC_RELAXED, __HIP_MEMORY_SCOPE_AGENT); }
__device__ __forceinline__ unsigned xb_add(unsigned* p, unsigned v) { return __hip_atomic_fetch_add(p, v, __ATOMIC_RELAXED, __HIP_MEMORY_SCOPE_AGENT); }
__device__ __forceinline__ unsigned xb_xcc_id() { return (unsigned)__builtin_amdgcn_s_getreg((3 << 11) | 20) & 0xFu; }
#define XB_SPIN(cond, bar) do { unsigned _sp = 0; while (cond) { __builtin_amdgcn_s_sleep(1); \
    if ((++_sp & 255u) == 0u) { if (xb_ld(&(bar)[XB_TMO])) break; if (_sp > XB_SPIN_CAP) { atomicAdd(&(bar)[XB_TMO], 1u); break; } } } } while (0)

struct XcdBarrier {
    unsigned* bar; unsigned x;
    volatile LAS unsigned* st;
};

__device__ __forceinline__ XcdBarrier xcd_barrier_post(unsigned* bar, volatile LAS unsigned* st) {
    XcdBarrier b; b.bar = bar; b.x = xb_xcc_id(); b.st = st;
    if (threadIdx.x == 0) (void)xb_add(&bar[XB_XCNT(b.x)], 1u);
    return b;
}
__device__ __forceinline__ void xcd_barrier_complete(unsigned* bar, unsigned x, unsigned& nloc, unsigned& nx) {
    const unsigned G = gridDim.x * gridDim.y * gridDim.z;
    unsigned sum, cnt, mine, sp = 0u;
    for (;;) {
        sum = 0u; cnt = 0u; mine = 0u;
#pragma unroll
        for (unsigned j = 0; j < 16; ++j) { const unsigned c = xb_ld(&bar[XB_XCNT(j)]); sum += c; cnt += (c > 0u) ? 1u : 0u; mine = (j == x) ? c : mine; }
        if (sum == G) break;
        __builtin_amdgcn_s_sleep(1);
        if ((++sp & 255u) == 0u) { if (xb_ld(&bar[XB_TMO])) break; if (sp > XB_SPIN_CAP) { atomicAdd(&bar[XB_TMO], 1u); break; } }
    }
    nloc = mine > 0u ? mine : 1u; nx = cnt > 0u ? cnt : 1u;
}

__device__ __forceinline__ void xcd_barrier(const XcdBarrier& b) {
    asm volatile("s_waitcnt vmcnt(0)" ::: "memory");
    __syncthreads();
    if (threadIdx.x == 0) {
        unsigned* bar = b.bar;
        __builtin_amdgcn_s_waitcnt(0);
        unsigned nloc = b.st[0], nx = b.st[1];
        if (nloc == 0u) { xcd_barrier_complete(bar, b.x, nloc, nx); b.st[0] = nloc; b.st[1] = nx; }
        const unsigned old = xb_add(&bar[XB_XSUB(b.x)], 1u);
        const unsigned gen = old / nloc;
        if (old + 1u == (gen + 1u) * nloc) {
            __builtin_amdgcn_fence(__ATOMIC_RELEASE, "agent");
            asm volatile("s_waitcnt vmcnt(0)" ::: "memory");
            const unsigned og = xb_add(&bar[XB_TOP], 1u);
            const unsigned tg = og / nx;
            if (og + 1u == (tg + 1u) * nx) xb_add(&bar[XB_TOPGEN], 1u);
            else XB_SPIN(xb_ld(&bar[XB_TOPGEN]) == tg, bar);
            __builtin_amdgcn_fence(__ATOMIC_ACQUIRE, "agent");
            xb_add(&bar[XB_XGEN(b.x)], 1u);
            asm volatile("s_waitcnt vmcnt(0)" ::: "memory");
        } else {
            XB_SPIN(xb_ld(&bar[XB_XGEN(b.x)]) == gen, bar);
            __builtin_amdgcn_fence(__ATOMIC_ACQUIRE, "agent");
            asm volatile("s_waitcnt vmcnt(0)" ::: "memory");
        }
    }
    __syncthreads();
}
__device__ __forceinline__ void xcd_barrier_arrive(const XcdBarrier& b) {
    asm volatile("s_waitcnt vmcnt(0)" ::: "memory");
    __syncthreads();
    if (threadIdx.x == 0) {
        unsigned* bar = b.bar;
        __builtin_amdgcn_s_waitcnt(0);
        unsigned nloc = b.st[0], nx = b.st[1];
        if (nloc == 0u) { xcd_barrier_complete(bar, b.x, nloc, nx); b.st[0] = nloc; b.st[1] = nx; }
        const unsigned old = xb_add(&bar[XB_XSUB(b.x)], 1u);
        const unsigned gen = old / nloc;
        if (old + 1u == (gen + 1u) * nloc) {
            __builtin_amdgcn_fence(__ATOMIC_RELEASE, "agent");
            asm volatile("s_waitcnt vmcnt(0)" ::: "memory");
            const unsigned og = xb_add(&bar[XB_TOP], 1u);
            const unsigned tg = og / nx;
            if (og + 1u == (tg + 1u) * nx) xb_add(&bar[XB_TOPGEN], 1u);
        }
        b.st[2] = gen; b.st[3] = (old + 1u == (gen + 1u) * nloc) ? 1u : 0u;
    }
    __syncthreads();
}
__device__ __forceinline__ void xcd_barrier_wait(const XcdBarrier& b) {
    if (threadIdx.x == 0) {
        unsigned* bar = b.bar;
        const unsigned gen = b.st[2];
        XB_SPIN(xb_ld(&bar[XB_TOPGEN]) == gen, bar);
        __builtin_amdgcn_fence(__ATOMIC_ACQUIRE, "agent");
        asm volatile("s_waitcnt vmcnt(0)" ::: "memory");
    }
    __syncthreads();
}

#define CAS __attribute__((address_space(4)))
struct Args { const float* in[N_IN]; float* out; unsigned char* ws; int ph_lo, ph_hi; };
struct Ctx {
    LAS unsigned char* lds;
    const CAS Args* a; float* out; unsigned char* ws;
    int tid, lane, wave, G, gw, ngw;
};
#define WSP(T, off) ((T*)(c.ws + (off)))

__device__ __forceinline__ f32x4 wave_tile16(const bf16* A, int lda, const bf16* Bt, int ldb, int K, int lane) {
    const bf16* ap = A + (size_t)(lane & 15) * lda + 8 * (lane >> 4);
    const bf16* bp = Bt + (size_t)(lane & 15) * ldb + 8 * (lane >> 4);
    f32x4 acc = {0.f, 0.f, 0.f, 0.f};
#pragma unroll 16
    for (int k = 0; k < K; k += 32) {
        const bf16x8 a = *(const bf16x8*)(ap + k), b = *(const bf16x8*)(bp + k);
        acc = __builtin_amdgcn_mfma_f32_16x16x32_bf16(b, a, acc, 0, 0, 0);
    }
    return acc;
}

__device__ __forceinline__ void wave_tile32x16(const bf16* A, int lda, const bf16* Bt, int ldb, int K, int lane, f32x4 (&acc)[2]) {
    const bf16* ap = A + (size_t)(lane & 15) * lda + 8 * (lane >> 4);
    const bf16* bp = Bt + (size_t)(lane & 15) * ldb + 8 * (lane >> 4);
    acc[0] = (f32x4){0.f, 0.f, 0.f, 0.f}; acc[1] = (f32x4){0.f, 0.f, 0.f, 0.f};
#pragma unroll 8
    for (int k = 0; k < K; k += 32) {
        const bf16x8 a0 = *(const bf16x8*)(ap + k), a1 = *(const bf16x8*)(ap + (size_t)16 * lda + k), b0 = *(const bf16x8*)(bp + k);
        acc[0] = __builtin_amdgcn_mfma_f32_16x16x32_bf16(b0, a0, acc[0], 0, 0, 0); acc[1] = __builtin_amdgcn_mfma_f32_16x16x32_bf16(b0, a1, acc[1], 0, 0, 0);
    }
}

__device__ __forceinline__ void transpose_tile(const float* W, int N, int k0, int n0, bf16* dst, int ldd, LAS float* scr, int lane) {
#pragma unroll 8
    for (int i = 0; i < 32; ++i) { const int kk = 2 * i + (lane >> 5); scr[kk * 33 + (lane & 31)] = W[(size_t)(k0 + kk) * N + n0 + (lane & 31)]; }
    LDS_WAIT(); asm volatile("" ::: "memory");
    const int cc = lane & 7;
#pragma unroll
    for (int j = 0; j < 4; ++j) { const int n = (lane >> 3) + 8 * j; const LAS float* s = scr + (8 * cc) * 33 + n;
        v4u o; o.x = pk2(s[0 * 33], s[1 * 33]); o.y = pk2(s[2 * 33], s[3 * 33]); o.z = pk2(s[4 * 33], s[5 * 33]); o.w = pk2(s[6 * 33], s[7 * 33]);
        *(v4u*)(dst + (size_t)n * ldd + 8 * cc) = o; }
    LDS_WAIT(); asm volatile("" ::: "memory");
}

constexpr float SC_W = 64.0f, SC_X = 16.0f, SC_H = 8.0f;
__device__ __forceinline__ void transpose64_f8(const float* W, int N, int k0, int n0, unsigned char* dst, int ldd, LAS float* scr, int lane) {
    const int cq = lane & 15, rq = lane >> 4;
    f32x4 v[16];
#pragma unroll
    for (int i = 0; i < 16; ++i) v[i] = *(const f32x4*)(W + (size_t)(k0 + rq + 4 * i) * N + n0 + 4 * cq);
#pragma unroll
    for (int i = 0; i < 16; ++i) *(LAS f32x4*)(scr + (rq + 4 * i) * 64 + 4 * cq) = v[i];
    LDS_WAIT(); asm volatile("" ::: "memory");
    unsigned o[16];
#pragma unroll
    for (int j = 0; j < 16; ++j) o[j] = pg8::pk4_fp8(scr[(4 * j) * 64 + lane] * SC_W, scr[(4 * j + 1) * 64 + lane] * SC_W, scr[(4 * j + 2) * 64 + lane] * SC_W, scr[(4 * j + 3) * 64 + lane] * SC_W);
#pragma unroll
    for (int t = 0; t < 4; ++t) { v4u w; w.x = o[4 * t]; w.y = o[4 * t + 1]; w.z = o[4 * t + 2]; w.w = o[4 * t + 3]; *(v4u*)(dst + (size_t)lane * ldd + 16 * t) = w; }
    LDS_WAIT(); asm volatile("" ::: "memory");
}

constexpr int CV_NIT = 32 * 528;
constexpr int CV_FILL = 8448 + 960;
__device__ __forceinline__ int cv_fill() { return gridDim.x == 256 ? CV_FILL : 0; }
__device__ __forceinline__ void convert_tiles(const Ctx& c, unsigned* qctr, int first, int base, int limit, int maxn) {
    volatile LAS unsigned* qslot = (volatile LAS unsigned*)(c.lds + MISC_OFF) + 16;
    f32x4 v[8];
    int it = first, buf = 0, par = 0, done = 0;
    if (first < 0) { if (c.tid == 0) qslot[2] = (unsigned)base + __hip_atomic_fetch_add(qctr, 1u, __ATOMIC_RELAXED, __HIP_MEMORY_SCOPE_AGENT); __syncthreads(); it = (int)qslot[2]; }
    const float* src = nullptr; int N = 0, k0 = 0, n0 = 0, le = 0, which = 0;
#define PRO_DECODE(IT) do { le = (IT) / 528; const int q_ = (IT) % 528; which = q_ / 176; const int r_ = q_ % 176; \
        if (which < 2) { n0 = 256 * (r_ / 16); k0 = 64 * (r_ % 16); N = 2816; src = c.a->in[which ? I_WU : I_WG] + (size_t)le * 1024 * 2816; } \
        else { n0 = 256 * (r_ / 44); k0 = 64 * (r_ % 44); N = 1024; src = c.a->in[I_WD] + (size_t)le * 2816 * 1024; } } while (0)
#define PRO_LOAD() do { _Pragma("unroll") for (int i = 0; i < 8; ++i) v[i] = __builtin_nontemporal_load((const f32x4*)(src + (size_t)(k0 + 8 * c.wave + i) * N + n0 + 4 * c.lane)); } while (0)
    if (it < limit) { PRO_DECODE(it); PRO_LOAD(); }
    while (it < limit) {
        ++done;
        unsigned nx = (unsigned)limit; if (c.tid == 0 && done < maxn) nx = (unsigned)base + __hip_atomic_fetch_add(qctr, 1u, __ATOMIC_RELAXED, __HIP_MEMORY_SCOPE_AGENT);
        LAS float* img = (LAS float*)(c.lds + buf * 65536);
#pragma unroll
        for (int i = 0; i < 8; ++i) *(LAS f32x4*)(img + (8 * c.wave + i) * 256 + 4 * c.lane) = v[i];
        const int n = n0 + (c.tid & 255), kh = c.tid >> 8;
        unsigned char* dst = which < 2 ? WSP(unsigned char, WS_W1) + ((size_t)le * 5632 + (n / 128) * 256 + (n % 128) + which * 128) * 1024 + k0 + 32 * kh
                                       : WSP(unsigned char, WS_W2) + ((size_t)le * 1024 + n) * 2816 + k0 + 32 * kh;
        if (c.tid == 0) qslot[par] = nx;
        __syncthreads();
        const int nxt = (int)qslot[par];
        if (nxt < limit) { PRO_DECODE(nxt); PRO_LOAD(); }
        const LAS float* s = img + (32 * kh) * 256 + (c.tid & 255);
#pragma unroll
        for (int t = 0; t < 2; ++t) { v4u w;
            w.x = pg8::pk4_fp8(s[(16 * t + 0) * 256] * SC_W, s[(16 * t + 1) * 256] * SC_W, s[(16 * t + 2) * 256] * SC_W, s[(16 * t + 3) * 256] * SC_W);
            w.y = pg8::pk4_fp8(s[(16 * t + 4) * 256] * SC_W, s[(16 * t + 5) * 256] * SC_W, s[(16 * t + 6) * 256] * SC_W, s[(16 * t + 7) * 256] * SC_W);
            w.z = pg8::pk4_fp8(s[(16 * t + 8) * 256] * SC_W, s[(16 * t + 9) * 256] * SC_W, s[(16 * t + 10) * 256] * SC_W, s[(16 * t + 11) * 256] * SC_W);
            w.w = pg8::pk4_fp8(s[(16 * t + 12) * 256] * SC_W, s[(16 * t + 13) * 256] * SC_W, s[(16 * t + 14) * 256] * SC_W, s[(16 * t + 15) * 256] * SC_W);
            *(v4u*)(dst + 16 * t) = w; }
        it = nxt; buf ^= 1; par ^= 1;
    }
    __syncthreads();
#undef PRO_DECODE
#undef PRO_LOAD
}
__device__ __forceinline__ void convert_fill(const Ctx& c, int maxn) { convert_tiles(c, (unsigned*)(c.ws + WS_CTL) + 2048 + 64, -1, CV_NIT - cv_fill(), CV_NIT, maxn); }

constexpr int TI_WINE = (1024 / 64) * (2560 / 32), TI_WOUT = (1024 / 64) * (1024 / 32), TI_WINO = (1024 / 64) * (2080 / 32), TI_POOL = 4 * 2 * 4;
constexpr int TI_SMALL = TI_WINE + 2 * TI_WOUT + TI_WINO + TI_POOL;
constexpr int TI_GU = (1024 / 64) * (2816 / 64), TI_DN = (2816 / 64) * (1024 / 64);
constexpr int TI_PER_LE = 2 * TI_GU + TI_DN;
constexpr int TI_TOTAL = TI_SMALL + 32 * TI_PER_LE;

constexpr int MOD0_FLAG = 2048 + 128;
__device__ __forceinline__ void ph_prologue(const Ctx& c) {
    if (blockIdx.x < 192) {
        LAS float* sl = (LAS float*)c.lds;
        LAS float* red = sl + 3 * 1024;
        for (int i = c.tid; i < 3072; i += 512) { const int s = i >> 10, k = i & 1023; const float v = s < 2 ? c.a->in[I_C][s * 1024 + k] : c.a->in[I_CCTX][k]; sl[i] = silu(v); }
        __syncthreads();
        const int item = blockIdx.x, l = item / 96, j = 64 * (item % 96) + c.lane;
        const float* W = c.a->in[I_WMOD] + (size_t)l * 1024 * 6144 + j;
        float a0 = 0.f, a1 = 0.f, a2 = 0.f;
#pragma unroll 8
        for (int kk = 0; kk < 128; ++kk) { const int k = c.wave * 128 + kk; const float w = W[(size_t)k * 6144]; a0 += sl[k] * w; a1 += sl[1024 + k] * w; a2 += sl[2048 + k] * w; }
        red[(c.wave * 3 + 0) * 64 + c.lane] = a0; red[(c.wave * 3 + 1) * 64 + c.lane] = a1; red[(c.wave * 3 + 2) * 64 + c.lane] = a2;
        __syncthreads();
        if (c.wave < 3) { float s = 0.f;
#pragma unroll
            for (int w = 0; w < 8; ++w) s += red[(w * 3 + c.wave) * 64 + c.lane];
            WSP(float, WS_MOD)[(l * 3 + c.wave) * 6144 + j] = s + c.a->in[I_BMOD][l * 6144 + j]; }
        asm volatile("s_waitcnt vmcnt(0)" ::: "memory");
        __syncthreads();
        if (blockIdx.x < 32 && c.tid == 0) { __builtin_amdgcn_fence(__ATOMIC_RELEASE, "agent"); asm volatile("s_waitcnt vmcnt(0)" ::: "memory"); xb_add((unsigned*)(c.ws + WS_CTL) + MOD0_FLAG, 1u); }
    }
    { const int g = blockIdx.x * 512 + c.tid;
      if (g < 192 * 16) { const int pos = g >> 4, f = g & 15; const float inv = powf(10000.0f, -(float)f / 16.0f); const float ang = (float)(pos < 128 ? pos : pos - 128) * inv;
          float sn, cs; sincosf(ang, &sn, &cs); float* T = WSP(float, WS_ROPE); T[g * 2] = cs; T[g * 2 + 1] = sn; } }
    LAS float* scr = (LAS float*)(c.lds + c.wave * 16384);
    for (int it = c.gw; it < TI_SMALL; it += c.ngw) {
        int r = it;
        {
            if (r < TI_WINE) { const int nb = 2560 / 32, kb = r / nb, n0 = 32 * (r % nb); transpose_tile(c.a->in[I_WINE], 2560, 64 * kb, n0, WSP(bf16, WS_WINE) + (size_t)n0 * 1024 + 64 * kb, 1024, scr, c.lane); continue; } r -= TI_WINE;
            if (r < TI_WOUT) { const int nb = 32, kb = r / nb, n0 = 32 * (r % nb); transpose_tile(c.a->in[I_WOUTE], 1024, 64 * kb, n0, WSP(bf16, WS_WOUTE) + (size_t)n0 * 1024 + 64 * kb, 1024, scr, c.lane); continue; } r -= TI_WOUT;
            if (r < TI_WOUT) { const int nb = 32, kb = r / nb, n0 = 32 * (r % nb); transpose_tile(c.a->in[I_WOUTO], 1024, 64 * kb, n0, WSP(bf16, WS_WOUTO) + (size_t)n0 * 1024 + 64 * kb, 1024, scr, c.lane); continue; } r -= TI_WOUT;
            if (r < TI_WINO) { const int nb = 2080 / 32, kb = r / nb, n0 = 32 * (r % nb); transpose_tile(c.a->in[I_WINO], 2080, 64 * kb, n0, WSP(bf16, WS_WINO) + (size_t)n0 * 1024 + 64 * kb, 1024, scr, c.lane); continue; } r -= TI_WINO;
            { const int g = r / 8, kb = (r % 8) / 4, n0 = 32 * (r % 4);
              transpose_tile(c.a->in[I_POOLW] + (size_t)g * 128 * 128, 128, 64 * kb, n0, WSP(bf16, WS_POOLW) + (size_t)g * 128 * 128 + (size_t)n0 * 128 + 64 * kb, 128, scr, c.lane); continue; }
        }
    }
    __syncthreads();
    convert_tiles(c, (unsigned*)(c.ws + WS_CTL) + 2048, (int)blockIdx.x, (int)c.G, CV_NIT - cv_fill(), 1 << 30);
}

__device__ __forceinline__ void ph_adaln0(const Ctx& c) {
    const f32x4* g4 = (const f32x4*)c.a->in[I_NORMG];
    const int rbase = NTOK / c.ngw, rrem = NTOK - rbase * c.ngw, rrank = c.wave * c.G + (int)blockIdx.x, cnt = rbase + (rrank < rrem ? 1 : 0), m0 = c.gw * rbase, mx = rbase * c.ngw + rrank;
#define ROWI(i) ((i) < rbase ? m0 + (i) : mx)
    const unsigned ln = (unsigned)c.lane;
    if (cnt > 0) {
        int scur = -1; f32x4 G[4], SC[4], SH[4], xn[4];
#define AD_LOAD(M) do { const f32x4* xr_ = (const f32x4*)((M) < NLAT ? c.a->in[I_X] + (size_t)(M) * 1024 : c.a->in[I_CTX] + (size_t)((M) - NLAT) * 1024); _Pragma("unroll") for (int j = 0; j < 4; ++j) xn[j] = xr_[ln + 64u * j]; } while (0)
        AD_LOAD(ROWI(0));
        for (int i = 0; i < cnt; ++i) { const int m = ROWI(i);
            const int s = m < NLAT ? m / SEQ : 2;
            if (s != scur) { scur = s; const f32x4* mod4 = (const f32x4*)(WSP(float, WS_MOD) + (size_t)s * 6144);
#pragma unroll
                for (int j = 0; j < 4; ++j) { G[j] = g4[ln + 64u * j]; SC[j] = (mod4 + 256)[ln + 64u * j] + 1.0f; SH[j] = mod4[ln + 64u * j]; } }
            f32x4 x[4]; float ss = 0.f;
#pragma unroll
            for (int j = 0; j < 4; ++j) { x[j] = xn[j]; ss += (x[j][0] * x[j][0] + x[j][1] * x[j][1]) + (x[j][2] * x[j][2] + x[j][3] * x[j][3]); }
            if (i + 1 < cnt) AD_LOAD(ROWI(i + 1));
            const float rs = 1.0f / sqrtf(wave_sum(ss) * (1.0f / 1024.0f) + EPS);
            v2u* ho = (v2u*)(WSP(bf16, WS_H) + (size_t)m * 1024);
#pragma unroll
            for (int j = 0; j < 4; ++j) { const f32x4 o = x[j] * rs * G[j] * SC[j] + SH[j]; v2u pk; pk.x = pk2(o[0], o[1]); pk.y = pk2(o[2], o[3]); ho[ln + 64u * j] = pk; }
        }
#undef AD_LOAD
    }
#undef ROWI
}

__device__ __forceinline__ void ph_conv(const Ctx& c) {
    LAS bf16* glu = (LAS bf16*)c.lds;
    LAS float* yb = (LAS float*)(c.lds + 65536);
    const bf16* P = WSP(bf16, WS_PBUF);
    const int ch = c.tid;
    float w[31];
#pragma unroll
    for (int i = 0; i < 31; ++i) w[i] = c.a->in[I_CONVW][i * 512 + ch];
    const float cb = c.a->in[I_CONVB][ch];
    const bool g256 = (c.G == 256); const int nrnd = g256 ? 3 : (NTOK / 32 + (int)c.G - 1) / (int)c.G;
    for (int rnd = 0; rnd < nrnd; ++rnd) {
        const int item = (g256 && rnd == 2) ? 512 + (int)blockIdx.x - 16 : (int)blockIdx.x + rnd * (int)c.G;
        if (item >= NTOK / 32 || item < 0 || (g256 && rnd == 2 && (int)blockIdx.x < 16)) continue;
        const int t0 = item * 32;
        int lo, hi; if (t0 < NLAT) { lo = (t0 / SEQ) * SEQ; hi = lo + SEQ; } else { lo = NLAT + ((t0 - NLAT) / CTXL) * CTXL; hi = lo + CTXL; }
        for (int i = c.tid; i < 62 * 64; i += 512) { const int rr = i >> 6, c8 = (i & 63) * 8, row = t0 - 15 + rr;
            v4u o = {0u, 0u, 0u, 0u};
            if (row >= lo && row < hi) { const v4u a = *(const v4u*)(P + (size_t)row * 2560 + c8), b = *(const v4u*)(P + (size_t)row * 2560 + 512 + c8);
                o.x = pk2(bflo(a.x) * sigmoidf(bflo(b.x)), bfhi(a.x) * sigmoidf(bfhi(b.x))); o.y = pk2(bflo(a.y) * sigmoidf(bflo(b.y)), bfhi(a.y) * sigmoidf(bfhi(b.y)));
                o.z = pk2(bflo(a.z) * sigmoidf(bflo(b.z)), bfhi(a.z) * sigmoidf(bfhi(b.z))); o.w = pk2(bflo(a.w) * sigmoidf(bflo(b.w)), bfhi(a.w) * sigmoidf(bfhi(b.w))); }
            *(LAS v4u*)(glu + rr * 512 + c8) = o; }
        __syncthreads();
        float acc[32];
#pragma unroll
        for (int t = 0; t < 32; ++t) acc[t] = cb;
#pragma unroll
        for (int rr = 0; rr < 62; ++rr) { const float gv = bf2f(glu[rr * 512 + ch]);
#pragma unroll
            for (int t = 0; t < 32; ++t) if (rr - t >= 0 && rr - t <= 30) acc[t] += gv * w[rr - t]; }
#pragma unroll
        for (int t = 0; t < 32; ++t) yb[t * 512 + ch] = acc[t];
        __syncthreads();
#pragma unroll
        for (int tt = 0; tt < 4; ++tt) { const int t = c.wave * 4 + tt;
            const f32x4 v0 = *(const LAS f32x4*)(yb + t * 512 + 8 * c.lane), v1 = *(const LAS f32x4*)(yb + t * 512 + 8 * c.lane + 4);
            const float mu = wave_sum((v0[0] + v0[1]) + (v0[2] + v0[3]) + (v1[0] + v1[1]) + (v1[2] + v1[3])) * (1.0f / 512.0f);
            float q = 0.f; float d[8];
#pragma unroll
            for (int j = 0; j < 4; ++j) { d[j] = v0[j] - mu; d[4 + j] = v1[j] - mu; }
#pragma unroll
            for (int j = 0; j < 8; ++j) q += d[j] * d[j];
            const float rstd = 1.0f / sqrtf(wave_sum(q) * (1.0f / 512.0f) + EPS);
            float o[8];
#pragma unroll
            for (int j = 0; j < 8; ++j) { const int k = 8 * c.lane + j; o[j] = silu(d[j] * rstd * c.a->in[I_CLNG][k] + c.a->in[I_CLNB][k]); }
            v4u pk; pk.x = pk2(o[0], o[1]); pk.y = pk2(o[2], o[3]); pk.z = pk2(o[4], o[5]); pk.w = pk2(o[6], o[7]);
            *(v4u*)(WSP(bf16, WS_MIX) + (size_t)(t0 + t) * 1024 + 8 * c.lane) = pk; }
        __syncthreads();
    }
}

__device__ __forceinline__ void ph_na_naive(const Ctx& c) {
    const bf16* P = WSP(bf16, WS_PBUF);
    const int qc = c.tid & 63, h = c.tid >> 6;
    for (int item = blockIdx.x; item < 256 + 8; item += c.G) {
        int b, r = 0, m; const bool lat = item < 256;
        if (lat) { b = item >> 7; r = item & 127; m = b * SEQ + r * 64 + qc; } else { const int ci = item - 256; b = ci >> 2; m = NLAT + b * CTXL + (ci & 3) * 64 + qc; }
        float q[64], o[64];
        { const bf16* qp = P + (size_t)m * 2560 + 1024 + h * 64;
#pragma unroll
          for (int d = 0; d < 64; d += 8) { const v4u a = *(const v4u*)(qp + d); q[d] = bflo(a.x) * 0.125f; q[d + 1] = bfhi(a.x) * 0.125f; q[d + 2] = bflo(a.y) * 0.125f; q[d + 3] = bfhi(a.y) * 0.125f;
              q[d + 4] = bflo(a.z) * 0.125f; q[d + 5] = bfhi(a.z) * 0.125f; q[d + 6] = bflo(a.w) * 0.125f; q[d + 7] = bfhi(a.w) * 0.125f; } }
#pragma unroll
        for (int d = 0; d < 64; ++d) o[d] = 0.f;
        float mx = -1e30f, l = 0.f;
        const int rs = lat ? min(max(r - 4, 0), 120) : 0, cs = min(max(qc - 8, 0), 48);
        const int nwin = lat ? 128 : 0;
        for (int kk = 0; kk < nwin + 256; ++kk) {
            int tok; float bias = 0.f;
            if (kk < nwin) { const int i = kk >> 4, j = kk & 15; tok = b * SEQ + (rs + i) * 64 + cs + j; bias = c.a->in[I_RPB][(h * 15 + (rs + i - r + 7)) * 31 + (cs + j - qc + 15)]; }
            else tok = NLAT + b * CTXL + (kk - nwin);
            const bf16* kp = P + (size_t)tok * 2560 + 1536 + h * 64; const bf16* vp = kp + 512;
            float s = 0.f;
#pragma unroll
            for (int d = 0; d < 64; d += 8) { const v4u a = *(const v4u*)(kp + d);
                s += q[d] * bflo(a.x) + q[d + 1] * bfhi(a.x) + q[d + 2] * bflo(a.y) + q[d + 3] * bfhi(a.y) + q[d + 4] * bflo(a.z) + q[d + 5] * bfhi(a.z) + q[d + 6] * bflo(a.w) + q[d + 7] * bfhi(a.w); }
            s += bias;
            const float mn = fmaxf(mx, s), al = __expf(mx - mn), p = __expf(s - mn);
            l = l * al + p; mx = mn;
#pragma unroll
            for (int d = 0; d < 64; d += 8) { const v4u a = *(const v4u*)(vp + d);
                o[d] = o[d] * al + p * bflo(a.x); o[d + 1] = o[d + 1] * al + p * bfhi(a.x); o[d + 2] = o[d + 2] * al + p * bflo(a.y); o[d + 3] = o[d + 3] * al + p * bfhi(a.y);
                o[d + 4] = o[d + 4] * al + p * bflo(a.z); o[d + 5] = o[d + 5] * al + p * bfhi(a.z); o[d + 6] = o[d + 6] * al + p * bflo(a.w); o[d + 7] = o[d + 7] * al + p * bfhi(a.w); }
        }
        const float il = 1.0f / l;
        bf16* op = WSP(bf16, WS_MIX) + (size_t)m * 1024 + 512 + h * 64;
#pragma unroll
        for (int d = 0; d < 64; d += 8) { v4u pk; pk.x = pk2(o[d] * il, o[d + 1] * il); pk.y = pk2(o[d + 2] * il, o[d + 3] * il); pk.z = pk2(o[d + 4] * il, o[d + 5] * il); pk.w = pk2(o[d + 6] * il, o[d + 7] * il);
            *(v4u*)(op + d) = pk; }
    }
}

__device__ __forceinline__ void ph_outproj_ctx_tiles(const Ctx& c, size_t ws_wout) {
    for (int t = c.gw; t < 32 * 64; t += c.ngw) { const int mt = t >> 6, nt = t & 63;
        const f32x4 a = wave_tile16(WSP(bf16, WS_MIX) + (size_t)(NLAT + 16 * mt) * 1024, 1024, WSP(bf16, ws_wout) + (size_t)(16 * nt) * 1024, 1024, 1024, c.lane);
        v2u pk; pk.x = pk2(a[0], a[1]); pk.y = pk2(a[2], a[3]);
        *(v2u*)(WSP(bf16, WS_YO) + (size_t)(NLAT + 16 * mt + (c.lane & 15)) * 1024 + 16 * nt + 4 * (c.lane >> 4)) = pk; }
}
__device__ __forceinline__ void ph_inproj_odd_tiles(const Ctx& c) {
    const bf16* H = WSP(bf16, WS_H); const bf16* W = WSP(bf16, WS_WINO);
    for (int t = c.gw; t < 1024 + 16 * 48 + 32; t += c.ngw) { f32x4 acc[2];
        if (t < 1024 || t >= 1024 + 16 * 48) { const int u = t < 1024 ? t : t - 1024 - 16 * 48, nt = u & 1, r0 = t < 1024 ? 32 * (u >> 1) : NLAT + 32 * (u >> 1);
            wave_tile32x16(H + (size_t)r0 * 1024, 1024, W + (size_t)(2048 + 16 * nt) * 1024, 1024, 1024, c.lane, acc);
#pragma unroll
            for (int mi = 0; mi < 2; ++mi) *(f32x4*)(WSP(float, WS_LR) + (size_t)(r0 + 16 * mi + (c.lane & 15)) * 32 + 16 * nt + 4 * (c.lane >> 4)) = acc[mi]; }
        else { const int u = t - 1024, mb = u / 48, nt = u % 48;
            wave_tile32x16(H + (size_t)(NLAT + 32 * mb) * 1024, 1024, W + (size_t)(768 + 16 * nt) * 1024, 1024, 1024, c.lane, acc);
#pragma unroll
            for (int mi = 0; mi < 2; ++mi) { v2u pk; pk.x = pk2(acc[mi][0], acc[mi][1]); pk.y = pk2(acc[mi][2], acc[mi][3]);
                *(v2u*)(WSP(bf16, WS_PBUF) + (size_t)(NLAT + 32 * mb + 16 * mi + (c.lane & 15)) * 2048 + 768 + 16 * nt + 4 * (c.lane >> 4)) = pk; } }
    }
}
__device__ __forceinline__ void ph_pool_tiles(const Ctx& c) {
    for (int t = c.gw; t < 1024 * 32; t += c.ngw) { const int mt = t >> 5, g = (t >> 3) & 3, et = t & 7;
        const f32x4 a = wave_tile16(WSP(bf16, WS_DPOOL) + (size_t)(16 * mt) * 512 + g * 128, 512, WSP(bf16, WS_POOLW) + (size_t)g * 128 * 128 + (size_t)(16 * et) * 128, 128, 128, c.lane);
        const int col = g * 128 + 16 * et + 4 * (c.lane >> 4); const float* sc = c.a->in[I_POOLS] + col;
        v2u pk; pk.x = pk2(a[0] * sc[0], a[1] * sc[1]); pk.y = pk2(a[2] * sc[2], a[3] * sc[3]);
        *(v2u*)(WSP(bf16, WS_MIX) + (size_t)(16 * mt + (c.lane & 15)) * 1024 + col) = pk; }
}

__device__ __forceinline__ void ph_post(const Ctx& c, int layer, int nrows) {
    LAS float* rw = (LAS float*)c.lds;
    { const float* R = c.a->in[I_ROUTER] + (size_t)layer * 1024 * 16;
      for (int i = c.tid; i < 1024 * 16; i += 512) { const int k = i >> 4, e = i & 15, rho = (k & 3) * 256 + ((k >> 8) & 3) * 64 + ((k >> 2) & 63); rw[rho * 16 + 4 * ((e >> 2) ^ ((rho >> 2) & 3)) + (e & 3)] = R[i]; } }
    __syncthreads();
    const f32x4* ng4 = (const f32x4*)(c.a->in[I_NORMG] + (size_t)layer * 4 * 1024);
    const int rbase = nrows / c.ngw, rrem = nrows - rbase * c.ngw, rrank = c.wave * c.G + (int)blockIdx.x, cnt = rbase + (rrank < rrem ? 1 : 0), m0 = c.gw * rbase, mx = rbase * c.ngw + rrank;
#define ROWI(i) ((i) < rbase ? m0 + (i) : mx)
    const unsigned ln = (unsigned)c.lane;
    if (cnt > 0) {
        int scur = -1;
        f32x4 G1[4], G2[4], M2[4], M3[4], M4[4], xin[2][4]; v2u yy[2][4], xb[2][4];
#define POST_LOADROW(P, M) do { const f32x4* xr_ = (const f32x4*)((M) < NLAT ? c.a->in[I_X] + (size_t)(M) * 1024 : c.a->in[I_CTX] + (size_t)((M) - NLAT) * 1024); const v2u* xq_ = (const v2u*)(WSP(bf16, WS_X1) + (size_t)(M) * 1024); \
            const v2u* yr_ = (const v2u*)(WSP(bf16, WS_YO) + (size_t)(M) * 1024); _Pragma("unroll") for (int j = 0; j < 4; ++j) { if (layer == 0) xin[P][j] = __builtin_nontemporal_load(xr_ + ln + 64u * j); else xb[P][j] = __builtin_nontemporal_load(xq_ + ln + 64u * j); \
                yy[P][j] = __builtin_nontemporal_load(yr_ + ln + 64u * j); } } while (0)
#define POST_BODY(P, I) do { const int m = ROWI(I); \
            const int s = m < NLAT ? m / SEQ : 2; \
            if (s != scur) { scur = s; const f32x4* mod4 = (const f32x4*)(WSP(float, WS_MOD) + (size_t)(layer * 3 + s) * 6144); \
                const f32x4* m2p = mod4 + 512; const f32x4* m3p = mod4 + 768; const f32x4* m4p = mod4 + 1024; const f32x4* g1p = ng4 + 256; const f32x4* g2p = ng4 + 512; \
_Pragma("unroll") \
                for (int j = 0; j < 4; ++j) { const unsigned idx = ln + 64u * j; G1[j] = g1p[idx]; G2[j] = g2p[idx]; M2[j] = m2p[idx]; M3[j] = m3p[idx]; M4[j] = m4p[idx] + 1.0f; } } \
            f32x4 x[4], xi[4]; float ss = 0.f; \
_Pragma("unroll") \
            for (int j = 0; j < 4; ++j) { x[j] = (f32x4){bflo(yy[P][j].x), bfhi(yy[P][j].x), bflo(yy[P][j].y), bfhi(yy[P][j].y)}; xi[j] = layer == 0 ? xin[P][j] : (f32x4){bflo(xb[P][j].x), bfhi(xb[P][j].x), bflo(xb[P][j].y), bfhi(xb[P][j].y)}; ss += (x[j][0] * x[j][0] + x[j][1] * x[j][1]) + (x[j][2] * x[j][2] + x[j][3] * x[j][3]); } \
            if ((I) + 2 < cnt) POST_LOADROW(P, ROWI((I) + 2)); \
            const float ry = 1.0f / sqrtf(wave_sum(ss) * (1.0f / 1024.0f) + EPS); \
            float s1 = 0.f; \
            v2u* x1r = (v2u*)(WSP(bf16, WS_X1) + (size_t)m * 1024); \
_Pragma("unroll") \
            for (int j = 0; j < 4; ++j) { x[j] = xi[j] + M2[j] * (x[j] * ry * G1[j]); s1 += (x[j][0] * x[j][0] + x[j][1] * x[j][1]) + (x[j][2] * x[j][2] + x[j][3] * x[j][3]); v2u pk_; pk_.x = pk2(x[j][0], x[j][1]); pk_.y = pk2(x[j][2], x[j][3]); x1r[ln + 64u * j] = pk_; } \
            const float r1 = 1.0f / sqrtf(wave_sum(s1) * (1.0f / 1024.0f) + EPS); \
            unsigned* xo = (unsigned*)(WSP(unsigned char, WS_XN2) + (size_t)m * 1024); \
_Pragma("unroll") \
            for (int j = 0; j < 4; ++j) { x[j] = x[j] * r1 * G2[j] * M4[j] + M3[j]; \
                xo[ln + 64u * j] = pg8::pk4_fp8(pg8::clamp448(x[j][0] * SC_X), pg8::clamp448(x[j][1] * SC_X), pg8::clamp448(x[j][2] * SC_X), pg8::clamp448(x[j][3] * SC_X)); } \
            float lg[16]; \
_Pragma("unroll") \
            for (int e = 0; e < 16; ++e) lg[e] = 0.f; \
_Pragma("unroll") \
            for (int j = 0; j < 4; ++j) \
_Pragma("unroll") \
                for (int t = 0; t < 4; ++t) { const float xn = x[j][t]; \
                    const LAS float* wr = rw + (t * 256 + 64 * j) * 16 + c.lane * 16; const int sw = (c.lane >> 2) & 3; \
                    const f32x4 w0 = *(const LAS f32x4*)(wr + 4 * (0 ^ sw)), w1 = *(const LAS f32x4*)(wr + 4 * (1 ^ sw)), w2 = *(const LAS f32x4*)(wr + 4 * (2 ^ sw)), w3 = *(const LAS f32x4*)(wr + 4 * (3 ^ sw)); \
_Pragma("unroll") \
                    for (int u = 0; u < 4; ++u) { lg[u] += xn * w0[u]; lg[4 + u] += xn * w1[u]; lg[8 + u] += xn * w2[u]; lg[12 + u] += xn * w3[u]; } \
                    asm volatile("" ::: "memory"); } \
 \
            float a8[8], a4[4], a2[2], a1; \
            { const bool hi = (c.lane & 1) != 0; \
_Pragma("unroll") \
              for (int i = 0; i < 8; ++i) { const float snd = hi ? lg[i] : lg[8 + i]; const float rcv = lane_xor1(snd); a8[i] = (hi ? lg[8 + i] : lg[i]) + rcv; } } \
            { const bool hi = (c.lane & 2) != 0; \
_Pragma("unroll") \
              for (int i = 0; i < 4; ++i) { const float snd = hi ? a8[i] : a8[4 + i]; const float rcv = lane_xor2(snd); a4[i] = (hi ? a8[4 + i] : a8[i]) + rcv; } } \
            { const bool hi = (c.lane & 4) != 0; \
_Pragma("unroll") \
              for (int i = 0; i < 2; ++i) { const float snd = hi ? a4[i] : a4[2 + i]; const float rcv = lane_xor4(snd); a2[i] = (hi ? a4[2 + i] : a4[i]) + rcv; } } \
            { const bool hi = (c.lane & 8) != 0; const float snd = hi ? a2[0] : a2[1]; const float rcv = lane_xor8(snd); a1 = (hi ? a2[1] : a2[0]) + rcv; } \
            a1 = xor16_sum(a1); a1 = xor32_sum(a1); \
            float mx = a1; \
            mx = fmaxf(mx, lane_xor1(mx)); mx = fmaxf(mx, lane_xor2(mx)); mx = fmaxf(mx, lane_xor4(mx)); mx = fmaxf(mx, lane_xor8(mx)); \
            const float ex = expf(a1 - mx); float den = ex; \
            den = row16_sum(den); \
            const int eidx = ((c.lane & 1) << 3) | ((c.lane & 2) << 1) | ((c.lane & 4) >> 1) | ((c.lane & 8) >> 3); \
            if (c.lane < 16) WSP(float, WS_AFF)[(size_t)m * 16 + eidx] = ex / den; \
        } while (0)
        POST_LOADROW(0, ROWI(0)); if (cnt > 1) POST_LOADROW(1, ROWI(1));
        for (int i = 0; i < cnt; i += 2) { POST_BODY(0, i); if (i + 1 < cnt) POST_BODY(1, i + 1); }
#undef POST_BODY
#undef POST_LOADROW
    }
#undef ROWI
    __syncthreads();
}

__device__ __forceinline__ void ph_topk_gather(const Ctx& c, int nlat_tasks, int nctx_lists) {
    LAS unsigned* keys = (LAS unsigned*)c.lds;
    LAS int* hist = (LAS int*)(c.lds + 32768);
    LAS int* cg = (LAS int*)(c.lds + 32768 + 4096);
    LAS int* ce = cg + 512;
    LAS unsigned* ctl = (LAS unsigned*)(ce + 512);
    LAS int* slot_tok = (LAS int*)(c.lds + 45056);
    const float* aff = WSP(float, WS_AFF); int* inv = WSP(int, WS_INV); int* rowtok = WSP(int, WS_ROWTOK);
    for (int task = blockIdx.x; task < nlat_tasks + nctx_lists; task += c.G) {
        int n, cap, tok0, rowbase, e, part, nparts;
        if (task < nlat_tasks) { const int lid = task >> 3; part = task & 7; nparts = 8; const int b = lid >> 4; e = lid & 15; n = SEQ; cap = 1024; tok0 = b * SEQ; rowbase = e * 2048 + b * 1024; }
        else { const int lid = task - nlat_tasks; part = 0; nparts = 1; const int b = lid >> 4; e = lid & 15; n = CTXL; cap = 32; tok0 = NLAT + b * CTXL; rowbase = MOE_LAT + e * 256 + b * 32; }
        const int cpt = n / 512 > 0 ? n / 512 : 1;
        for (int i = c.tid; i < n; i += 512) keys[i] = min(__builtin_bit_cast(unsigned, aff[(size_t)(tok0 + i) * 16 + e]), 0x3fffffffu);
        if (n <= 512) {
            __syncthreads();
            if (c.tid < n) { const unsigned key = keys[c.tid]; int rank = 0;
                for (int j = 0; j < n; ++j) { const unsigned kj = keys[j]; rank += (kj > key || (kj == key && j < c.tid)) ? 1 : 0; }
                const int slot = rank < cap ? rank : -1;
                if (slot >= 0) slot_tok[slot] = tok0 + c.tid;
                inv[(size_t)(tok0 + c.tid) * 16 + e] = slot >= 0 ? rowbase + slot : -1; if (slot >= 0) rowtok[rowbase + slot] = tok0 + c.tid; }
        } else {
        if (c.tid == 0) { ctl[0] = 0u; ctl[1] = (unsigned)cap; }
        __syncthreads();
        for (int pass = 0; pass < 3; ++pass) {
            const int shift = 20 - 10 * pass;
            for (int i = c.tid; i < 1024; i += 512) hist[i] = 0;
            __syncthreads();
            const unsigned prefix = ctl[0];
            for (int i = c.tid; i < n; i += 512) { const unsigned kk = keys[i]; if (pass == 0 || (kk >> (shift + 10)) == prefix) __hip_atomic_fetch_add(&hist[(kk >> shift) & 1023u], 1, __ATOMIC_RELAXED, __HIP_MEMORY_SCOPE_WORKGROUP); }
            __syncthreads();
            if (c.wave == 0) {
                const int kth = (int)ctl[1];
                int hb[16]; int mine = 0;
#pragma unroll
                for (int j = 0; j < 16; ++j) { hb[j] = hist[16 * c.lane + j]; mine += hb[j]; }
                int suf = mine;
#pragma unroll
                for (int o = 1; o < 64; o <<= 1) { const int t = __shfl_down(suf, o); if (c.lane + o < 64) suf += t; }
                const int above = suf - mine;
                if (above < kth && suf >= kth) {
                    int cum = above, sel = 0, rem = 0; bool found = false;
#pragma unroll
                    for (int j = 15; j >= 0; --j) { if (!found) { if (cum + hb[j] >= kth) { sel = j; rem = kth - cum; found = true; } else cum += hb[j]; } }
                    ctl[0] = (prefix << 10) | (unsigned)(16 * c.lane + sel); ctl[1] = (unsigned)rem; }
            }
            __syncthreads();
        }
        const unsigned T = ctl[0]; const int need_eq = (int)ctl[1]; const int ngt = cap - need_eq;
        { int g = 0, q = 0;
          for (int j = 0; j < cpt; ++j) { const int i = c.tid * cpt + j; if (i < n) { const unsigned k = keys[i]; g += (k > T); q += (k == T); } }
          cg[c.tid] = g; ce[c.tid] = q; }
        __syncthreads();
        if (c.wave == 0) {
            int g[8], q[8], sg = 0, sq = 0;
#pragma unroll
            for (int j = 0; j < 8; ++j) { g[j] = cg[c.lane * 8 + j]; q[j] = ce[c.lane * 8 + j]; sg += g[j]; sq += q[j]; }
            int ig = sg, iq = sq;
#pragma unroll
            for (int o = 1; o < 64; o <<= 1) { const int tg = __shfl_up(ig, o), tq = __shfl_up(iq, o); if (c.lane >= o) { ig += tg; iq += tq; } }
            int eg = ig - sg, eq = iq - sq;
#pragma unroll
            for (int j = 0; j < 8; ++j) { cg[c.lane * 8 + j] = eg; ce[c.lane * 8 + j] = eq; eg += g[j]; eq += q[j]; }
        }
        __syncthreads();
        { int g = cg[c.tid], q = ce[c.tid];
          for (int j = 0; j < cpt; ++j) { const int i = c.tid * cpt + j; if (i < n) { const unsigned k = keys[i]; int slot = -1;
              if (k > T) { slot = g; ++g; } else if (k == T) { if (q < need_eq) slot = ngt + q; ++q; }
              if (slot >= 0) slot_tok[slot] = tok0 + i;
              if ((i * nparts) / n == part) { inv[(size_t)(tok0 + i) * 16 + e] = slot >= 0 ? rowbase + slot : -1; if (slot >= 0) rowtok[rowbase + slot] = tok0 + i; } } } }
        }
        __syncthreads();
        { const int per = cap / nparts, s0 = part * per;
          for (int base = s0 + c.wave; base < s0 + per; base += NWAVES * 8) { v4u vals[8]; int sls[8];
#pragma unroll
              for (int u = 0; u < 8; ++u) { const int sl = base + NWAVES * u; sls[u] = sl; if (sl < s0 + per) { const int tok = slot_tok[sl]; vals[u] = ((const v4u*)(WSP(unsigned char, WS_XN2) + (size_t)tok * 1024))[c.lane]; } }
#pragma unroll
              for (int u = 0; u < 8; ++u) if (sls[u] < s0 + per) ((v4u*)(WSP(unsigned char, WS_XG) + (size_t)(rowbase + sls[u]) * 1024))[c.lane] = vals[u]; } }
        if (task >= nlat_tasks && task < nlat_tasks + 16) {
            for (int i = 64 + c.wave; i < 256; i += NWAVES) { ((v4u*)(WSP(unsigned char, WS_XG) + (size_t)(MOE_LAT + e * 256 + i) * 1024))[c.lane] = (v4u){0u, 0u, 0u, 0u}; if (c.lane == 0) rowtok[MOE_LAT + e * 256 + i] = -1; } }
        __syncthreads();
    }
}

__device__ __forceinline__ void ph_combine(const Ctx& c, int layer, int nrows) {
    const float* ng = c.a->in[I_NORMG] + (size_t)layer * 4 * 1024;
    const int rbase = nrows / c.ngw, rrem = nrows - rbase * c.ngw, rrank = c.wave * c.G + (int)blockIdx.x, cnt = rbase + (rrank < rrem ? 1 : 0), m0 = c.gw * rbase, mx = rbase * c.ngw + rrank;
#define ROWI(i) ((i) < rbase ? m0 + (i) : mx)
    const unsigned ln = (unsigned)c.lane;
    if (cnt > 0) {
        int scur = -1;
        f32x4 G3[2][2], M5[2][2], GN[2][2], MS[2][2], MH[2][2];
        int inv_n = -1; float aff_n = 0.f; int inv_c; float aff_c;
        int rows_c[4], rows_n[4]; float as_c[4], as_n[4]; unsigned long long rest_c = 0ull, rest_n = 0ull;
        v4u yc[4][2], yn[4][2]; v4u x1c[2], x1n[2];
#define CMB_REC(M, IV, AF) do { IV = ln < 16u ? WSP(int, WS_INV)[(size_t)(M) * 16 + ln] : -1; AF = ln < 16u ? WSP(float, WS_AFF)[(size_t)(M) * 16 + ln] : 0.f; } while (0)
#define CMB_PREP(IV, AF, ROWS, AS, REST) do { unsigned long long mk_ = __ballot((IV) >= 0); _Pragma("unroll") for (int u = 0; u < 4; ++u) { ROWS[u] = -1; AS[u] = 0.f; \
            if (mk_) { const int e_ = __builtin_ctzll(mk_); mk_ &= mk_ - 1; ROWS[u] = __shfl((IV), e_); AS[u] = __shfl((AF), e_); } } REST = mk_; } while (0)
#define CMB_ISSUE(M, ROWS, YV, XV) do { _Pragma("unroll") for (int u = 0; u < 4; ++u) if (ROWS[u] >= 0) { const v4u* src_ = (const v4u*)(WSP(bf16, WS_Y) + (size_t)ROWS[u] * 1024); YV[u][0] = __builtin_nontemporal_load(src_ + ln); YV[u][1] = __builtin_nontemporal_load(src_ + ln + 64u); } \
            const v4u* xr_ = (const v4u*)(WSP(bf16, WS_X1) + (size_t)(M) * 1024); _Pragma("unroll") for (int j = 0; j < 2; ++j) XV[j] = xr_[ln + 64u * j]; } while (0)
        CMB_REC(ROWI(0), inv_c, aff_c);
        CMB_PREP(inv_c, aff_c, rows_c, as_c, rest_c);
        CMB_ISSUE(ROWI(0), rows_c, yc, x1c);
        if (1 < cnt) CMB_REC(ROWI(1), inv_n, aff_n);
        for (int i = 0; i < cnt; ++i) { const int m = ROWI(i);
            const int s = m < NLAT ? m / SEQ : 2;
            if (s != scur) { scur = s; const f32x4* mod4 = (const f32x4*)(WSP(float, WS_MOD) + (size_t)(layer * 3 + s) * 6144); const f32x4* g34 = (const f32x4*)(ng + 3 * 1024);
                const f32x4* gn4 = (const f32x4*)(c.a->in[I_NORMG] + (size_t)4 * 1024); const f32x4* mn4 = (const f32x4*)(WSP(float, WS_MOD) + (size_t)(3 + s) * 6144);
#pragma unroll
                for (int j = 0; j < 2; ++j)
#pragma unroll
                    for (int hh = 0; hh < 2; ++hh) { const unsigned idx = 2u * ln + 128u * j + hh; G3[j][hh] = g34[idx]; M5[j][hh] = (mod4 + 1280)[idx];
                        if (layer == 0) { GN[j][hh] = gn4[idx]; MS[j][hh] = (mn4 + 256)[idx] + 1.0f; MH[j][hh] = mn4[idx]; } } }
            int inv_nn = -1; float aff_nn = 0.f;
            if (i + 1 < cnt) { CMB_PREP(inv_n, aff_n, rows_n, as_n, rest_n); CMB_ISSUE(ROWI(i + 1), rows_n, yn, x1n); if (i + 2 < cnt) CMB_REC(ROWI(i + 2), inv_nn, aff_nn); }
            float f[16];
#pragma unroll
            for (int i = 0; i < 16; ++i) f[i] = 0.f;
#pragma unroll
            for (int u = 0; u < 4; ++u) if (rows_c[u] >= 0) { const float a = as_c[u];
#pragma unroll
                for (int j = 0; j < 2; ++j) { const v4u w = yc[u][j];
                    f[8 * j + 0] += a * bflo(w.x); f[8 * j + 1] += a * bfhi(w.x); f[8 * j + 2] += a * bflo(w.y); f[8 * j + 3] += a * bfhi(w.y);
                    f[8 * j + 4] += a * bflo(w.z); f[8 * j + 5] += a * bfhi(w.z); f[8 * j + 6] += a * bflo(w.w); f[8 * j + 7] += a * bfhi(w.w); } }
            while (rest_c) { const int e_ = __builtin_ctzll(rest_c); rest_c &= rest_c - 1; const int row = __shfl(inv_c, e_); const float a = __shfl(aff_c, e_);
                const v4u* src = (const v4u*)(WSP(bf16, WS_Y) + (size_t)row * 1024);
#pragma unroll
                for (int j = 0; j < 2; ++j) { const v4u w = src[ln + 64u * j];
                    f[8 * j + 0] += a * bflo(w.x); f[8 * j + 1] += a * bfhi(w.x); f[8 * j + 2] += a * bflo(w.y); f[8 * j + 3] += a * bfhi(w.y);
                    f[8 * j + 4] += a * bflo(w.z); f[8 * j + 5] += a * bfhi(w.z); f[8 * j + 6] += a * bflo(w.w); f[8 * j + 7] += a * bfhi(w.w); } }
            float ss = 0.f;
#pragma unroll
            for (int i = 0; i < 16; ++i) ss += f[i] * f[i];
            const float rf = 1.0f / sqrtf(wave_sum(ss) * (1.0f / 1024.0f) + EPS);
            f32x4 x[2][2]; float s2 = 0.f;
#pragma unroll
            for (int j = 0; j < 2; ++j)
#pragma unroll
                for (int hh = 0; hh < 2; ++hh) { const f32x4 fv = (f32x4){f[8 * j + 4 * hh], f[8 * j + 4 * hh + 1], f[8 * j + 4 * hh + 2], f[8 * j + 4 * hh + 3]};
                    const unsigned xa_ = hh ? x1c[j].z : x1c[j].x, xb_ = hh ? x1c[j].w : x1c[j].y; const f32x4 xv_ = (f32x4){bflo(xa_), bfhi(xa_), bflo(xb_), bfhi(xb_)};
                    x[j][hh] = xv_ + M5[j][hh] * (fv * rf * G3[j][hh]); s2 += (x[j][hh][0] * x[j][hh][0] + x[j][hh][1] * x[j][hh][1]) + (x[j][hh][2] * x[j][hh][2] + x[j][hh][3] * x[j][hh][3]); }
            if (layer == 0) {
                const float r2 = 1.0f / sqrtf(wave_sum(s2) * (1.0f / 1024.0f) + EPS);
                v4u* x1r = (v4u*)(WSP(bf16, WS_X1) + (size_t)m * 1024); v4u* ho = (v4u*)(WSP(bf16, WS_H) + (size_t)m * 1024);
#pragma unroll
                for (int j = 0; j < 2; ++j) { { v4u px_; px_.x = pk2(x[j][0][0], x[j][0][1]); px_.y = pk2(x[j][0][2], x[j][0][3]); px_.z = pk2(x[j][1][0], x[j][1][1]); px_.w = pk2(x[j][1][2], x[j][1][3]); x1r[ln + 64u * j] = px_; }
                    const f32x4 o0 = x[j][0] * r2 * GN[j][0] * MS[j][0] + MH[j][0], o1 = x[j][1] * r2 * GN[j][1] * MS[j][1] + MH[j][1];
                    v4u pk; pk.x = pk2(o0[0], o0[1]); pk.y = pk2(o0[2], o0[3]); pk.z = pk2(o1[0], o1[1]); pk.w = pk2(o1[2], o1[3]); ho[ln + 64u * j] = pk; }
            } else {
                f32x4* orow = (f32x4*)(c.out + (size_t)m * 1024);
#pragma unroll
                for (int j = 0; j < 2; ++j) { orow[2u * ln + 128u * j] = x[j][0]; orow[2u * ln + 128u * j + 1u] = x[j][1]; }
            }
            inv_c = inv_n; aff_c = aff_n; rest_c = rest_n; inv_n = inv_nn; aff_n = aff_nn;
#pragma unroll
            for (int u = 0; u < 4; ++u) { rows_c[u] = rows_n[u]; as_c[u] = as_n[u]; yc[u][0] = yn[u][0]; yc[u][1] = yn[u][1]; }
#pragma unroll
            for (int j = 0; j < 2; ++j) x1c[j] = x1n[j];
        }
#undef CMB_REC
#undef CMB_PREP
#undef CMB_ISSUE
    }
#undef ROWI
}

__device__ __forceinline__ void ph_prep_odd(const Ctx& c) {
    const bf16* P = WSP(bf16, WS_PBUF);
    for (int it = blockIdx.x * 512 + c.tid; it < NLAT * 64; it += c.G * 512) {
        const int m = it >> 6, c8 = (it & 63) * 8, t = m & (SEQ - 1), b0 = m - t;
        const int win = 2 << (c8 >> 7), lo = max(t - win / 2, 0), hi = min(t + win / 2, SEQ);
        float sum[8];
#pragma unroll
        for (int j = 0; j < 8; ++j) sum[j] = 0.f;
        for (int tt = lo; tt < hi; ++tt) { const v4u a = *(const v4u*)(P + (size_t)(b0 + tt) * 2048 + c8);
            sum[0] += bflo(a.x); sum[1] += bfhi(a.x); sum[2] += bflo(a.y); sum[3] += bfhi(a.y); sum[4] += bflo(a.z); sum[5] += bfhi(a.z); sum[6] += bflo(a.w); sum[7] += bfhi(a.w); }
        const v4u a = *(const v4u*)(P + (size_t)m * 2048 + c8); const float inv = 1.0f / (float)(hi - lo);
        v4u o; o.x = pk2(sum[0] * inv - bflo(a.x), sum[1] * inv - bfhi(a.x)); o.y = pk2(sum[2] * inv - bflo(a.y), sum[3] * inv - bfhi(a.y));
        o.z = pk2(sum[4] * inv - bflo(a.z), sum[5] * inv - bfhi(a.z)); o.w = pk2(sum[6] * inv - bflo(a.w), sum[7] * inv - bfhi(a.w));
        *(v4u*)(WSP(bf16, WS_DPOOL) + (size_t)m * 512 + c8) = o;
    }
    const int hd = c.tid & 255, d = hd & 63;
    float gw0[16], gw1[16];
#pragma unroll
    for (int r = 0; r < 16; ++r) { gw0[r] = c.a->in[I_GATEW][r * 256 + hd]; gw1[r] = c.a->in[I_GATEW][(16 + r) * 256 + hd]; }
    const float gb0 = c.a->in[I_GATEB][hd], gb1 = c.a->in[I_GATEB][256 + hd];
    const float* rope = WSP(float, WS_ROPE);
    for (int m = blockIdx.x * 2 + (c.tid >> 8); m < NTOK; m += c.G * 2) {
        const float* lr = WSP(float, WS_LR) + (size_t)m * 32;
        float z0 = gb0, z1 = gb1;
#pragma unroll
        for (int r = 0; r < 16; ++r) { z0 += lr[r] * gw0[r]; z1 += lr[16 + r] * gw1[r]; }
        const float l0 = fminf(z0, 0.f) - log1pf(expf(-fabsf(z0))), l1 = fminf(z1, 0.f) - log1pf(expf(-fabsf(z1)));
        WSP(float, WS_GF)[(size_t)m * 256 + hd] = l0 * (1.0f / 16.0f); WSP(float, WS_GB)[(size_t)m * 256 + hd] = l1 * (1.0f / 16.0f);
        const bf16* pr = P + (size_t)m * 2048;
        if (m < NLAT) {
            const int t = m & (SEQ - 1), pos = (d & 32) ? 128 + (t & 63) : (t >> 6), f = d & 15;
            const float cs = rope[(pos * 16 + f) * 2], sn = rope[(pos * 16 + f) * 2 + 1];
            const int d1 = hd & ~16, d2 = hd | 16;
            const float q1 = bf2f(pr[512 + d1]), q2 = bf2f(pr[512 + d2]), k1 = bf2f(pr[768 + d1]), k2 = bf2f(pr[768 + d2]);
            const bool second = (d & 16) != 0;
            WSP(float, WS_QR)[(size_t)m * 256 + hd] = (second ? q1 * sn + q2 * cs : q1 * cs - q2 * sn) * 0.125f;
            WSP(float, WS_KR)[(size_t)m * 256 + hd] = second ? k1 * sn + k2 * cs : k1 * cs - k2 * sn;
        } else WSP(float, WS_KR)[(size_t)m * 256 + hd] = bf2f(pr[768 + hd]);
    }
}

__device__ __forceinline__ void ph_gla_naive(const Ctx& c) {
    const bf16* P = WSP(bf16, WS_PBUF);
    for (int item = blockIdx.x; item < 256; item += c.G) {
        const int es = item & 15, dir = (item >> 4) & 1, h = (item >> 5) & 3, b = item >> 7;
        const int e = es * 8 + c.wave, d = c.lane;
        const float* G = dir ? WSP(float, WS_GB) : WSP(float, WS_GF);
        float* O = WSP(float, WS_OACC) + (size_t)dir * NLAT * 512;
        float S = 0.f;
        for (int blk = 0; blk < (CTXL + SEQ) / 8; ++blk) {
            float gg[8], kk[8], vv[8], qq[8]; int mm[8];
#pragma unroll
            for (int j = 0; j < 8; ++j) { const int step = blk * 8 + j; int m;
                if (step < CTXL) m = NLAT + b * CTXL + (dir ? CTXL - 1 - step : step); else { const int t = step - CTXL; m = b * SEQ + (dir ? SEQ - 1 - t : t); }
                mm[j] = m; gg[j] = G[(size_t)m * 256 + h * 64 + d]; kk[j] = WSP(float, WS_KR)[(size_t)m * 256 + h * 64 + d]; vv[j] = bf2f(P[(size_t)m * 2048 + 1024 + h * 128 + e]);
                qq[j] = m < NLAT ? WSP(float, WS_QR)[(size_t)m * 256 + h * 64 + d] : 0.f; }
#pragma unroll
            for (int j = 0; j < 8; ++j) { S = expf(gg[j]) * S + kk[j] * vv[j];
                if (blk >= CTXL / 8) { const float o = wave_sum(qq[j] * S); if (c.lane == 0) O[(size_t)mm[j] * 512 + h * 128 + e] = o; } }
        }
    }
}
__device__ __forceinline__ void ph_gla_out(const Ctx& c) {
    for (int m = c.gw; m < NLAT; m += c.ngw) {
        const float* o0 = WSP(float, WS_OACC) + (size_t)m * 512 + 8 * c.lane; const float* o1 = o0 + (size_t)NLAT * 512;
        float o[8]; float ss = 0.f;
#pragma unroll
        for (int j = 0; j < 8; ++j) { o[j] = o0[j] + o1[j]; ss += o[j] * o[j]; }
        ss = row16_sum(ss);
        const float rn = 1.0f / sqrtf(ss * (1.0f / 128.0f) + EPS);
        const v4u rr = *(const v4u*)(WSP(bf16, WS_PBUF) + (size_t)m * 2048 + 1536 + 8 * c.lane);
        const float r[8] = {bflo(rr.x), bfhi(rr.x), bflo(rr.y), bfhi(rr.y), bflo(rr.z), bfhi(rr.z), bflo(rr.w), bfhi(rr.w)};
        float v[8];
#pragma unroll
        for (int j = 0; j < 8; ++j) v[j] = o[j] * rn * c.a->in[I_HEADG][8 * c.lane + j] * silu(r[j]);
        v4u pk; pk.x = pk2(v[0], v[1]); pk.y = pk2(v[2], v[3]); pk.z = pk2(v[4], v[5]); pk.w = pk2(v[6], v[7]);
        *(v4u*)(WSP(bf16, WS_MIX) + (size_t)m * 1024 + 512 + 8 * c.lane) = pk;
    }
}

constexpr int GP = 72, GVP = 136;
typedef short s16x4_t __attribute__((ext_vector_type(4)));
constexpr int GP_unused = 0;
__device__ __forceinline__ bf16x8 mk8(v2u lo, v2u hi) { v4u t; t.x = lo.x; t.y = lo.y; t.z = hi.x; t.w = hi.y; return __builtin_bit_cast(bf16x8, t); }

__device__ __forceinline__ float logsig16(float z) { return (fminf(z, 0.f) - __logf(1.0f + __expf(-fabsf(z)))) * (1.0f / 16.0f); }
__device__ __forceinline__ void ph_gla_g1(const Ctx& c) {
    LAS bf16* keT = (LAS bf16*)c.lds;
    LAS bf16* vL = keT + 2 * 64 * GP;
    LAS float* tot = (LAS float*)(vL + 64 * GVP);
    LAS float* lrL = tot + 2 * 8 * 64;
    LAS bf16* kL = (LAS bf16*)(lrL + 64 * 32);
    LAS bf16* qL = kL + 64 * 64;
    LAS bf16* qkL = qL + 64 * 64;
    const bf16* P = WSP(bf16, WS_PBUF);
    const float* rope = WSP(float, WS_ROPE);
    const int d = c.tid & 63, tg = c.tid >> 6, q = c.lane >> 4, l15 = c.lane & 15;
    const int d1 = d & ~16, d2 = d | 16, fi = d & 15; const bool second = (d & 16) != 0, colhalf = (d & 32) != 0;
    const bool g256 = (c.G == 256);
    int hcur = -1; float gw0[16], gw1[16]; float gb0 = 0.f, gb1 = 0.f;
    f32x4 rlr; v4u rk, rq, rv[2];
#define G1_ITEM(I, B_, H_, C_) do { if (g256) { H_ = (int)blockIdx.x & 3; B_ = ((int)blockIdx.x >> 2) & 1; C_ = ((int)blockIdx.x >> 3) + 32 * (I); } else { const int it_ = (int)blockIdx.x + (I) * (int)c.G; C_ = it_ % 132; H_ = (it_ / 132) & 3; B_ = it_ / 528; if (it_ >= 1056) C_ = 132; } } while (0)
#define G1_FETCH(B_, H_, C_) do { const bool lat_ = (C_) >= 4; const int m0_ = lat_ ? (B_) * SEQ + 64 * ((C_) - 4) : NLAT + (B_) * CTXL + 64 * (C_); \
        rlr = ((const f32x4*)(WSP(float, WS_LR) + (size_t)m0_ * 32))[c.tid]; const bf16* pr_ = P + (size_t)(m0_ + (c.tid >> 3)) * 2048 + (H_) * 64 + 8 * (c.tid & 7); \
        rk = *(const v4u*)(pr_ + 768); if (lat_) rq = *(const v4u*)(pr_ + 512); \
        _Pragma("unroll") for (int r2 = 0; r2 < 2; ++r2) { const int id_ = c.tid + 512 * r2; rv[r2] = *(const v4u*)(P + (size_t)(m0_ + (id_ >> 4)) * 2048 + 1024 + (H_) * 128 + 8 * (id_ & 15)); } } while (0)
    { int b0_, h0_, c0_; G1_ITEM(0, b0_, h0_, c0_); if (c0_ < 132) G1_FETCH(b0_, h0_, c0_); }
    for (int ii = 0; ; ++ii) {
        int b, h, cidx; G1_ITEM(ii, b, h, cidx);
        if (cidx >= 132) break;
        const bool lat = cidx >= 4;
        const int m0 = lat ? b * SEQ + 64 * (cidx - 4) : NLAT + b * CTXL + 64 * cidx;
        { ((LAS f32x4*)lrL)[c.tid] = rlr; const int row = c.tid >> 3, ch = c.tid & 7;
          *(LAS v4u*)(kL + row * 64 + 8 * ch) = rk; if (lat) *(LAS v4u*)(qL + row * 64 + 8 * ch) = rq;
#pragma unroll
          for (int r2 = 0; r2 < 2; ++r2) { const int id = c.tid + 512 * r2; *(LAS v4u*)(vL + (id >> 4) * GVP + 8 * (id & 15)) = rv[r2]; } }
        if (h != hcur) { hcur = h;
#pragma unroll
            for (int r = 0; r < 16; ++r) { gw0[r] = c.a->in[I_GATEW][r * 256 + h * 64 + d]; gw1[r] = c.a->in[I_GATEW][(16 + r) * 256 + h * 64 + d]; }
            gb0 = c.a->in[I_GATEB][h * 64 + d]; gb1 = c.a->in[I_GATEB][256 + h * 64 + d]; }
        float csr = 1.f, snr = 0.f; if (lat && !colhalf) { csr = rope[((cidx - 4) * 16 + fi) * 2]; snr = rope[((cidx - 4) * 16 + fi) * 2 + 1]; }
        __syncthreads();
        float pf[8], pb[8];
#pragma unroll
        for (int j = 0; j < 8; ++j) { const LAS float* lr = lrL + (8 * tg + j) * 32; float z0 = gb0, z1 = gb1;
#pragma unroll
            for (int r = 0; r < 16; ++r) { z0 += lr[r] * gw0[r]; z1 += lr[16 + r] * gw1[r]; }
            pf[j] = logsig16(z0); pb[j] = logsig16(z1); }
#pragma unroll
        for (int j = 1; j < 8; ++j) pf[j] += pf[j - 1];
#pragma unroll
        for (int j = 6; j >= 0; --j) pb[j] += pb[j + 1];
        tot[(0 * 8 + tg) * 64 + d] = pf[7]; tot[(1 * 8 + tg) * 64 + d] = pb[0];
        __syncthreads();
        float offf = 0.f, offb = 0.f, Bf = 0.f, Bb = 0.f;
#pragma unroll
        for (int g = 0; g < 8; ++g) { const float tf = tot[g * 64 + d], tb = tot[(8 + g) * 64 + d]; Bf += tf; Bb += tb; offf += g < tg ? tf : 0.f; offb += g > tg ? tb : 0.f; }
        float kef[8], keb[8];
#pragma unroll
        for (int j = 0; j < 8; ++j) { const int tj = 8 * tg + j; const float bfj = offf + pf[j], bbj = offb + pb[j];
            float kv, qv = 0.f;
            if (lat) { float cs = csr, sn = snr; if (colhalf) { cs = rope[((128 + tj) * 16 + fi) * 2]; sn = rope[((128 + tj) * 16 + fi) * 2 + 1]; }
                const float k1 = bf2f(kL[tj * 64 + d1]), k2 = bf2f(kL[tj * 64 + d2]), q1 = bf2f(qL[tj * 64 + d1]), q2 = bf2f(qL[tj * 64 + d2]);
                kv = second ? k1 * sn + k2 * cs : k1 * cs - k2 * sn; qv = (second ? q1 * sn + q2 * cs : q1 * cs - q2 * sn) * 0.125f; }
            else kv = bf2f(kL[tj * 64 + d]);
            kef[j] = kv * __expf(Bf - bfj); keb[j] = kv * __expf(Bb - bbj);
            if (lat) { qkL[(0 * 64 + tj) * 64 + d] = (bf16)f2bf(qv * __expf(bfj)); qkL[(1 * 64 + tj) * 64 + d] = (bf16)f2bf(kv * __expf(-bfj));
                qkL[(2 * 64 + tj) * 64 + d] = (bf16)f2bf(qv * __expf(bbj)); qkL[(3 * 64 + tj) * 64 + d] = (bf16)f2bf(kv * __expf(-bbj)); } }
        { v4u w; w.x = pk2(kef[0], kef[1]); w.y = pk2(kef[2], kef[3]); w.z = pk2(kef[4], kef[5]); w.w = pk2(kef[6], kef[7]); *(LAS v4u*)(keT + (size_t)d * GP + 8 * tg) = w;
          w.x = pk2(keb[0], keb[1]); w.y = pk2(keb[2], keb[3]); w.z = pk2(keb[4], keb[5]); w.w = pk2(keb[6], keb[7]); *(LAS v4u*)(keT + (size_t)(64 + d) * GP + 8 * tg) = w; }
        if (tg == 0) { float* DCp = WSP(float, WS_DC);
            DCp[((size_t)(0 * 8 + b * 4 + h) * 132 + cidx) * 64 + d] = __expf(Bf); DCp[((size_t)(1 * 8 + b * 4 + h) * 132 + cidx) * 64 + d] = __expf(Bb); }
        __syncthreads();
        if (lat) {
#pragma unroll
            for (int r2 = 0; r2 < 4; ++r2) { const int id = c.tid + 512 * r2, arr = id >> 9, row = (id >> 3) & 63, ch = id & 7;
                bf16* dst = ((arr & 1) ? WSP(bf16, WS_KD) : WSP(bf16, WS_QE)) + (size_t)(arr >> 1) * NLAT * 256 + (size_t)(m0 + row) * 256 + h * 64 + 8 * ch;
                *(v4u*)dst = *(const LAS v4u*)(qkL + (arr * 64 + row) * 64 + 8 * ch); } }
        { const LAS bf16* vb = vL + (size_t)(8 * q + (l15 >> 2)) * GVP + 16 * c.wave + 4 * (l15 & 3);
          const bf16x8 av0 = mk8(__builtin_bit_cast(v2u, __builtin_amdgcn_ds_read_tr16_b64_v4i16((LAS s16x4_t*)vb)), __builtin_bit_cast(v2u, __builtin_amdgcn_ds_read_tr16_b64_v4i16((LAS s16x4_t*)(vb + 4 * GVP))));
          const bf16x8 av1 = mk8(__builtin_bit_cast(v2u, __builtin_amdgcn_ds_read_tr16_b64_v4i16((LAS s16x4_t*)(vb + 32 * GVP))), __builtin_bit_cast(v2u, __builtin_amdgcn_ds_read_tr16_b64_v4i16((LAS s16x4_t*)(vb + 36 * GVP))));
#pragma unroll
          for (int dir = 0; dir < 2; ++dir)
#pragma unroll
            for (int dt = 0; dt < 4; ++dt) {
                const bf16x8 b0 = *(const LAS bf16x8*)(keT + (size_t)(dir * 64 + 16 * dt + l15) * GP + 8 * q), b1 = *(const LAS bf16x8*)(keT + (size_t)(dir * 64 + 16 * dt + l15) * GP + 32 + 8 * q);
                f32x4 acc = {0.f, 0.f, 0.f, 0.f};
                acc = __builtin_amdgcn_mfma_f32_16x16x32_bf16(av0, b0, acc, 0, 0, 0); acc = __builtin_amdgcn_mfma_f32_16x16x32_bf16(av1, b1, acc, 0, 0, 0);
                float* U = WSP(float, WS_UT) + ((size_t)(dir * 8 + b * 4 + h) * 132 + cidx) * 8192 + (size_t)(16 * c.wave + 4 * q) * 64 + 16 * dt + l15;
#pragma unroll
                for (int r = 0; r < 4; ++r) U[r * 64] = acc[r]; } }
        { int bn, hn, cn; G1_ITEM(ii + 1, bn, hn, cn); if (cn < 132) G1_FETCH(bn, hn, cn); }
        __syncthreads();
    }
#undef G1_ITEM
#undef G1_FETCH
}

constexpr int PP = 520;
__device__ __forceinline__ void ph_pool(const Ctx& c) {
    LAS bf16* uL = (LAS bf16*)c.lds;
    const bf16* P = WSP(bf16, WS_PBUF);
    const int q = c.lane >> 4, l15 = c.lane & 15;
    for (int item = blockIdx.x; item < NLAT / 64; item += c.G) {
        const int mbase = item * 64, tb = mbase & (SEQ - 1);
        { v4u a[10];
#pragma unroll
          for (int u = 0; u < 10; ++u) { const int i = c.tid + 512 * u, r = i >> 6, c8 = (i & 63) * 8, t = tb - 8 + r; a[u] = (v4u){0u, 0u, 0u, 0u};
              if (t >= 0 && t < SEQ) a[u] = *(const v4u*)(P + (size_t)(mbase - 8 + r) * 2048 + c8); }
#pragma unroll
          for (int u = 0; u < 10; ++u) { const int i = c.tid + 512 * u, r = i >> 6, c8 = (i & 63) * 8; *(LAS v4u*)(uL + r * PP + c8) = a[u]; } }
        __syncthreads();
        v4u dv[8];
#pragma unroll
        for (int i = 0; i < 8; ++i) { const int id = c.tid + 512 * i, tt = id >> 6, c8 = (id & 63) * 8, t = tb + tt;
            const int hw = 1 << (c8 >> 7), lo = max(t - hw, 0), hi = min(t + hw, SEQ);
            float sum[8];
#pragma unroll
            for (int j = 0; j < 8; ++j) sum[j] = 0.f;
            for (int u = -hw; u < hw; ++u) { const v4u a = *(const LAS v4u*)(uL + (tt + 8 + u) * PP + c8);
                sum[0] += bflo(a.x); sum[1] += bfhi(a.x); sum[2] += bflo(a.y); sum[3] += bfhi(a.y); sum[4] += bflo(a.z); sum[5] += bfhi(a.z); sum[6] += bflo(a.w); sum[7] += bfhi(a.w); }
            const v4u a = *(const LAS v4u*)(uL + (tt + 8) * PP + c8); const float inv = 1.0f / (float)(hi - lo);
            dv[i].x = pk2(sum[0] * inv - bflo(a.x), sum[1] * inv - bfhi(a.x)); dv[i].y = pk2(sum[2] * inv - bflo(a.y), sum[3] * inv - bfhi(a.y));
            dv[i].z = pk2(sum[4] * inv - bflo(a.z), sum[5] * inv - bfhi(a.z)); dv[i].w = pk2(sum[6] * inv - bflo(a.w), sum[7] * inv - bfhi(a.w)); }
        __syncthreads();
#pragma unroll
        for (int i = 0; i < 8; ++i) { const int id = c.tid + 512 * i, tt = id >> 6, c8 = (id & 63) * 8; *(LAS v4u*)(uL + (tt + 8) * PP + c8) = dv[i]; }
        __syncthreads();
        for (int i = 0; i < 16; ++i) { const int tl = c.wave + 8 * i, mt = tl >> 5, g = (tl >> 3) & 3, et = tl & 7;
            const LAS bf16* ap = uL + (8 + 16 * mt + l15) * PP + g * 128 + 8 * q; const bf16* bp = WSP(bf16, WS_POOLW) + (size_t)g * 128 * 128 + (size_t)(16 * et + l15) * 128 + 8 * q;
            f32x4 acc = {0.f, 0.f, 0.f, 0.f};
#pragma unroll
            for (int ks = 0; ks < 4; ++ks) acc = __builtin_amdgcn_mfma_f32_16x16x32_bf16(*(const bf16x8*)(bp + 32 * ks), *(const LAS bf16x8*)(ap + 32 * ks), acc, 0, 0, 0);
            const int col = g * 128 + 16 * et + 4 * q; const float* sc = c.a->in[I_POOLS] + col;
            v2u pk; pk.x = pk2(acc[0] * sc[0], acc[1] * sc[1]); pk.y = pk2(acc[2] * sc[2], acc[3] * sc[3]);
            *(v2u*)(WSP(bf16, WS_MIX) + (size_t)(mbase + 16 * mt + l15) * 1024 + col) = pk; }
        __syncthreads();
    }
}

__device__ __forceinline__ void ph_gla_g2(const Ctx& c) {
    for (int el = blockIdx.x * 512 + c.tid; el < 16 * 8192; el += c.G * 512) {
        const int combo = el >> 13, ed = el & 8191, d = ed & 63, dir = combo >> 3;
        const float* Ub = WSP(float, WS_UT); const float* Db = WSP(float, WS_DC); const unsigned uo = (unsigned)combo * (132u * 8192u) + (unsigned)ed, dof = (unsigned)combo * (132u * 64u) + (unsigned)d;
        bf16* So = WSP(bf16, WS_ST) + (size_t)combo * 128 * 8192 + ed;
        float S = 0.f;
        for (int s4 = 0; s4 < 132; s4 += 22) {
            float u[22], dd[22];
#define G2_CI(j) (dir == 0 ? s4 + (j) : (s4 + (j) < 4 ? 3 - (s4 + (j)) : 135 - (s4 + (j))))
#pragma unroll
            for (int j = 0; j < 22; ++j) { const unsigned ci = (unsigned)G2_CI(j); u[j] = __builtin_nontemporal_load(Ub + (uo + ci * 8192u)); dd[j] = Db[dof + ci * 64u]; }
#pragma unroll
            for (int j = 0; j < 22; ++j) { const int ci = G2_CI(j); if (ci >= 4) So[(size_t)(ci - 4) * 8192] = (bf16)f2bf(S); S = dd[j] * S + u[j]; }
#undef G2_CI
        }
    }
}

__device__ __forceinline__ void ph_gla_g3(const Ctx& c) {
    LAS bf16* qe = (LAS bf16*)c.lds;
    LAS bf16* kd = qe + 2 * 64 * GP;
    LAS bf16* vL = kd + 2 * 64 * GP;
    LAS bf16* STl = vL + 64 * GVP;
    LAS float* ssq = (LAS float*)(STl + 2 * 128 * GP);
    const bf16* P = WSP(bf16, WS_PBUF);
    const int q = c.lane >> 4, l15 = c.lane & 15, it = c.wave & 3, eh = c.wave >> 2;
    v4u rq[2], rk[2], rs[2][2], rv[2];
#define G3_FETCH(ITEM) do { const int lc_ = (ITEM) & 127, h_ = ((ITEM) >> 7) & 3, b_ = (ITEM) >> 9, m0_ = b_ * SEQ + 64 * lc_; const int row_ = c.tid >> 3, ch_ = c.tid & 7; \
        _Pragma("unroll") for (int dir = 0; dir < 2; ++dir) { const size_t o_ = ((size_t)dir * NLAT + m0_ + row_) * 256 + h_ * 64 + 8 * ch_; rq[dir] = *(const v4u*)(WSP(bf16, WS_QE) + o_); rk[dir] = *(const v4u*)(WSP(bf16, WS_KD) + o_); \
            _Pragma("unroll") for (int r = 0; r < 2; ++r) { const int id_ = c.tid + 512 * r; rs[dir][r] = *(const v4u*)(WSP(bf16, WS_ST) + ((size_t)(dir * 8 + b_ * 4 + h_) * 128 + lc_) * 8192 + (id_ >> 3) * 64 + 8 * (id_ & 7)); } } \
        _Pragma("unroll") for (int r2 = 0; r2 < 2; ++r2) { const int id_ = c.tid + 512 * r2; rv[r2] = *(const v4u*)(P + (size_t)(m0_ + (id_ >> 4)) * 2048 + 1024 + h_ * 128 + 8 * (id_ & 15)); } } while (0)
    if ((int)blockIdx.x < 2 * 4 * 128) G3_FETCH((int)blockIdx.x);
    for (int item = blockIdx.x; item < 2 * 4 * 128; item += c.G) {
        const int lc = item & 127, h = (item >> 7) & 3, b = item >> 9, m0 = b * SEQ + 64 * lc;
        { const int row = c.tid >> 3, ch = c.tid & 7;
#pragma unroll
          for (int dir = 0; dir < 2; ++dir) { *(LAS v4u*)(qe + (size_t)(dir * 64 + row) * GP + 8 * ch) = rq[dir]; *(LAS v4u*)(kd + (size_t)(dir * 64 + row) * GP + 8 * ch) = rk[dir];
#pragma unroll
            for (int r = 0; r < 2; ++r) { const int id = c.tid + 512 * r; *(LAS v4u*)(STl + (size_t)(dir * 128 + (id >> 3)) * GP + 8 * (id & 7)) = rs[dir][r]; } }
#pragma unroll
          for (int r2 = 0; r2 < 2; ++r2) { const int id = c.tid + 512 * r2; *(LAS v4u*)(vL + (id >> 4) * GVP + 8 * (id & 15)) = rv[r2]; } }
        __syncthreads();
        f32x4 acc[4];
#pragma unroll
        for (int nt = 0; nt < 4; ++nt) acc[nt] = (f32x4){0.f, 0.f, 0.f, 0.f};
        const int iq = 16 * it + l15;
#pragma unroll
        for (int dir = 0; dir < 2; ++dir) {
            const bf16x8 bq0 = *(const LAS bf16x8*)(qe + (size_t)(dir * 64 + iq) * GP + 8 * q), bq1 = *(const LAS bf16x8*)(qe + (size_t)(dir * 64 + iq) * GP + 32 + 8 * q);
            f32x4 s[4];
#pragma unroll
            for (int jt = 0; jt < 4; ++jt) {
                const bf16x8 a0 = *(const LAS bf16x8*)(kd + (size_t)(dir * 64 + 16 * jt + l15) * GP + 8 * q), a1 = *(const LAS bf16x8*)(kd + (size_t)(dir * 64 + 16 * jt + l15) * GP + 32 + 8 * q);
                f32x4 t = {0.f, 0.f, 0.f, 0.f};
                t = __builtin_amdgcn_mfma_f32_16x16x32_bf16(a0, bq0, t, 0, 0, 0); t = __builtin_amdgcn_mfma_f32_16x16x32_bf16(a1, bq1, t, 0, 0, 0);
#pragma unroll
                for (int r = 0; r < 4; ++r) { const int j = 16 * jt + 4 * q + r; const bool keep = dir == 0 ? (j <= iq) : (j >= iq); t[r] = keep ? t[r] : 0.f; }
                s[jt] = t; }
            bf16x8 pbf[2];
#pragma unroll
            for (int ks = 0; ks < 2; ++ks) { v4u w; w.x = pk2(s[2 * ks][0], s[2 * ks][1]); w.y = pk2(s[2 * ks][2], s[2 * ks][3]); w.z = pk2(s[2 * ks + 1][0], s[2 * ks + 1][1]); w.w = pk2(s[2 * ks + 1][2], s[2 * ks + 1][3]);
                pbf[ks] = __builtin_bit_cast(bf16x8, w); }
#pragma unroll
            for (int nt = 0; nt < 4; ++nt) { const int er = 64 * eh + 16 * nt + l15;
                const bf16x8 s0 = *(const LAS bf16x8*)(STl + (size_t)(dir * 128 + er) * GP + 8 * q), s1 = *(const LAS bf16x8*)(STl + (size_t)(dir * 128 + er) * GP + 32 + 8 * q);
                acc[nt] = __builtin_amdgcn_mfma_f32_16x16x32_bf16(s0, bq0, acc[nt], 0, 0, 0); acc[nt] = __builtin_amdgcn_mfma_f32_16x16x32_bf16(s1, bq1, acc[nt], 0, 0, 0);
#pragma unroll
                for (int ks = 0; ks < 2; ++ks) { const LAS bf16* vb = vL + (size_t)(32 * ks + 4 * q + (l15 >> 2)) * GVP + 64 * eh + 16 * nt + 4 * (l15 & 3);
                    const v2u lo = __builtin_bit_cast(v2u, __builtin_amdgcn_ds_read_tr16_b64_v4i16((LAS s16x4_t*)vb)), hi = __builtin_bit_cast(v2u, __builtin_amdgcn_ds_read_tr16_b64_v4i16((LAS s16x4_t*)(vb + 16 * GVP)));
                    acc[nt] = __builtin_amdgcn_mfma_f32_16x16x32_bf16(mk8(lo, hi), pbf[ks], acc[nt], 0, 0, 0); } }
        }
        float ss = 0.f;
#pragma unroll
        for (int nt = 0; nt < 4; ++nt) ss += (acc[nt][0] * acc[nt][0] + acc[nt][1] * acc[nt][1]) + (acc[nt][2] * acc[nt][2] + acc[nt][3] * acc[nt][3]);
        ss = xor16_sum(ss); ss = xor32_sum(ss);
        if (q == 0) ssq[eh * 64 + iq] = ss;
        __syncthreads();
        const float rn = 1.0f / sqrtf((ssq[iq] + ssq[64 + iq]) * (1.0f / 128.0f) + EPS);
#pragma unroll
        for (int nt = 0; nt < 4; ++nt) { const int e = 64 * eh + 16 * nt + 4 * q; const size_t m = (size_t)(m0 + iq);
            const v2u rr = *(const v2u*)(P + m * 2048 + 1536 + h * 128 + e); const float* hg = c.a->in[I_HEADG] + h * 128 + e;
            v2u o; o.x = pk2(acc[nt][0] * rn * hg[0] * silu(bflo(rr.x)), acc[nt][1] * rn * hg[1] * silu(bfhi(rr.x))); o.y = pk2(acc[nt][2] * rn * hg[2] * silu(bflo(rr.y)), acc[nt][3] * rn * hg[3] * silu(bfhi(rr.y)));
            *(v2u*)(WSP(bf16, WS_MIX) + m * 1024 + 512 + h * 128 + e) = o; }
        if (item + c.G < 2 * 4 * 128) G3_FETCH(item + c.G);
        __syncthreads();
    }
#undef G3_FETCH
}

constexpr int NP = 72;
constexpr float LOG2E = 1.4426950408889634f;
template <int QG, bool WIN>
__device__ __forceinline__ void na_qgroup(const LAS bf16* Kt, const bf16x8 (&vf)[4][2], const LAS float* bp, const float (&cap)[3][4], const bf16x8 (&qf)[2], f32x4 (&o)[4], float& mrun, float& lrun, int q, int l15) {
    constexpr int KT_LO = WIN ? (QG <= 1 ? 0 : QG - 1) : 0, KT_HI = WIN ? (QG == 0 ? 1 : (QG == 3 ? 3 : QG + 1)) : 3;
    f32x4 s[4];
#pragma unroll
    for (int kt = 0; kt < 4; ++kt) if (kt >= KT_LO && kt <= KT_HI) {
        const bf16x8 a0 = *(const LAS bf16x8*)(Kt + (size_t)(16 * kt + l15) * NP + 8 * q), a1 = *(const LAS bf16x8*)(Kt + (size_t)(16 * kt + l15) * NP + 32 + 8 * q);
        f32x4 t = {0.f, 0.f, 0.f, 0.f};
        t = __builtin_amdgcn_mfma_f32_16x16x32_bf16(a0, qf[0], t, 0, 0, 0); t = __builtin_amdgcn_mfma_f32_16x16x32_bf16(a1, qf[1], t, 0, 0, 0);
        s[kt] = t; }
    float mx = -1e30f;
#pragma unroll
    for (int kt = 0; kt < 4; ++kt) if (kt >= KT_LO && kt <= KT_HI) {
#pragma unroll
        for (int r = 0; r < 4; ++r) { float v;
            if (WIN) v = fminf(__builtin_fmaf(s[kt][r], 0.125f * LOG2E, bp[16 * kt + r]), cap[kt - KT_LO][r]); else v = s[kt][r] * (0.125f * LOG2E);
            s[kt][r] = v; mx = fmaxf(mx, v); } }
    mx = xor16_max(mx); mx = xor32_max(mx);
    const float mnew = fmaxf(mrun, mx), alpha = __builtin_amdgcn_exp2f(mrun - mnew);
    mrun = mnew;
    float psum = 0.f;
#pragma unroll
    for (int kt = 0; kt < 4; ++kt) {
        if (kt >= KT_LO && kt <= KT_HI) {
#pragma unroll
            for (int r = 0; r < 4; ++r) { const float p = __builtin_amdgcn_exp2f(s[kt][r] - mnew); s[kt][r] = p; psum += p; } }
        else s[kt] = (f32x4){0.f, 0.f, 0.f, 0.f}; }
    lrun = lrun * alpha + psum;
#pragma unroll
    for (int nt = 0; nt < 4; ++nt) o[nt] = o[nt] * alpha;
#pragma unroll
    for (int ks = 0; ks < 2; ++ks) if (2 * ks + 1 >= KT_LO && 2 * ks <= KT_HI) {
        v4u w; w.x = pk2(s[2 * ks][0], s[2 * ks][1]); w.y = pk2(s[2 * ks][2], s[2 * ks][3]); w.z = pk2(s[2 * ks + 1][0], s[2 * ks + 1][1]); w.w = pk2(s[2 * ks + 1][2], s[2 * ks + 1][3]);
        const bf16x8 pb = __builtin_bit_cast(bf16x8, w);
#pragma unroll
        for (int nt = 0; nt < 4; ++nt) o[nt] = __builtin_amdgcn_mfma_f32_16x16x32_bf16(vf[nt][ks], pb, o[nt], 0, 0, 0); }
}
__device__ __forceinline__ void na_load_vf(const LAS bf16* Vt, bf16x8 (&vf)[4][2], int q, int l15) {
    const LAS bf16* base = Vt + (size_t)(4 * q + (l15 >> 2)) * NP + 4 * (l15 & 3);
#pragma unroll
    for (int nt = 0; nt < 4; ++nt)
#pragma unroll
        for (int ks = 0; ks < 2; ++ks) {
            const s16x4_t lo = __builtin_amdgcn_ds_read_tr16_b64_v4i16((LAS s16x4_t*)(base + (size_t)(32 * ks) * NP + 16 * nt)), hi = __builtin_amdgcn_ds_read_tr16_b64_v4i16((LAS s16x4_t*)(base + (size_t)(32 * ks + 16) * NP + 16 * nt));
            vf[nt][ks] = mk8(__builtin_bit_cast(v2u, lo), __builtin_bit_cast(v2u, hi)); }
}
__device__ __forceinline__ void ph_na(const Ctx& c) {
    LAS bf16* Kb = (LAS bf16*)c.lds;
    LAS bf16* Vb = Kb + 2 * 64 * NP;
    LAS float* rpbL = (LAS float*)(Vb + 2 * 64 * NP);
    const bf16* P = WSP(bf16, WS_PBUF);
    const int q = c.lane >> 4, l15 = c.lane & 15, hq = c.wave & 1;
    const int lkey = c.tid >> 3, lch = c.tid & 7;
    for (int item = blockIdx.x; item < 512 + 16; item += c.G) {
        const bool lat = item < 512;
        int b, h, r0 = 0, rlo = 0, nwin = 0;
        if (lat) { const int rb = item & 31; h = (item >> 5) & 7; b = item >> 8; r0 = 4 * rb; rlo = min(max(r0 - 4, 0), 120); nwin = min(max(r0 - 1, 0), 120) + 7 - rlo + 1; }
        else { const int ci = item - 512; h = ci & 7; b = ci >> 3; }
        const int nsteps = nwin + 4, r = r0 + (c.wave >> 1), rs = min(max(r - 4, 0), 120);
        for (int i = c.tid; i < 465; i += 512) rpbL[i] = c.a->in[I_RPB][h * 465 + i] * LOG2E;
        bf16x8 qf[2][2];
#pragma unroll
        for (int g = 0; g < 2; ++g) { const int qt = lat ? b * SEQ + r * 64 + 16 * (2 * hq + g) + l15 : NLAT + b * CTXL + 32 * c.wave + 16 * g + l15;
#pragma unroll
            for (int ks = 0; ks < 2; ++ks) qf[g][ks] = *(const bf16x8*)(P + (size_t)qt * 2560 + 1024 + h * 64 + 32 * ks + 8 * q); }
        f32x4 o[2][4];
#pragma unroll
        for (int g = 0; g < 2; ++g)
#pragma unroll
            for (int nt = 0; nt < 4; ++nt) o[g][nt] = (f32x4){0.f, 0.f, 0.f, 0.f};
        float mrun[2] = {-1e30f, -1e30f}, lrun[2] = {0.f, 0.f};
        float cap[2][3][4]; int bidx[2];
#pragma unroll
        for (int g = 0; g < 2; ++g) { const int QGr = 2 * hq + g, qc = 16 * QGr + l15, cs = min(max(qc - 8, 0), 48), ktlo = QGr <= 1 ? 0 : QGr - 1; bidx[g] = 4 * q - qc + 15;
#pragma unroll
            for (int t = 0; t < 3; ++t)
#pragma unroll
                for (int rr = 0; rr < 4; ++rr) { const int kc = 16 * (ktlo + t) + 4 * q + rr; cap[g][t][rr] = (unsigned)(kc - cs) < 16u ? __builtin_inff() : -1e30f; } }
        v4u kreg, vreg;
        { const int tok0 = nwin > 0 ? b * SEQ + rlo * 64 : NLAT + b * CTXL; const bf16* src = P + (size_t)(tok0 + lkey) * 2560 + 1536 + h * 64 + 8 * lch; kreg = *(const v4u*)src; vreg = *(const v4u*)(src + 512); }
        for (int s = 0; s < nsteps; ++s) {
            LAS bf16* Kt = Kb + (s & 1) * 64 * NP; LAS bf16* Vt = Vb + (s & 1) * 64 * NP;
            *(LAS v4u*)(Kt + (size_t)lkey * NP + 8 * lch) = kreg;
            *(LAS v4u*)(Vt + (size_t)lkey * NP + 8 * lch) = vreg;
            __syncthreads();
            if (s + 1 < nsteps) { const int s1 = s + 1; const int tok0 = s1 < nwin ? b * SEQ + (rlo + s1) * 64 : NLAT + b * CTXL + 64 * (s1 - nwin);
                const bf16* src = P + (size_t)(tok0 + lkey) * 2560 + 1536 + h * 64 + 8 * lch; kreg = *(const v4u*)src; vreg = *(const v4u*)(src + 512); }
            if (s < nwin) { const int kr = rlo + s;
                if (kr >= rs && kr < rs + 8) { bf16x8 vf[4][2]; na_load_vf(Vt, vf, q, l15); const LAS float* rpbrow = rpbL + (kr - r + 7) * 31;
                    if (hq == 0) { na_qgroup<0, true>(Kt, vf, rpbrow + bidx[0], cap[0], qf[0], o[0], mrun[0], lrun[0], q, l15); na_qgroup<1, true>(Kt, vf, rpbrow + bidx[1], cap[1], qf[1], o[1], mrun[1], lrun[1], q, l15); }
                    else { na_qgroup<2, true>(Kt, vf, rpbrow + bidx[0], cap[0], qf[0], o[0], mrun[0], lrun[0], q, l15); na_qgroup<3, true>(Kt, vf, rpbrow + bidx[1], cap[1], qf[1], o[1], mrun[1], lrun[1], q, l15); } } }
            else { bf16x8 vf[4][2]; na_load_vf(Vt, vf, q, l15);
                na_qgroup<0, false>(Kt, vf, rpbL, cap[0], qf[0], o[0], mrun[0], lrun[0], q, l15); na_qgroup<0, false>(Kt, vf, rpbL, cap[1], qf[1], o[1], mrun[1], lrun[1], q, l15); }
        }
#pragma unroll
        for (int g = 0; g < 2; ++g) { float l = lrun[g]; l = xor16_sum(l); l = xor32_sum(l); const float il = 1.0f / l;
            const int qt = lat ? b * SEQ + r * 64 + 16 * (2 * hq + g) + l15 : NLAT + b * CTXL + 32 * c.wave + 16 * g + l15;
#pragma unroll
            for (int nt = 0; nt < 4; ++nt) { v2u pk; pk.x = pk2(o[g][nt][0] * il, o[g][nt][1] * il); pk.y = pk2(o[g][nt][2] * il, o[g][nt][3] * il);
                *(v2u*)(WSP(bf16, WS_MIX) + (size_t)qt * 1024 + 512 + h * 64 + 16 * nt + 4 * q) = pk; } }
        __syncthreads();
    }
}


typedef int v8i_c __attribute__((ext_vector_type(8)));
typedef int v4i_c __attribute__((ext_vector_type(4)));
__device__ __forceinline__ v8i_c ld32(const unsigned char* p) { const v4i_c lo = *(const v4i_c*)p, hi = *(const v4i_c*)(p + 16); return __builtin_shufflevector(lo, hi, 0, 1, 2, 3, 4, 5, 6, 7); }
template <int NT, int KS, int APITCH, int MT> __device__ __forceinline__ void ctx_pass(const Ctx& c, const unsigned char* A, int lda, const unsigned char* B0, const unsigned char* B1, int ldb, f32x4 (&acc)[MT][NT], int mt0) {
    const int l15 = c.lane & 15, q = c.lane >> 4;
    LAS unsigned char* aL = c.lds;
    v8i_c b[KS][NT];
    { const unsigned char* bp0 = B0 + (size_t)l15 * ldb + 32 * q; const unsigned char* bp1 = B1 + (size_t)l15 * ldb + 32 * q;
#pragma unroll
      for (int ks = 0; ks < KS; ++ks) { b[ks][0] = ld32(bp0 + 128 * ks); if (NT > 1) b[ks][NT - 1] = ld32(bp1 + 128 * ks); } }
    __syncthreads();
    constexpr int CPR = KS * 8;
    for (int i = c.tid; i < 64 * CPR; i += 512) { const int row = i / CPR, ch = i % CPR; *(LAS v4i_c*)(aL + row * APITCH + 16 * ch) = *(const v4i_c*)(A + (size_t)row * lda + 16 * ch); }
    __syncthreads();
#pragma unroll
    for (int ks = 0; ks < KS; ++ks) {
        v8i_c a[MT];
#pragma unroll
        for (int mt = 0; mt < MT; ++mt) { const LAS unsigned char* p = aL + (16 * (mt0 + mt) + l15) * APITCH + 128 * ks + 32 * q; const v4i_c lo = *(const LAS v4i_c*)p, hi = *(const LAS v4i_c*)(p + 16); a[mt] = __builtin_shufflevector(lo, hi, 0, 1, 2, 3, 4, 5, 6, 7); }
#pragma unroll
        for (int mt = 0; mt < MT; ++mt)
#pragma unroll
            for (int nt = 0; nt < NT; ++nt) asm volatile("v_mfma_f32_16x16x128_f8f6f4 %0, %1, %2, %0" : "+v"(acc[mt][nt]) : "v"(b[ks][nt]), "v"(a[mt]));
    }
}
__device__ __forceinline__ void ph_moe_ctx1(const Ctx& c, int layer) {
    const unsigned char* W1 = WSP(unsigned char, WS_W1) + (size_t)layer * 16 * 5632 * 1024;
    const int l15 = c.lane & 15, q = c.lane >> 4;
    for (int item = blockIdx.x; item < 16 * 22; item += c.G) {
        const int e = item / 22, pn = item % 22;
        const unsigned char* A = WSP(unsigned char, WS_XG) + (size_t)(MOE_LAT + e * 256) * 1024;
        const unsigned char* Bg = W1 + ((size_t)e * 5632 + pn * 256 + 16 * c.wave) * 1024;
        f32x4 acc[4][2];
#pragma unroll
        for (int mt = 0; mt < 4; ++mt) { acc[mt][0] = (f32x4){0.f, 0.f, 0.f, 0.f}; acc[mt][1] = (f32x4){0.f, 0.f, 0.f, 0.f}; }
        ctx_pass<2, 8, 1040, 4>(c, A, 1024, Bg, Bg + (size_t)128 * 1024, 1024, acc, 0);
        asm volatile("s_nop 15\n\ts_nop 15" ::: "memory");
        const float in_inv = 1.0f / (SC_X * SC_W);
#pragma unroll
        for (int mt = 0; mt < 4; ++mt) { const f32x4 g = acc[mt][0] * in_inv, u = acc[mt][1] * (in_inv * SC_H);
            const unsigned w = pg8::pk4_fp8(pg8::clamp448(pg8::silu_f(g[0]) * u[0]), pg8::clamp448(pg8::silu_f(g[1]) * u[1]), pg8::clamp448(pg8::silu_f(g[2]) * u[2]), pg8::clamp448(pg8::silu_f(g[3]) * u[3]));
            *(unsigned*)(WSP(unsigned char, WS_HID) + (size_t)(MOE_LAT + e * 256 + 16 * mt + l15) * FF + pn * 128 + 16 * c.wave + 4 * q) = w; }
    }
    __syncthreads();
}
__device__ __forceinline__ void ph_moe_ctx2(const Ctx& c, int layer) {
    const unsigned char* W2 = WSP(unsigned char, WS_W2) + (size_t)layer * 16 * 1024 * 2816;
    const int l15 = c.lane & 15, q = c.lane >> 4, nt = c.wave & 3, mh = c.wave >> 2;
    for (int item = blockIdx.x; item < 16 * 16; item += c.G) {
        const int e = item >> 4, cb = item & 15;
        const unsigned char* A = WSP(unsigned char, WS_HID) + (size_t)(MOE_LAT + e * 256) * FF;
        const unsigned char* B = W2 + ((size_t)e * 1024 + cb * 64 + 16 * nt) * FF;
        f32x4 acc[2][1];
        acc[0][0] = (f32x4){0.f, 0.f, 0.f, 0.f}; acc[1][0] = (f32x4){0.f, 0.f, 0.f, 0.f};
        ctx_pass<1, 11, 1424, 2>(c, A, FF, B, B, FF, acc, 2 * mh);
        ctx_pass<1, 11, 1424, 2>(c, A + 1408, FF, B + 1408, B + 1408, FF, acc, 2 * mh);
        asm volatile("s_nop 15\n\ts_nop 15" ::: "memory");
        const float sc = 1.0f / (SC_H * SC_W);
#pragma unroll
        for (int mt = 0; mt < 2; ++mt) { const f32x4 v = acc[mt][0] * sc; v2u pk; pk.x = pk2(v[0], v[1]); pk.y = pk2(v[2], v[3]);
            *(v2u*)(WSP(bf16, WS_Y) + (size_t)(MOE_LAT + e * 256 + 16 * (2 * mh + mt) + l15) * 1024 + cb * 64 + 16 * nt + 4 * q) = pk; }
    }
    __syncthreads();
}

#ifndef GLA_NAIVE
#define GLA_NAIVE 0
#endif
#ifndef NA_NAIVE
#define NA_NAIVE 0
#endif
#ifndef MK_ONE_LAUNCH
#define MK_ONE_LAUNCH 1
#endif
constexpr int NPH = 23;
#define MKCTX() Ctx c; c.lds = lds; { unsigned long long a_ = (unsigned long long)a; asm volatile("" : "+s"(a_)); const unsigned lo_ = __builtin_amdgcn_readfirstlane((unsigned)a_), hi_ = __builtin_amdgcn_readfirstlane((unsigned)(a_ >> 32)); c.a = (const CAS Args*)(((unsigned long long)hi_ << 32) | lo_); } c.out = a->out; c.ws = a->ws; { int t_ = threadIdx.x; asm volatile("" : "+v"(t_)); c.tid = t_ & 511; } c.lane = c.tid & 63; c.wave = __builtin_amdgcn_readfirstlane(c.tid >> 6); c.G = gridDim.x; \
    c.gw = blockIdx.x * NWAVES + c.wave; c.ngw = c.G * NWAVES
__device__ __forceinline__ void P_prologue(LAS unsigned char* lds, const CAS Args* a) { MKCTX(); ph_prologue(c); }
__device__ __forceinline__ void P_fill(LAS unsigned char* lds, const CAS Args* a, int maxn) { MKCTX(); convert_fill(c, maxn); }
__device__ __forceinline__ void P_adaln0(LAS unsigned char* lds, const CAS Args* a) { MKCTX();
    if (c.tid == 0) { unsigned* ctl_ = (unsigned*)(c.ws + WS_CTL); XB_SPIN(xb_ld(ctl_ + MOD0_FLAG) < 32u, ctl_ + CW_BAR); __builtin_amdgcn_fence(__ATOMIC_ACQUIRE, "agent"); asm volatile("s_waitcnt vmcnt(0)" ::: "memory"); }
    __syncthreads();
    ph_adaln0(c); }
__device__ __forceinline__ void P_conv(LAS unsigned char* lds, const CAS Args* a) { MKCTX(); ph_conv(c); }
#if NA_NAIVE
__device__ __forceinline__ void P_na(LAS unsigned char* lds, const CAS Args* a) { MKCTX(); ph_na_naive(c); }
#else
__device__ __forceinline__ void P_na(LAS unsigned char* lds, const CAS Args* a) { MKCTX(); ph_na(c); }
#endif
__device__ __forceinline__ void P_outproj_ctx(LAS unsigned char* lds, const CAS Args* a) { MKCTX(); ph_outproj_ctx_tiles(c, WS_WOUTE); }
__device__ __forceinline__ void P_inproj_odd_tiles(LAS unsigned char* lds, const CAS Args* a) { MKCTX(); ph_inproj_odd_tiles(c); }
__device__ __forceinline__ void P_prep_odd(LAS unsigned char* lds, const CAS Args* a) { MKCTX(); ph_prep_odd(c); }
__device__ __forceinline__ void P_pool(LAS unsigned char* lds, const CAS Args* a) { MKCTX(); ph_pool(c); }
__device__ __forceinline__ void P_gla_naive(LAS unsigned char* lds, const CAS Args* a) { MKCTX(); ph_gla_naive(c); }
__device__ __forceinline__ void P_gla_out(LAS unsigned char* lds, const CAS Args* a) { MKCTX(); ph_gla_out(c); }
__device__ __forceinline__ void P_gla_g1(LAS unsigned char* lds, const CAS Args* a) { MKCTX(); ph_gla_g1(c); }
__device__ __forceinline__ void P_gla_g2(LAS unsigned char* lds, const CAS Args* a) { MKCTX(); ph_gla_g2(c); }
__device__ __forceinline__ void P_gla_g3(LAS unsigned char* lds, const CAS Args* a) { MKCTX(); ph_gla_g3(c); }
__device__ __forceinline__ void P_post(LAS unsigned char* lds, const CAS Args* a, int layer, int ntok) { MKCTX(); ph_post(c, layer, ntok); }
__device__ __forceinline__ void P_topk_gather(LAS unsigned char* lds, const CAS Args* a, int nctx) { MKCTX(); ph_topk_gather(c, 256, nctx); }
__device__ __forceinline__ void P_moe_ctx1(LAS unsigned char* lds, const CAS Args* a, int layer) { MKCTX(); ph_moe_ctx1(c, layer); }
__device__ __forceinline__ void P_moe_ctx2(LAS unsigned char* lds, const CAS Args* a, int layer) { MKCTX(); ph_moe_ctx2(c, layer); }
__device__ __forceinline__ void P_combine(LAS unsigned char* lds, const CAS Args* a, int layer, int ntok) { MKCTX(); ph_combine(c, layer, ntok); }
template <int K, int NN, int LDC> __device__ __forceinline__ void P_gemm_bf16(LAS unsigned char* lds, const bf16* A, const bf16* Bt, bf16* O, int nM) {
    pg8::Gemm g{A, Bt, K}; pg8::Order S; S.init(nM, NN, (int)gridDim.x, (int)blockIdx.x, 0);
    pg8::EpiBf16 E{O, LDC, 1.0f}; pg8::gemm_phase<pg8::EpiBf16, pg8::Order, PG8_ALIGN, PG8_SP2>(lds, g, S, E);
}
template <int KB, int NN, int LDC> __device__ __forceinline__ void P_gemm_f8_bf16(LAS unsigned char* lds, const unsigned char* A, const unsigned char* Bt, bf16* O, int nM) {
    pg8::Gemm g{(const bf16*)A, (const bf16*)Bt, KB / 2}; pg8::Order S; S.init(nM, NN, (int)gridDim.x, (int)blockIdx.x, 1);
    pg8::EpiBf16F8 E{O, LDC, 1.0f / (SC_H * SC_W)}; pg8::gemm_phase<pg8::EpiBf16F8, pg8::Order, PG8_ALIGN, PG8_SP2>(lds, g, S, E);
}
template <int KB, int NN, int LDC> __device__ __forceinline__ void P_gemm_f8_swiglu(LAS unsigned char* lds, const unsigned char* A, const unsigned char* Bt, unsigned char* O, int nM) {
    pg8::Gemm g{(const bf16*)A, (const bf16*)Bt, KB / 2}; pg8::Order S; S.init(nM, NN, (int)gridDim.x, (int)blockIdx.x, 1);
    pg8::EpiSwigluF8 E{O, LDC, 1.0f / (SC_X * SC_W), SC_H}; pg8::gemm_phase<pg8::EpiSwigluF8, pg8::Order, PG8_ALIGN, PG8_SP2>(lds, g, S, E);
}

__global__ void __launch_bounds__(NWAVES * 64, 2) fwd(Args args) {
    extern __shared__ __attribute__((aligned(16))) unsigned char lds_raw[];
    LAS unsigned char* lds = (LAS unsigned char*)lds_raw;
    const CAS Args* a = (const CAS Args*)__builtin_amdgcn_kernarg_segment_ptr();
    unsigned char* ws = args.ws;
    const int tid = threadIdx.x;
    volatile LAS unsigned* MISC = (volatile LAS unsigned*)(lds + MISC_OFF);
    for (int u = tid; u < (LDS_BYTES - LDSCTL_OFF) / 4; u += NWAVES * 64) ((LAS unsigned*)(lds + LDSCTL_OFF))[u] = 0u;
    __syncthreads();
    const int lo = args.ph_lo, hi = args.ph_hi;
    XcdBarrier bar; bar.bar = (unsigned*)(ws + WS_CTL) + CW_BAR; bar.x = 0; bar.st = nullptr;
    if (hi - lo > 1) bar = xcd_barrier_post((unsigned*)(ws + WS_CTL) + CW_BAR, MISC + 8);
#ifndef PROBE_MASK
#define PROBE_MASK 0
#endif
#ifndef PROBE_N
#define PROBE_N 2
#endif
#define REP(k) (((k) != 17 && (k) != 10 && (((PROBE_MASK) >> ((k) < 17 ? (k) : (k) - 12)) & 1)) ? PROBE_N : 1)
#define REPX(b) ((((PROBE_MASK) >> (b)) & 1) ? PROBE_N : 1)
#define RX(b, call) do { for (int rx_ = 0; rx_ < REPX(b); ++rx_) { call; } } while (0)
#define IN(k) (lo <= (k) && (k) < hi)
#define BARRIER_FILL(k) do { xcd_barrier_arrive(bar); if (gridDim.x == 256 && (k) <= 17 && MISC[11] == 0u) P_fill(lds, a, 2); xcd_barrier_wait(bar); } while (0)
#define SEAM(k) do { if (IN(k) && IN((k) + 1)) BARRIER_FILL(k); } while (0)
#define WP(off) ((bf16*)(ws + (off)))
    if (IN(0)) for (int rep_ = 0; rep_ < REP(0); ++rep_) { P_prologue(lds, a); }
    if (IN(1)) for (int rep_ = 0; rep_ < REP(1); ++rep_) { P_adaln0(lds, a); } SEAM(1);
    if (IN(2)) for (int rep_ = 0; rep_ < REP(2); ++rep_) { P_gemm_bf16<1024, EVEN_IN / 256, EVEN_IN>(lds, WP(WS_H), WP(WS_WINE), WP(WS_PBUF), NTOK / 256); if (gridDim.x == 256 && blockIdx.x >= 148) P_fill(lds, a, 8); }     SEAM(2);
    if (IN(3)) for (int rep_ = 0; rep_ < REP(3); ++rep_) { RX(17, P_conv(lds, a)); RX(18, P_na(lds, a)); if (gridDim.x == 256 && blockIdx.x >= 32) P_fill(lds, a, 2); }     SEAM(3);
    if (IN(4)) for (int rep_ = 0; rep_ < REP(4); ++rep_) { P_gemm_bf16<1024, 4, 1024>(lds, WP(WS_MIX), WP(WS_WOUTE), WP(WS_YO), NLAT / 256); RX(19, P_outproj_ctx(lds, a)); } SEAM(4);
#define COMMON(layer, p0, ntok, nlists, nrows) \
    if (IN(p0 + 0)) for (int rep_ = 0; rep_ < REP(p0 + 0); ++rep_) { P_post(lds, a, layer, ntok); } SEAM(p0 + 0); \
    if (IN(p0 + 1)) for (int rep_ = 0; rep_ < REP(p0 + 1); ++rep_) { P_topk_gather(lds, a, (nlists) - 32); if (layer == 1) P_fill(lds, a, 1 << 30); }     do { if (IN(p0 + 1) && IN(p0 + 3)) BARRIER_FILL(p0 + 1); } while (0); \
    if (IN(p0 + 3)) for (int rep_ = 0; rep_ < REP(p0 + 3); ++rep_) { P_gemm_f8_swiglu<1024, 22, FF>(lds, ws + WS_XG, ws + WS_W1 + (size_t)layer * 16 * 5632 * 1024, ws + WS_HID, MOE_LAT / 256); if ((nrows) > MOE_LAT) { P_moe_ctx1(lds, a, layer); if (gridDim.x == 256 && blockIdx.x >= 96) P_fill(lds, a, 2); } } SEAM(p0 + 3); \
    if (IN(p0 + 4)) for (int rep_ = 0; rep_ < REP(p0 + 4); ++rep_) { P_gemm_f8_bf16<FF, 4, 1024>(lds, ws + WS_HID, ws + WS_W2 + (size_t)layer * 16 * 1024 * 2816, WP(WS_Y), MOE_LAT / 256); if ((nrows) > MOE_LAT) P_moe_ctx2(lds, a, layer); } SEAM(p0 + 4); \
    if (IN(p0 + 5)) for (int rep_ = 0; rep_ < REP(p0 + 5); ++rep_) { P_combine(lds, a, layer, ntok); }
    COMMON(0, 5, NTOK, 64, MOE_ROWS) SEAM(10);
    if (IN(11)) for (int rep_ = 0; rep_ < REP(11); ++rep_) { P_gemm_bf16<1024, 8, 2048>(lds, WP(WS_H), WP(WS_WINO), WP(WS_PBUF), NLAT / 256); RX(20, P_inproj_odd_tiles(lds, a)); }
    do { if (IN(11) && IN(13)) BARRIER_FILL(11); } while (0);
#if GLA_NAIVE
    if (IN(12)) for (int rep_ = 0; rep_ < REP(12); ++rep_) { P_prep_odd(lds, a); } SEAM(12);
    if (IN(13)) for (int rep_ = 0; rep_ < REP(13); ++rep_) { P_pool(lds, a); P_gla_naive(lds, a); } SEAM(13);
    if (IN(14)) for (int rep_ = 0; rep_ < REP(14); ++rep_) { P_gla_out(lds, a); } SEAM(14);
    SEAM(15);
#else
    if (IN(13)) for (int rep_ = 0; rep_ < REP(13); ++rep_) { RX(21, P_pool(lds, a)); RX(22, P_gla_g1(lds, a)); if (gridDim.x == 256 && (blockIdx.x >> 3) >= 4) P_fill(lds, a, 1); } SEAM(13);
    if (IN(14)) for (int rep_ = 0; rep_ < REP(14); ++rep_) { P_gla_g2(lds, a); } SEAM(14);
    if (IN(15)) for (int rep_ = 0; rep_ < REP(15); ++rep_) { P_gla_g3(lds, a); } SEAM(15);
#endif
    if (IN(16)) for (int rep_ = 0; rep_ < REP(16); ++rep_) { P_gemm_bf16<1024, 4, 1024>(lds, WP(WS_MIX), WP(WS_WOUTO), WP(WS_YO), NLAT / 256); } SEAM(16);
    COMMON(1, 17, NLAT, 32, MOE_LAT)
#undef COMMON
#undef IN
#undef SEAM
#undef WP
}

extern "C" void kernel_launch(void* const* d_in, const int* in_sizes, int n_in, void* d_out, int out_size, void* d_ws, size_t ws_size, hipStream_t stream) {
    static int grid = 0;
    if (grid == 0) {
        if (n_in != N_IN || out_size != NLAT * D || ws_size < WS_END) { fprintf(stderr, "kernel_launch: unexpected shapes (n_in %d, out %d, ws %zu, need %zu)\n", n_in, out_size, ws_size, (size_t)WS_END); grid = -1; return; }
        int dev = 0, cus = 0, per_cu = 0;
        if (hipGetDevice(&dev) != hipSuccess || hipDeviceGetAttribute(&cus, hipDeviceAttributeMultiprocessorCount, dev) != hipSuccess) { grid = -1; return; }
        if (hipFuncSetAttribute((const void*)fwd, hipFuncAttributeMaxDynamicSharedMemorySize, LDS_BYTES) != hipSuccess) { fprintf(stderr, "kernel_launch: hipFuncSetAttribute failed\n"); grid = -1; return; }
        if (hipOccupancyMaxActiveBlocksPerMultiprocessor(&per_cu, (const void*)fwd, NWAVES * 64, LDS_BYTES) != hipSuccess || per_cu < 1) fprintf(stderr, "kernel_launch: occupancy query reports %d\n", per_cu);
        (void)hipGetLastError();
        grid = cus;
    }
    if (grid < 0) return;
    (void)in_sizes;
    if (hipMemsetAsync((char*)d_ws + WS_CTL, 0, CTL_ZERO_BYTES, stream) != hipSuccess) return;
    Args a{};
    for (int i = 0; i < N_IN; ++i) a.in[i] = (const float*)d_in[i];
    a.out = (float*)d_out; a.ws = (unsigned char*)d_ws;
#if MK_ONE_LAUNCH
    a.ph_lo = 0; a.ph_hi = NPH;
    hipLaunchKernelGGL(fwd, dim3(grid), dim3(NWAVES * 64), LDS_BYTES, stream, a);
#else
    for (int li = 0; li < NPH; ++li) { a.ph_lo = li; a.ph_hi = li + 1; hipLaunchKernelGGL(fwd, dim3(grid), dim3(NWAVES * 64), LDS_BYTES, stream, a); }
#endif
}
```
